# Optimizing an MI355X kernel written in HIP

```python
import jax, jax.numpy as jnp
from jax import lax
import numpy as np

D_MODEL = 1024
BATCH = 8
SEQ = 4096
DEPTH = 2

CHUNK = 64
D_MIX = D_MODEL

GLA_DV = 96
GLA_DK = 48
GLA_WIDTH = 3 * D_MODEL // 8
GLA_HEADS = GLA_WIDTH // GLA_DV
GLA_KEY_WIDTH = GLA_HEADS * GLA_DK
GLA_GATE_RANK = 16
GLA_GATE_TAU = 16.0

CONV_WIDTH = D_MODEL // 4
CONV_KERNEL = 31

ATT_HEAD_DIM = 64
ATT_WIDTH = 3 * D_MODEL // 8
ATT_HEADS = ATT_WIDTH // ATT_HEAD_DIM
ATT_LEFT_CHUNKS = 8
ATT_BAND_CHUNKS = ATT_LEFT_CHUNKS + 1
ATT_BAND = ATT_BAND_CHUNKS * CHUNK
MAX_REL_DIST = 128
N_REL = 2 * MAX_REL_DIST + 1

D_FF = 4 * D_MODEL

EPS = 1e-6
NEG_INF = -1e30

IN_SIZES = (
    GLA_KEY_WIDTH,
    GLA_KEY_WIDTH,
    GLA_WIDTH,
    GLA_WIDTH,
    GLA_GATE_RANK,
    2 * CONV_WIDTH,
    ATT_WIDTH,
    ATT_WIDTH,
    ATT_WIDTH,
)
D_IN = int(sum(IN_SIZES))
IN_SPLITS = [int(s) for s in np.cumsum(IN_SIZES)[:-1]]

kernel_name = "hybrid_gla_conformer_chunkattn_encoder"


def rmsnorm(x, g):
    xf = x.astype(jnp.float32)
    y = xf * lax.rsqrt(jnp.mean(xf * xf, axis=-1, keepdims=True) + EPS)
    return (y * g.astype(jnp.float32)).astype(x.dtype)


def gla_mixer(q, k, v, g, gate_lr, w_gate, b_gate, out_norm):
    dtype = v.dtype
    B, S = q.shape[:2]
    nc = S // CHUNK
    f32 = jnp.float32
    shp_k = (B, nc, CHUNK, GLA_HEADS, GLA_DK)
    qf = q.astype(f32).reshape(shp_k) * (GLA_DK ** -0.5)
    kf = k.astype(f32).reshape(shp_k)
    vf = v.astype(f32).reshape(B, nc, CHUNK, GLA_HEADS, GLA_DV)
    z = gate_lr.astype(f32) @ w_gate.astype(f32) + b_gate.astype(f32)
    log_a = (jax.nn.log_sigmoid(z) / GLA_GATE_TAU).reshape(shp_k)
    cum = jnp.cumsum(log_a, axis=2)
    end = cum[:, :, -1:]
    k_dec = kf * jnp.exp(end - cum)
    chunk_decay = jnp.exp(end[:, :, 0])
    kv = jnp.einsum('bnchk,bnchv->bnhkv', k_dec, vf)

    def step(state, inp):
        a, kv_c = inp
        state = a[..., None] * state + kv_c
        return state, state

    init = jnp.zeros((B, GLA_HEADS, GLA_DK, GLA_DV), f32)
    _, states = lax.scan(step, init, (jnp.moveaxis(chunk_decay, 1, 0), jnp.moveaxis(kv, 1, 0)))
    o = jnp.einsum('bnchk,nbhkv->bnchv', qf, states)
    o = o.reshape(B, S, GLA_HEADS, GLA_DV)
    o = o * lax.rsqrt(jnp.mean(o * o, axis=-1, keepdims=True) + EPS)
    o = o.reshape(B, S, GLA_WIDTH) * out_norm.astype(f32)
    o = o * jax.nn.silu(g.astype(f32))
    return o.astype(dtype)


def conv_mixer(u, w_dw, b_dw, ln_g, ln_b):
    dtype = u.dtype
    a, b = jnp.split(u, 2, axis=-1)
    h = a * jax.nn.sigmoid(b)
    h = lax.conv_general_dilated(
        h, w_dw.reshape(CONV_KERNEL, 1, CONV_WIDTH).astype(h.dtype),
        window_strides=(1,), padding=((CONV_KERNEL - 1, 0),),
        dimension_numbers=('NWC', 'WIO', 'NWC'), feature_group_count=CONV_WIDTH)
    hf = h.astype(jnp.float32) + b_dw.astype(jnp.float32)
    mu = jnp.mean(hf, axis=-1, keepdims=True)
    var = jnp.mean(jnp.square(hf - mu), axis=-1, keepdims=True)
    hf = (hf - mu) * lax.rsqrt(var + EPS) * ln_g.astype(jnp.float32) + ln_b.astype(jnp.float32)
    return jax.nn.silu(hf).astype(dtype)


def chunk_attention(q, k, v, rel_bias):
    dtype = v.dtype
    B, S = q.shape[:2]
    nc = S // CHUNK
    shp = (B, nc, CHUNK, ATT_HEADS, ATT_HEAD_DIM)
    qc, kc, vc = q.reshape(shp), k.reshape(shp), v.reshape(shp)
    pad = ((0, 0), (ATT_LEFT_CHUNKS, 0), (0, 0), (0, 0), (0, 0))
    kp, vp = jnp.pad(kc, pad), jnp.pad(vc, pad)
    k_band = jnp.concatenate([kp[:, w:w + nc] for w in range(ATT_BAND_CHUNKS)], axis=2)
    v_band = jnp.concatenate([vp[:, w:w + nc] for w in range(ATT_BAND_CHUNKS)], axis=2)
    scores = jnp.einsum('bnqhd,bnkhd->bnhqk', qc, k_band).astype(jnp.float32) * (ATT_HEAD_DIM ** -0.5)
    q_pos = np.arange(CHUNK)[:, None]
    k_pos = np.arange(ATT_BAND)[None, :] - ATT_LEFT_CHUNKS * CHUNK
    rel_idx = np.clip(q_pos - k_pos, -MAX_REL_DIST, MAX_REL_DIST) + MAX_REL_DIST
    bias = rel_bias.astype(jnp.float32)[:, rel_idx]
    key_chunk = np.arange(nc)[:, None] - ATT_LEFT_CHUNKS + np.repeat(np.arange(ATT_BAND_CHUNKS), CHUNK)[None, :]
    valid = key_chunk >= 0
    scores = jnp.where(valid[None, :, None, None, :], scores + bias[None, None], NEG_INF)
    p = jax.nn.softmax(scores, axis=-1).astype(dtype)
    o = jnp.einsum('bnhqk,bnkhd->bnqhd', p, v_band)
    return o.reshape(B, S, ATT_WIDTH)


def sq_relu_mlp(x, w_up, w_down):
    h = jax.nn.relu(x @ w_up)
    return (h * h) @ w_down


def setup_inputs(seed: int = 0) -> dict:
    key = jax.random.key(seed)
    ks = jax.random.split(key, 20)
    f32 = jnp.float32
    nrm = lambda k, shape, s: (jax.random.normal(k, shape, f32) * s)
    return {
        "x": nrm(ks[0], (BATCH, SEQ, D_MODEL), 1.0),
        "norm_mix": 1.0 + nrm(ks[1], (DEPTH, D_MODEL), 0.01),
        "w_in": nrm(ks[2], (DEPTH, D_MODEL, D_IN), D_MODEL ** -0.5),
        "w_gla_gate": nrm(ks[3], (DEPTH, GLA_GATE_RANK, GLA_KEY_WIDTH), GLA_GATE_RANK ** -0.5),
        "b_gla_gate": nrm(ks[4], (DEPTH, GLA_KEY_WIDTH), 0.1),
        "gla_norm": 1.0 + nrm(ks[5], (DEPTH, GLA_WIDTH), 0.01),
        "w_dw": nrm(ks[6], (DEPTH, CONV_KERNEL, CONV_WIDTH), CONV_KERNEL ** -0.5),
        "b_dw": nrm(ks[7], (DEPTH, CONV_WIDTH), 0.01),
        "conv_ln_g": 1.0 + nrm(ks[8], (DEPTH, CONV_WIDTH), 0.01),
        "conv_ln_b": nrm(ks[9], (DEPTH, CONV_WIDTH), 0.01),
        "rel_bias": nrm(ks[10], (DEPTH, ATT_HEADS, N_REL), 0.1),
        "w_out": nrm(ks[11], (DEPTH, D_MIX, D_MODEL), D_MIX ** -0.5),
        "norm_ffn": 1.0 + nrm(ks[12], (DEPTH, D_MODEL), 0.01),
        "w_up": nrm(ks[13], (DEPTH, D_MODEL, D_FF), D_MODEL ** -0.5),
        "w_down": nrm(ks[14], (DEPTH, D_FF, D_MODEL), D_FF ** -0.5),
        "norm_final": 1.0 + nrm(ks[15], (D_MODEL,), 0.01),
    }


def reference(x, norm_mix, w_in, w_gla_gate, b_gla_gate, gla_norm, w_dw, b_dw,
              conv_ln_g, conv_ln_b, rel_bias, w_out, norm_ffn, w_up, w_down, norm_final):
    h = x
    for l in range(DEPTH):
        xn = rmsnorm(h, norm_mix[l])
        proj = xn @ w_in[l]
        (g_q, g_k, g_v, g_g, g_lr, c_u, a_q, a_k, a_v) = jnp.split(proj, IN_SPLITS, axis=-1)
        o_gla = gla_mixer(g_q, g_k, g_v, g_g, g_lr, w_gla_gate[l], b_gla_gate[l], gla_norm[l])
        o_conv = conv_mixer(c_u, w_dw[l], b_dw[l], conv_ln_g[l], conv_ln_b[l])
        o_att = chunk_attention(a_q, a_k, a_v, rel_bias[l])
        mixed = jnp.concatenate([o_gla, o_conv, o_att], axis=-1)
        h = h + mixed @ w_out[l]
        h = h + sq_relu_mlp(rmsnorm(h, norm_ffn[l]), w_up[l], w_down[l])
    return rmsnorm(h, norm_final)
```

```cpp
#include <hip/hip_runtime.h>
#include <hip/hip_cooperative_groups.h>
#include <cstdio>
#include <cstdint>
namespace cg = cooperative_groups;
#ifndef USE_XCD
#define USE_XCD 1
#endif
#ifndef PROBE_DRY
#define PROBE_DRY 0
#endif
#ifndef WSTAG
#define WSTAG 1
#endif
#ifndef ATT_BLOCK
#define ATT_BLOCK 1
#endif
namespace pg8 {
#define PG8_LAS __attribute__((address_space(3)))
typedef unsigned short bf16_t;
typedef short bf16x8 __attribute__((ext_vector_type(8)));
typedef float f32x4 __attribute__((ext_vector_type(4)));
typedef unsigned u32x4 __attribute__((ext_vector_type(4)));
constexpr int BM = 256, BK = 64, HALF = 128, HTB = HALF * BK * 2  , STAGE_BYTES = 8 * HTB, NXCD = 8, WGM = 8;

__host__ __device__ __forceinline__ int lds_byte(int r, int c) { const int st = (r >> 4) * 2 + (c >> 5), rr = r & 15, cc = c & 31, ob = rr * 64 + cc * 2; return st * 1024 + (ob ^ (((ob >> 9) & 1) << 5)); }
__host__ __device__ __forceinline__ void stage_rc(int b, int& R, int& C) { const int st = b / 1024, sb = b % 1024, swz = sb ^ (((sb >> 9) & 1) << 5); R = (st >> 1) * 16 + swz / 64; C = (st & 1) * 32 + (swz % 64) / 2; }
__host__ __device__ __forceinline__ int perm32(int rho) { const int n = rho >> 4, i = rho & 15; return 8 * (i >> 2) + 4 * n + (i & 3); }

struct Unit { int pm, pn; };
struct Gemm { const bf16_t* A; const bf16_t* Bt; int M, N, K; };

struct StaticOrder {
    int nM, nN, nwg, G, c;
    __host__ __device__ void init(int M, int N, int G_, int c_) { nM = M / BM; nN = N / BM; nwg = nM * nN; G = G_; c = c_; }
    __host__ __device__ bool next(int i, Unit& u) const {
        const long L = (long)i * G + c; if (L >= nwg) return false;
        int wgid = (int)L; { const int q = nwg / NXCD, r = nwg % NXCD, xcd = wgid % NXCD, off = wgid / NXCD; wgid = (xcd < r ? xcd * (q + 1) : r * (q + 1) + (xcd - r) * q) + off; }
        const int nig = WGM * nN, gid = wgid / nig, fm = gid * WGM, gsz = (nM - fm) < WGM ? (nM - fm) : WGM;
        u.pm = fm + ((wgid % nig) % gsz); u.pn = (wgid % nig) / gsz; return true;
    }
    __device__ __forceinline__ void a_ready(const Unit&) const {}
    __device__ __forceinline__ void done(const Unit&) const {}
};

__device__ __forceinline__ unsigned cvt_pk_bf16(float lo, float hi) { unsigned r; asm volatile("v_cvt_pk_bf16_f32 %0, %1, %2" : "=v"(r) : "v"(lo), "v"(hi)); return r; }

__device__ __forceinline__ unsigned cvtpk2(float lo, float hi) { typedef float f2_t __attribute__((ext_vector_type(2))); typedef __bf16 b2_t __attribute__((ext_vector_type(2))); f2_t v = {lo, hi}; b2_t b = __builtin_convertvector(v, b2_t); return __builtin_bit_cast(unsigned, b); }
__device__ __forceinline__ float row_rstd16(const float* sspart, int row, int fq) {
    const f32x4 p = *(const f32x4*)(sspart + (size_t)row * 16 + 4 * fq);
    float s = (p[0] + p[1]) + (p[2] + p[3]);
    s += __shfl_xor(s, 16); s += __shfl_xor(s, 32);
    return __builtin_amdgcn_rsqf(s * (1.0f / 1024.0f) + 1e-6f);
}
template <int ACT, bool DRY = false> struct EpiScaleBf16 {
    static constexpr bool PERM = true, AFTER_DRAIN = false;
    bf16_t* O; int ldc; const float* sspart;
    __device__ __forceinline__ void operator()(const f32x4 (&acc)[2][2][4][2], const Unit& u, int wr, int wc, int fr, int fq) const {
        const int row0 = u.pm * BM + wr * 64 + fr; const int col0 = u.pn * BM + wc * 32 + 8 * fq;
        float rs[2][4];
#pragma unroll
        for (int ai = 0; ai < 2; ++ai)
#pragma unroll
            for (int m = 0; m < 4; ++m) { const f32x4 p = *(const f32x4*)(sspart + (size_t)(row0 + ai * HALF + m * 16) * 16 + 4 * fq); rs[ai][m] = (p[0] + p[1]) + (p[2] + p[3]); }
#pragma unroll
        for (int ai = 0; ai < 2; ++ai)
#pragma unroll
            for (int m = 0; m < 4; ++m) { float s = rs[ai][m]; s += __shfl_xor(s, 16); s += __shfl_xor(s, 32); rs[ai][m] = __builtin_amdgcn_rsqf(s * (1.0f / 1024.0f) + 1e-6f); }
#pragma unroll
        for (int ai = 0; ai < 2; ++ai)
#pragma unroll
            for (int m = 0; m < 4; ++m) { const int row = row0 + ai * HALF + m * 16; const float r = rs[ai][m];
                bf16_t* rowp = O + (size_t)row * ldc + col0;
#pragma unroll
                for (int bj = 0; bj < 2; ++bj) { f32x4 v0 = acc[ai][bj][m][0] * r, v1 = acc[ai][bj][m][1] * r;
                    if (ACT == 1) {
#pragma unroll
                        for (int e = 0; e < 4; ++e) { const float a = fmaxf(v0[e], 0.f), b = fmaxf(v1[e], 0.f); v0[e] = a * a; v1[e] = b * b; } }
                    u32x4 w; w.x = cvtpk2(v0[0], v0[1]); w.y = cvtpk2(v0[2], v0[3]); w.z = cvtpk2(v1[0], v1[1]); w.w = cvtpk2(v1[2], v1[3]);
                    if (!DRY || w.x == 0x7fc17fc1u) *(u32x4*)(rowp + bj * HALF) = w; } }
    }
};
struct EpiResid {
    static constexpr bool PERM = false, AFTER_DRAIN = false;
    bf16_t* hb; float* sspart;
    __device__ __forceinline__ void operator()(const f32x4 (&acc)[2][2][4][2], const Unit& u, int wr, int wc, int fr, int fq) const {
        typedef unsigned u32x2v __attribute__((ext_vector_type(2)));
        const int col0 = u.pn * BM + wc * 32 + 4 * fq;
#pragma unroll
        for (int ai = 0; ai < 2; ++ai) {
            u32x2v bs[4][2][2];
#pragma unroll
            for (int m = 0; m < 4; ++m) { const size_t off = (size_t)(u.pm * BM + ai * HALF + wr * 64 + m * 16 + fr) * 1024 + col0;
#pragma unroll
                for (int bj = 0; bj < 2; ++bj)
#pragma unroll
                    for (int n = 0; n < 2; ++n) bs[m][bj][n] = *(const u32x2v*)(hb + off + bj * HALF + n * 16); }
            asm volatile("" ::: "memory");
#pragma unroll
            for (int m = 0; m < 4; ++m) { const int r = u.pm * BM + ai * HALF + wr * 64 + m * 16 + fr; const size_t off = (size_t)r * 1024 + col0; float ss = 0.f;
#pragma unroll
                for (int bj = 0; bj < 2; ++bj)
#pragma unroll
                    for (int n = 0; n < 2; ++n) { const u32x2v b = bs[m][bj][n]; f32x4 o = acc[ai][bj][m][n];
                        o[0] += __uint_as_float(b.x << 16); o[1] += __uint_as_float(b.x & 0xffff0000u); o[2] += __uint_as_float(b.y << 16); o[3] += __uint_as_float(b.y & 0xffff0000u);
                        u32x2v w; w.x = cvtpk2(o[0], o[1]); w.y = cvtpk2(o[2], o[3]); *(u32x2v*)(hb + off + bj * HALF + n * 16) = w;
                        ss += (o[0] * o[0] + o[1] * o[1]) + (o[2] * o[2] + o[3] * o[3]); }
                ss += __shfl_xor(ss, 16); ss += __shfl_xor(ss, 32);
                if (fq == 0) sspart[(size_t)r * 16 + u.pn * 4 + wc] = ss; }
            asm volatile("" ::: "memory");
        }
    }
};
template <class Epi, class Sched, bool ALIGN_EPI = false, bool SP2 = false>
__device__ __forceinline__ void gemm_phase(PG8_LAS unsigned char* lds, const Gemm g, const Sched& S, const Epi& E) {
    int tid_ = threadIdx.x; asm volatile("" : "+v"(tid_));
    const int tid = tid_, wid = __builtin_amdgcn_readfirstlane(tid >> 6), lane = tid & 63, wr = wid >> 2, wc = wid & 3, fr = lane & 15, fq = lane >> 4;
    const int K = g.K, nt = K / BK;
    unsigned voffA[2], voffB[2];
#pragma unroll
    for (int i = 0; i < 2; ++i) { int R, C; stage_rc(tid * 16 + i * 8192, R, C); const int Rb = Epi::PERM ? ((R & ~31) + perm32(R & 31)) : R;
        voffA[i] = (unsigned)(R * K + C) * 2u; voffB[i] = (unsigned)(Rb * K + C) * 2u; }
    const size_t kstep = (size_t)(BK * 2);
    const size_t hstep = (size_t)HALF * K * 2;
    const size_t tstep = 2 * hstep;
    const unsigned ldsw = (unsigned)wid * 1024u;
    const int aoff = lds_byte(wr * 64 + fr, fq * 8), boff = lds_byte(wc * 32 + fr, fq * 8);
#define PG8_SA(b, h) (((b) * 2 + (h)) * HTB)
#define PG8_SB(b, h) ((4 + (b) * 2 + (h)) * HTB)
#define PG8_STAGE(bufoff, gbase, voff) do { _Pragma("unroll") for (int _i = 0; _i < 2; ++_i) \
        __builtin_amdgcn_global_load_lds((const unsigned*)((const char*)(gbase) + (voff)[_i]), (PG8_LAS unsigned*)(lds + (bufoff) + ldsw + _i * 8192), 16, 0, 0); } while (0)
#define PG8_LDA(dst, b, h) do { _Pragma("unroll") for (int m = 0; m < 4; ++m) _Pragma("unroll") for (int k = 0; k < 2; ++k) dst[m][k] = *(const PG8_LAS bf16x8*)(lds + PG8_SA(b, h) + aoff + m * 2048 + k * 1024); } while (0)
#define PG8_LDB(dst, b, h) do { _Pragma("unroll") for (int n = 0; n < 2; ++n) _Pragma("unroll") for (int k = 0; k < 2; ++k) dst[n][k] = *(const PG8_LAS bf16x8*)(lds + PG8_SB(b, h) + boff + n * 2048 + k * 1024); } while (0)
#define PG8_MMA(ai, bj, At, Bt) do { __builtin_amdgcn_s_setprio(1); _Pragma("unroll") for (int m = 0; m < 4; ++m) _Pragma("unroll") for (int n = 0; n < 2; ++n) _Pragma("unroll") for (int k = 0; k < 2; ++k) \
        acc[ai][bj][m][n] = __builtin_amdgcn_mfma_f32_16x16x32_bf16(Bt[n][k], At[m][k], acc[ai][bj][m][n], 0, 0, 0); __builtin_amdgcn_s_setprio(0); } while (0)
#define PG8_WAIT_V(n) asm volatile("s_waitcnt vmcnt(" #n ")" ::: "memory")
#define PG8_WAIT_L(n) asm volatile("s_waitcnt lgkmcnt(" #n ")" ::: "memory")
#define PG8_BAR __builtin_amdgcn_s_barrier()
#define PG8_SCHED __builtin_amdgcn_sched_barrier(0)
    Unit cur, nxt; int ui = 0;
    if (!S.next(0, cur)) return;
    f32x4 acc[2][2][4][2];
#pragma unroll
    for (int a = 0; a < 2; ++a)
#pragma unroll
        for (int b = 0; b < 2; ++b)
#pragma unroll
            for (int m = 0; m < 4; ++m)
#pragma unroll
                for (int n = 0; n < 2; ++n) acc[a][b][m][n] = (f32x4){0.f, 0.f, 0.f, 0.f};
    bf16x8 At[4][2], B0[2][2], B1[2][2];
    const char* cA = (const char*)g.A + (size_t)cur.pm * tstep; const char* cB = (const char*)g.Bt + (size_t)cur.pn * tstep;
    S.a_ready(cur);
    if constexpr (SP2) {
        PG8_STAGE(PG8_SB(0, 0), cB, voffB); PG8_STAGE(PG8_SB(0, 1), cB + hstep, voffB); PG8_STAGE(PG8_SA(0, 0), cA, voffA); PG8_STAGE(PG8_SA(0, 1), cA + hstep, voffA);
        if (wr == 1) PG8_BAR;
        PG8_WAIT_V(2); PG8_BAR;
        PG8_STAGE(PG8_SB(1, 0), cB + kstep, voffB); PG8_STAGE(PG8_SA(1, 0), cA + kstep, voffA); PG8_STAGE(PG8_SB(1, 1), cB + hstep + kstep, voffB);
        PG8_WAIT_V(6); PG8_BAR;
    } else {
        PG8_STAGE(PG8_SB(0, 0), cB, voffB); PG8_STAGE(PG8_SA(0, 0), cA, voffA); PG8_STAGE(PG8_SB(0, 1), cB + hstep, voffB); PG8_STAGE(PG8_SA(0, 1), cA + hstep, voffA);
        if (wr == 1) PG8_BAR;
        PG8_WAIT_V(4); PG8_BAR;
        PG8_STAGE(PG8_SB(1, 0), cB + kstep, voffB); PG8_STAGE(PG8_SA(1, 0), cA + kstep, voffA); PG8_STAGE(PG8_SB(1, 1), cB + hstep + kstep, voffB);
        PG8_WAIT_V(6); PG8_BAR;
    }
    for (;;) {
        const bool has_next = S.next(ui + 1, nxt);
        const char* nA = has_next ? (const char*)g.A + (size_t)nxt.pm * tstep : cA; const char* nB = has_next ? (const char*)g.Bt + (size_t)nxt.pn * tstep : cB;
        for (int t = 0; t < nt; t += 2) {
            const bool last = (t == nt - 2);
            const char* a1 = cA + (size_t)(t + 1) * kstep;
            const char* a2 = last ? nA : cA + (size_t)(t + 2) * kstep; const char* b2 = last ? nB : cB + (size_t)(t + 2) * kstep;
            const char* a3 = a2 + kstep; const char* b3 = b2 + kstep;
            if (last && has_next) S.a_ready(nxt);
            if constexpr (SP2) {
            PG8_LDB(B0, 0, 0); PG8_LDB(B1, 0, 1); PG8_SCHED; PG8_LDA(At, 0, 0); PG8_STAGE(PG8_SA(1, 1), a1 + hstep, voffA);
            PG8_WAIT_V(8); PG8_WAIT_L(0); PG8_BAR; PG8_MMA(0, 0, At, B0); PG8_MMA(0, 1, At, B1); PG8_BAR; PG8_SCHED;
            PG8_LDA(At, 0, 1); PG8_STAGE(PG8_SB(0, 0), b2, voffB); PG8_STAGE(PG8_SB(0, 1), b2 + hstep, voffB); PG8_STAGE(PG8_SA(0, 0), a2, voffA);
            PG8_WAIT_V(8); PG8_WAIT_L(0); PG8_BAR; PG8_MMA(1, 0, At, B0); PG8_MMA(1, 1, At, B1); PG8_BAR; PG8_SCHED;
            PG8_LDB(B0, 1, 0); PG8_LDB(B1, 1, 1); PG8_SCHED; PG8_LDA(At, 1, 0); PG8_STAGE(PG8_SA(0, 1), a2 + hstep, voffA);
            PG8_WAIT_V(8); PG8_WAIT_L(0); PG8_BAR; PG8_MMA(0, 0, At, B0); PG8_MMA(0, 1, At, B1); PG8_BAR; PG8_SCHED;
            PG8_LDA(At, 1, 1); PG8_STAGE(PG8_SB(1, 0), b3, voffB); PG8_STAGE(PG8_SB(1, 1), b3 + hstep, voffB); PG8_STAGE(PG8_SA(1, 0), a3, voffA);
            PG8_WAIT_V(8); PG8_WAIT_L(0); PG8_BAR; PG8_MMA(1, 0, At, B0); PG8_MMA(1, 1, At, B1); PG8_BAR; PG8_SCHED;
            } else {
            PG8_LDB(B0, 0, 0); PG8_SCHED; PG8_LDA(At, 0, 0); PG8_STAGE(PG8_SA(1, 1), a1 + hstep, voffA);
            PG8_WAIT_L(8); PG8_BAR; PG8_WAIT_L(0); PG8_MMA(0, 0, At, B0); PG8_BAR; PG8_SCHED;
            PG8_LDB(B1, 0, 1); PG8_STAGE(PG8_SB(0, 0), b2, voffB);
            PG8_BAR; PG8_WAIT_L(0); PG8_MMA(0, 1, At, B1); PG8_BAR;
            PG8_LDA(At, 0, 1); PG8_STAGE(PG8_SA(0, 0), a2, voffA);
            PG8_BAR; PG8_WAIT_L(0); PG8_MMA(1, 0, At, B0); PG8_BAR; PG8_SCHED;
            PG8_STAGE(PG8_SB(0, 1), b2 + hstep, voffB);
            PG8_WAIT_V(6); PG8_BAR; PG8_MMA(1, 1, At, B1); PG8_BAR;
            PG8_LDB(B0, 1, 0); PG8_SCHED; PG8_LDA(At, 1, 0); PG8_STAGE(PG8_SA(0, 1), a2 + hstep, voffA);
            PG8_WAIT_L(8); PG8_BAR; PG8_WAIT_L(0); PG8_MMA(0, 0, At, B0); PG8_BAR; PG8_SCHED;
            PG8_LDB(B1, 1, 1); PG8_STAGE(PG8_SB(1, 0), b3, voffB);
            PG8_BAR; PG8_WAIT_L(0); PG8_MMA(0, 1, At, B1); PG8_BAR;
            PG8_LDA(At, 1, 1); PG8_STAGE(PG8_SA(1, 0), a3, voffA);
            PG8_BAR; PG8_WAIT_L(0); PG8_MMA(1, 0, At, B0); PG8_BAR; PG8_SCHED;
            PG8_STAGE(PG8_SB(1, 1), b3 + hstep, voffB);
            PG8_WAIT_V(6); PG8_BAR; PG8_MMA(1, 1, At, B1); PG8_BAR;
            }
        }
        if constexpr (ALIGN_EPI) { if (wr == 0) PG8_BAR; }
        if constexpr (!Epi::AFTER_DRAIN) { E(acc, cur, wr, wc, fr, fq); S.done(cur); }
        if (!has_next) break;
#pragma unroll
        for (int a = 0; a < 2; ++a)
#pragma unroll
            for (int b = 0; b < 2; ++b)
#pragma unroll
                for (int m = 0; m < 4; ++m)
#pragma unroll
                    for (int n = 0; n < 2; ++n) acc[a][b][m][n] = (f32x4){0.f, 0.f, 0.f, 0.f};
        cur = nxt; cA = nA; cB = nB; ++ui;
        if constexpr (ALIGN_EPI) { if (wr == 1) PG8_BAR; }
    }
    PG8_WAIT_V(0);
    if constexpr (!ALIGN_EPI) { if (wr == 0) PG8_BAR; }
    PG8_BAR;
    if constexpr (Epi::AFTER_DRAIN) { E.fused(acc, cur, wr, wc, fr, fq, lds, wid, lane); S.done(cur); }
#undef PG8_SA
#undef PG8_SB
#undef PG8_STAGE
#undef PG8_LDA
#undef PG8_LDB
#undef PG8_MMA
#undef PG8_WAIT_V
#undef PG8_WAIT_L
#undef PG8_BAR
#undef PG8_SCHED
}
}

#define LAS __attribute__((address_space(3)))
typedef unsigned short bf16;
typedef short bf16x8 __attribute__((ext_vector_type(8)));
typedef float f32x4 __attribute__((ext_vector_type(4)));
typedef float f32x16 __attribute__((ext_vector_type(16)));
typedef unsigned u32x4 __attribute__((ext_vector_type(4)));
typedef unsigned u32x2 __attribute__((ext_vector_type(2)));
typedef short v4i16_t __attribute__((ext_vector_type(4)));

constexpr int NWAVES = 8;
constexpr int MTOK = 32768, DM = 1024, SEQ = 4096, NCH = 64, FF = 4096;
constexpr int DIN_SRC = 2832;
constexpr int LDP = 3072;
constexpr int GQ = 0, GK = 192, GV = 384, GG = 768, GZ = 1152, CU = 1344, AQ = 1856, AK = 2240, AV = 2624, PEND = 3008;
constexpr int MIX_GLA = 0, MIX_CONV = 384, MIX_ATT = 640;
constexpr float EPS = 1e-6f;
constexpr float LOG2E = 1.4426950408889634f;

constexpr size_t MiB = 1u << 20;
constexpr size_t WS_CTL = 0;
constexpr size_t WS_W = 1 * MiB, W_LAYER = 24 * MiB, W_IN = 0, W_OUT = 6 * MiB, W_UP = 8 * MiB, W_DN = 16 * MiB;
constexpr size_t WS_HB = 49 * MiB;
constexpr size_t WS_PROJ = 113 * MiB;
constexpr size_t WS_MIX = 305 * MiB;
constexpr size_t WS_FF = 113 * MiB;
constexpr size_t WS_SS = 369 * MiB;
constexpr size_t WS_KVT = 371 * MiB;
constexpr size_t WS_DEC = 407 * MiB;
constexpr size_t WS_ST = 408 * MiB;
constexpr size_t WS_END = 427 * MiB;

constexpr int LDS_BYTES = 147456;

__device__ __forceinline__ unsigned cvtpk(float lo, float hi) { typedef float f2_t __attribute__((ext_vector_type(2))); typedef __bf16 b2_t __attribute__((ext_vector_type(2))); f2_t v = {lo, hi}; b2_t b = __builtin_convertvector(v, b2_t); return __builtin_bit_cast(unsigned, b); }
__device__ __forceinline__ float bflo(unsigned u) { return __uint_as_float(u << 16); }
__device__ __forceinline__ float bfhi(unsigned u) { return __uint_as_float(u & 0xffff0000u); }
__device__ __forceinline__ float bf2f(bf16 u) { return __uint_as_float((unsigned)u << 16); }
__device__ __forceinline__ float wave_sum(float v) {
#pragma unroll
    for (int o = 1; o < 64; o <<= 1) v += __shfl_xor(v, o);
    return v;
}
__device__ __forceinline__ int crow(int r, int hi) { return (r & 3) + 8 * (r >> 2) + 4 * hi; }
__device__ __forceinline__ v4i16_t trrd(LAS const unsigned char* p) { return __builtin_amdgcn_ds_read_tr16_b64_v4i16((LAS v4i16_t*)p); }
__device__ __forceinline__ bf16x8 cat8(v4i16_t a, v4i16_t b) { return (bf16x8){a[0], a[1], a[2], a[3], b[0], b[1], b[2], b[3]}; }
#define MFMA32(a, b, c) __builtin_amdgcn_mfma_f32_32x32x16_bf16((a), (b), (c), 0, 0, 0)
#define LDS_FENCE() asm volatile("s_waitcnt lgkmcnt(0)" ::: "memory")

struct Args { const float* in[16]; float* out; unsigned char* ws; };
typedef const Args __attribute__((address_space(4))) CArgs;
__device__ __forceinline__ void p0_store_tile(LAS float* scr, bf16* WT, int K, int dst_row0, int k0, int lane) {
    LDS_FENCE();
    const int c = lane & 7;
#pragma unroll
    for (int j = 0; j < 4; ++j) { const int n = (lane >> 3) + 8 * j; const LAS float* s = scr + (8 * c) * 33 + n;
        u32x4 o; o.x = cvtpk(s[0 * 33], s[1 * 33]); o.y = cvtpk(s[2 * 33], s[3 * 33]); o.z = cvtpk(s[4 * 33], s[5 * 33]); o.w = cvtpk(s[6 * 33], s[7 * 33]);
        *(u32x4*)(WT + (size_t)(dst_row0 + n) * K + k0 + 8 * c) = o; }
    LDS_FENCE();
}
__device__ __forceinline__ void p0_copy_item(const float* W, int ldw, int src0, const float* gain, LAS float* scr, int k0, int lane) {
#pragma unroll
    for (int i = 0; i < 32; ++i) { const int kk = 2 * i + (lane >> 5); const float g = gain ? gain[k0 + kk] : 1.f;
        scr[kk * 33 + (lane & 31)] = W[(size_t)(k0 + kk) * ldw + src0 + (lane & 31)] * g; }
}
__device__ __forceinline__ void p0_weights(CArgs* ka, LAS float* scr, int lo, int hi, int gw, int ngw, int lane) {
    constexpr int I_IN = 16 * 96, I_OUT = 16 * 32, I_UP = 16 * 128, I_DN = 64 * 32, I_L = I_IN + I_OUT + I_UP + I_DN;
    unsigned char* ws = ka->ws;
    for (int it = lo + gw; it < hi; it += ngw) {
        const int l = it / I_L; int r = it - l * I_L;
        unsigned char* wl = ws + WS_W + (size_t)l * W_LAYER;
        if (r < I_IN) {
            const int kb = r / 96, nb = r % 96, k0 = 64 * kb, n0 = 32 * nb;
            const float* W = ka->in[2] + (size_t)l * DM * DIN_SRC; const float* gain = ka->in[1] + l * DM;
            if (n0 < GZ) p0_copy_item(W, DIN_SRC, n0, gain, scr, k0, lane);
            else if (n0 < CU) {
                const float* wg = ka->in[3] + (size_t)l * 16 * 192; const int j = n0 - GZ + (lane & 31);
                float wgc[16];
#pragma unroll
                for (int q = 0; q < 16; ++q) wgc[q] = wg[q * 192 + j];
#pragma unroll 4
                for (int i = 0; i < 32; ++i) { const int kk = 2 * i + (lane >> 5); const f32x4* wr = (const f32x4*)(W + (size_t)(k0 + kk) * DIN_SRC + 1152); float s = 0.f;
#pragma unroll
                    for (int q = 0; q < 4; ++q) { const f32x4 wv = wr[q]; s += (wv[0] * wgc[4 * q] + wv[1] * wgc[4 * q + 1]) + (wv[2] * wgc[4 * q + 2] + wv[3] * wgc[4 * q + 3]); }
                    scr[kk * 33 + (lane & 31)] = s * gain[k0 + kk]; }
            }
            else if (n0 < PEND) p0_copy_item(W, DIN_SRC, n0 - CU + 1168, gain, scr, k0, lane);
            else {
#pragma unroll 8
                for (int i = 0; i < 32; ++i) scr[(2 * i + (lane >> 5)) * 33 + (lane & 31)] = 0.f;
            }
            p0_store_tile(scr, (bf16*)(wl + W_IN), DM, n0, k0, lane);
            continue;
        }
        r -= I_IN;
        if (r < I_OUT) { const int kb = r / 32, nb = r % 32; p0_copy_item(ka->in[11] + (size_t)l * DM * DM, DM, 32 * nb, kb < 6 ? ka->in[5] + l * 384 : nullptr, scr, 64 * kb, lane);     p0_store_tile(scr, (bf16*)(wl + W_OUT), DM, 32 * nb, 64 * kb, lane); continue; }
        r -= I_OUT;
        if (r < I_UP) { const int kb = r / 128, nb = r % 128; p0_copy_item(ka->in[13] + (size_t)l * DM * FF, FF, 32 * nb, ka->in[12] + l * DM, scr, 64 * kb, lane); p0_store_tile(scr, (bf16*)(wl + W_UP), DM, 32 * nb, 64 * kb, lane); continue; }
        r -= I_UP;
        { const int kb = r / 32, nb = r % 32; p0_copy_item(ka->in[14] + (size_t)l * FF * DM, DM, 32 * nb, nullptr, scr, 64 * kb, lane); p0_store_tile(scr, (bf16*)(wl + W_DN), FF, 32 * nb, 64 * kb, lane); }
    }
}
__device__ __forceinline__ void p0_rows(const float* x, bf16* hb, float* sspart, int gw, int ngw, int lane) {
    for (int m0 = gw; m0 < MTOK; m0 += 4 * ngw) {
        f32x4 v[4][4];
#pragma unroll
        for (int q = 0; q < 4; ++q) { int m = m0 + q * ngw; m = m < MTOK ? m : m0; const f32x4* xr = (const f32x4*)(x + (size_t)m * DM) + lane;
#pragma unroll
            for (int j = 0; j < 4; ++j) v[q][j] = xr[64 * j]; }
#pragma unroll
        for (int q = 0; q < 4; ++q) { const int m = m0 + q * ngw; if (m < MTOK) {
            float s = 0.f;
#pragma unroll
            for (int j = 0; j < 4; ++j) s += (v[q][j][0] * v[q][j][0] + v[q][j][1] * v[q][j][1]) + (v[q][j][2] * v[q][j][2] + v[q][j][3] * v[q][j][3]);
            s = wave_sum(s);
            u32x2* o = (u32x2*)(hb + (size_t)m * DM) + lane;
#pragma unroll
            for (int j = 0; j < 4; ++j) { u32x2 w; w.x = cvtpk(v[q][j][0], v[q][j][1]); w.y = cvtpk(v[q][j][2], v[q][j][3]); o[64 * j] = w; }
            if (lane < 16) sspart[(size_t)m * 16 + lane] = s * (1.0f / 16.0f); } }
    }
}
__device__ __forceinline__ void final_rows(float* out, const bf16* hb, const float* sspart, const float* g, int gw, int ngw, int lane) {
    f32x4 gv[4];
#pragma unroll
    for (int j = 0; j < 4; ++j) gv[j] = ((const f32x4*)g)[lane + 64 * j];
    for (int m0 = gw; m0 < MTOK; m0 += 4 * ngw) {
        u32x2 v[4][4]; float ps[4];
#pragma unroll
        for (int q = 0; q < 4; ++q) { int m = m0 + q * ngw; m = m < MTOK ? m : m0; const u32x2* xr = (const u32x2*)(hb + (size_t)m * DM) + lane;
            ps[q] = lane < 16 ? sspart[(size_t)m * 16 + lane] : 0.f;
#pragma unroll
            for (int j = 0; j < 4; ++j) v[q][j] = xr[64 * j]; }
#pragma unroll
        for (int q = 0; q < 4; ++q) { const int m = m0 + q * ngw; if (m < MTOK) {
            const float rs = __builtin_amdgcn_rsqf(wave_sum(ps[q]) * (1.0f / 1024.0f) + EPS);
            f32x4* xr = (f32x4*)(out + (size_t)m * DM) + lane;
#pragma unroll
            for (int j = 0; j < 4; ++j) { f32x4 o; o[0] = bflo(v[q][j].x); o[1] = bfhi(v[q][j].x); o[2] = bflo(v[q][j].y); o[3] = bfhi(v[q][j].y); xr[64 * j] = o * rs * gv[j]; } } }
    }
}

__device__ __forceinline__ void conv_item(const bf16* proj, const float* wdw, const float* bdw, const float* lng, const float* lnb, bf16* mixed, LAS unsigned char* lds, int bc, int tid, int wave, int lane) {
    asm volatile("" : "+v"(lane), "+v"(tid));
    const int c = bc & 63; const size_t tokb = (size_t)(bc >> 6) * SEQ; const int t0 = c * 64;
    LAS float* gl = (LAS float*)lds;
    const int c4 = lane * 4;
    f32x4 wr[31];
#pragma unroll
    for (int j = 0; j < 31; ++j) wr[j] = *(const f32x4*)(wdw + j * 256 + c4);
    const f32x4 bias = *(const f32x4*)(bdw + c4);
    const f32x4 g = *(const f32x4*)(lng + c4), be = *(const f32x4*)(lnb + c4);
    {
        u32x2 av[12], gv[12];
#pragma unroll
        for (int ii = 0; ii < 12; ++ii) { const int idx = tid + ii * 512, row = idx >> 6, c4 = (idx & 63) * 4; int t = t0 - 30 + row; t = t < 0 ? 0 : (row > 93 ? t0 : t);
            const bf16* p = proj + (tokb + t) * LDP + CU + c4; av[ii] = *(const u32x2*)p; gv[ii] = *(const u32x2*)(p + 256); }
#pragma unroll
        for (int ii = 0; ii < 12; ++ii) { const int idx = tid + ii * 512, row = idx >> 6, c4 = (idx & 63) * 4, t = t0 - 30 + row;
            const u32x2 a = av[ii], g = gv[ii];
            const float a0 = bflo(a.x), a1 = bfhi(a.x), a2 = bflo(a.y), a3 = bfhi(a.y), g0 = bflo(g.x), g1 = bfhi(g.x), g2 = bflo(g.y), g3 = bfhi(g.y);
            f32x4 v; v[0] = a0 / (1.f + __expf(-g0)); v[1] = a1 / (1.f + __expf(-g1)); v[2] = a2 / (1.f + __expf(-g2)); v[3] = a3 / (1.f + __expf(-g3));
            if (t < 0) v = (f32x4){0.f, 0.f, 0.f, 0.f};
            if (row < 94) *(LAS f32x4*)(gl + row * 256 + c4) = v; }
    }
    __syncthreads();
#pragma nounroll
    for (int tq = 0; tq < 2; ++tq) {
        f32x4 acc[4];
#pragma unroll
        for (int to = 0; to < 4; ++to) acc[to] = bias;
        const LAS float* gp = gl + (8 * wave + 4 * tq) * 256 + c4;
#pragma unroll
        for (int rin = 0; rin < 34; ++rin) { const f32x4 x = *(const LAS f32x4*)(gp + rin * 256);
#pragma unroll
            for (int to = 0; to < 4; ++to) { const int j = rin - to; if (j >= 0 && j <= 30) acc[to] += wr[j] * x; }
            if ((rin & 7) == 7) asm volatile("" ::: "memory"); }
#pragma unroll
        for (int to = 0; to < 4; ++to) {
            const f32x4 a = acc[to]; const float mean = wave_sum((a[0] + a[1]) + (a[2] + a[3])) * (1.0f / 256.0f);
            const f32x4 d = a - mean; const float var = wave_sum((d[0] * d[0] + d[1] * d[1]) + (d[2] * d[2] + d[3] * d[3])) * (1.0f / 256.0f);
            const float rs = __builtin_amdgcn_rsqf(var + EPS);
            f32x4 y = d * rs * g + be;
#pragma unroll
            for (int e = 0; e < 4; ++e) y[e] = y[e] / (1.f + __expf(-y[e]));
            u32x2 w; w.x = cvtpk(y[0], y[1]); w.y = cvtpk(y[2], y[3]);
            *(u32x2*)(mixed + (tokb + t0 + 8 * wave + 4 * tq + to) * DM + MIX_CONV + c4) = w;
        }
    }
    __syncthreads();
}

#define GLDS16(gp, lp) __builtin_amdgcn_global_load_lds((const unsigned*)(gp), (LAS unsigned*)(lp), 16, 0, 0)
__device__ __forceinline__ void attn_unit(const bf16* proj, bf16* mixed, const LAS float* biasT, LAS unsigned char* vimg, int u, int lane) {
    asm volatile("" : "+v"(lane));
    const int half = u & 1; int t = u >> 1; const int h = t % 6; t /= 6; const int c = t & 63;
    const int r32 = lane & 31, hi = lane >> 5;
    const size_t tok0 = (size_t)t * 64;
    const int iq = 32 * half + r32;
    const bf16* qp = proj + (tok0 + iq) * LDP + AQ + h * 64 + 8 * hi;
    bf16x8 qf[4];
#pragma unroll
    for (int ks = 0; ks < 4; ++ks) qf[ks] = *(const bf16x8*)(qp + 16 * ks);
    float mrun = -1e30f, lrun = 0.f; f32x16 o0, o1;
#pragma unroll
    for (int r = 0; r < 16; ++r) { o0[r] = 0.f; o1[r] = 0.f; }
    const LAS float* bh = biasT + h * 260;
    const unsigned trb = ((lane >> 4) & 1) * 32 + (lane & 3) * 8 + (4 * hi + ((lane & 15) >> 2)) * 64;
    const float C2 = 0.125f * LOG2E;
    const int w0 = (c < 8 ? 8 - c : 0);
    const unsigned koff = (unsigned)r32 * LDP + 8u * hi;
    const unsigned vdoff = (unsigned)(8 * (lane >> 5) + ((lane & 31) >> 2)) * LDP + 8u * (lane & 3);
    bf16x8 kf[2][4];
    { const bf16* kt = proj + (tok0 - (size_t)(8 - w0) * 64) * LDP + AK + h * 64; const bf16* vt = kt + (AV - AK);
#pragma unroll
      for (int kb = 0; kb < 2; ++kb)
#pragma unroll
          for (int ks = 0; ks < 4; ++ks) kf[kb][ks] = *(const bf16x8*)(kt + (koff + (unsigned)(kb * 32 * LDP + 16 * ks)));
#pragma unroll
      for (int p = 0; p < 8; ++p) GLDS16(vt + (vdoff + (unsigned)((16 * (p & 3)) * LDP + 32 * (p >> 2))), vimg + p * 1024);
      asm volatile("" ::: "memory"); }
    int buf = 0;
    for (int w = w0; w <= 8; ++w) {
        bf16x8 kn[2][4];
        { const int wn = w < 8 ? w + 1 : 8;
          const bf16* kt = proj + (tok0 - (size_t)(8 - wn) * 64) * LDP + AK + h * 64; const bf16* vt = kt + (AV - AK);
          LAS unsigned char* vb = vimg + (buf ^ 1) * 8192;
          LDS_FENCE();
#pragma unroll
          for (int kb = 0; kb < 2; ++kb)
#pragma unroll
              for (int ks = 0; ks < 4; ++ks) kn[kb][ks] = *(const bf16x8*)(kt + (koff + (unsigned)(kb * 32 * LDP + 16 * ks)));
#pragma unroll
          for (int p = 0; p < 8; ++p) GLDS16(vt + (vdoff + (unsigned)((16 * (p & 3)) * LDP + 32 * (p >> 2))), vb + p * 1024);
          asm volatile("" ::: "memory"); }
        f32x16 s0, s1;
#pragma unroll
        for (int r = 0; r < 16; ++r) { s0[r] = 0.f; s1[r] = 0.f; }
#pragma unroll
        for (int ks = 0; ks < 4; ++ks) { s0 = MFMA32(kf[0][ks], qf[ks], s0); s1 = MFMA32(kf[1][ks], qf[ks], s1); }
        const int relb = (8 - w) * 64 + iq;
        float tm = -1e30f;
        if (w <= 5) {
            const float bc = bh[256];
#pragma unroll
            for (int r = 0; r < 16; ++r) { s0[r] = s0[r] * C2 + bc; s1[r] = s1[r] * C2 + bc; tm = fmaxf(tm, fmaxf(s0[r], s1[r])); }
        } else {
            float bv0[16], bv1[16];
#pragma unroll
            for (int r = 0; r < 16; ++r) { const int j0 = crow(r, hi); int i0 = relb - j0, i1 = relb - j0 - 32; i0 = (i0 > 128 ? 128 : i0) + 128; i1 = (i1 > 128 ? 128 : i1) + 128;
                bv0[r] = bh[i0]; bv1[r] = bh[i1]; }
            LDS_FENCE();
#pragma unroll
            for (int r = 0; r < 16; ++r) { s0[r] = s0[r] * C2 + bv0[r]; s1[r] = s1[r] * C2 + bv1[r]; tm = fmaxf(tm, fmaxf(s0[r], s1[r])); }
        }
        tm = fmaxf(tm, __shfl_xor(tm, 32));
        const float mn = fmaxf(mrun, tm); const float sc = __builtin_amdgcn_exp2f(mrun - mn); mrun = mn;
        float ps = 0.f;
#pragma unroll
        for (int r = 0; r < 16; ++r) { s0[r] = __builtin_amdgcn_exp2f(s0[r] - mn); s1[r] = __builtin_amdgcn_exp2f(s1[r] - mn); ps += s0[r] + s1[r]; o0[r] *= sc; o1[r] *= sc; }
        lrun = lrun * sc + ps;
        bf16x8 pf[2][2];
#pragma unroll
        for (int s2 = 0; s2 < 2; ++s2) {
            u32x4 a, b;
            a.x = cvtpk(s0[8 * s2 + 0], s0[8 * s2 + 1]); a.y = cvtpk(s0[8 * s2 + 2], s0[8 * s2 + 3]); a.z = cvtpk(s0[8 * s2 + 4], s0[8 * s2 + 5]); a.w = cvtpk(s0[8 * s2 + 6], s0[8 * s2 + 7]);
            b.x = cvtpk(s1[8 * s2 + 0], s1[8 * s2 + 1]); b.y = cvtpk(s1[8 * s2 + 2], s1[8 * s2 + 3]); b.z = cvtpk(s1[8 * s2 + 4], s1[8 * s2 + 5]); b.w = cvtpk(s1[8 * s2 + 6], s1[8 * s2 + 7]);
            pf[0][s2] = __builtin_bit_cast(bf16x8, a); pf[1][s2] = __builtin_bit_cast(bf16x8, b);
        }
        asm volatile("s_waitcnt vmcnt(16)" ::: "memory");
        const LAS unsigned char* vc = vimg + buf * 8192;
#pragma unroll
        for (int kb = 0; kb < 2; ++kb)
#pragma unroll
            for (int s2 = 0; s2 < 2; ++s2) {
                const unsigned off = (4 * kb + 2 * s2) * 512 + trb;
                const bf16x8 v0 = cat8(trrd(vc + off), trrd(vc + off + 512));
                const bf16x8 v1 = cat8(trrd(vc + 4096 + off), trrd(vc + 4096 + off + 512));
                o0 = MFMA32(v0, pf[kb][s2], o0); o1 = MFMA32(v1, pf[kb][s2], o1);
            }
#pragma unroll
        for (int kb = 0; kb < 2; ++kb)
#pragma unroll
            for (int ks = 0; ks < 4; ++ks) kf[kb][ks] = kn[kb][ks];
        buf ^= 1;
    }
    lrun += __shfl_xor(lrun, 32);
    const float inv = 1.0f / lrun;
    bf16* op = mixed + (tok0 + iq) * DM + MIX_ATT + h * 64 + 4 * hi;
#pragma unroll
    for (int rg = 0; rg < 4; ++rg) {
        u32x2 w0v, w1v;
        w0v.x = cvtpk(o0[4 * rg] * inv, o0[4 * rg + 1] * inv); w0v.y = cvtpk(o0[4 * rg + 2] * inv, o0[4 * rg + 3] * inv);
        w1v.x = cvtpk(o1[4 * rg] * inv, o1[4 * rg + 1] * inv); w1v.y = cvtpk(o1[4 * rg + 2] * inv, o1[4 * rg + 3] * inv);
        *(u32x2*)(op + 8 * rg) = w0v; *(u32x2*)(op + 32 + 8 * rg) = w1v;
    }
    asm volatile("s_waitcnt vmcnt(0) lgkmcnt(0)" ::: "memory");
}

__device__ __forceinline__ void attn_block_unit(const bf16* proj, bf16* mixed, const LAS float* biasT, LAS unsigned char* ring, int u, int wave, int lane) {
    asm volatile("" : "+v"(lane));
    const int h = u % 6; const int bg = u / 6; const int g = bg & 15, b = bg >> 4;
    const int qc = wave >> 1, half = wave & 1;
    const int r32 = lane & 31, hi = lane >> 5;
    const size_t tokg = (size_t)b * SEQ + (size_t)g * 256;
    const int tlo = (g < 2) ? 8 - 4 * g : 0;
    const int ntile = 12 - tlo;
    const unsigned kdo = (unsigned)(32 * (wave >> 2) + r32) * LDP + 16u * (wave & 3) + 8u * hi;
    const unsigned vdo = (unsigned)(16 * (wave & 3) + 8 * hi + (r32 >> 2)) * LDP + 32u * (wave >> 2) + 8u * (lane & 3) + (unsigned)(AV - AK);
#define ATT_ISSUE(t_, st_) do { const bf16* kt_ = proj + (tokg + (size_t)(t_) * 64 - 512) * LDP + AK + h * 64; \
        GLDS16(kt_ + kdo, ring + (st_) * 16384 + wave * 1024); GLDS16(kt_ + vdo, ring + (st_) * 16384 + 8192 + wave * 1024); } while (0)
    const int iq = 32 * half + r32;
    const bf16* qp = proj + (tokg + qc * 64 + iq) * LDP + AQ + h * 64 + 8 * hi;
    bf16x8 qf[4];
#pragma unroll
    for (int ks = 0; ks < 4; ++ks) qf[ks] = *(const bf16x8*)(qp + 16 * ks);
    asm volatile("" ::: "memory");
    ATT_ISSUE(tlo, 0); ATT_ISSUE(tlo + 1, 1); ATT_ISSUE(tlo + 2, 2);
    asm volatile("" ::: "memory");
    float mrun = -1e30f, lrun = 0.f; f32x16 o0, o1;
#pragma unroll
    for (int r = 0; r < 16; ++r) { o0[r] = 0.f; o1[r] = 0.f; }
    const LAS float* bh = biasT + h * 260;
    const unsigned trb = ((lane >> 4) & 1) * 32 + (lane & 3) * 8 + (4 * hi + ((lane & 15) >> 2)) * 64;
    const float C2 = 0.125f * LOG2E;
    for (int j = 0; j < ntile; ++j) {
        const int left = ntile - 1 - j;
        if (left >= 2) asm volatile("s_waitcnt vmcnt(4) lgkmcnt(0)\n\ts_barrier" ::: "memory");
        else if (left == 1) asm volatile("s_waitcnt vmcnt(2) lgkmcnt(0)\n\ts_barrier" ::: "memory");
        else asm volatile("s_waitcnt vmcnt(0) lgkmcnt(0)\n\ts_barrier" ::: "memory");
        if (j + 3 < ntile) { ATT_ISSUE(tlo + j + 3, (j + 3) & 3); }
        asm volatile("" ::: "memory");
        const int w = tlo + j - qc;
        if (w >= 0 && w <= 8) {
            const LAS unsigned char* kc = ring + (j & 3) * 16384; const LAS unsigned char* vc = kc + 8192;
            bf16x8 kf[2][4];
#pragma unroll
            for (int kb = 0; kb < 2; ++kb)
#pragma unroll
                for (int ks = 0; ks < 4; ++ks) kf[kb][ks] = *(const LAS bf16x8*)(kc + (kb * 4 + ks) * 1024 + 16 * lane);
            f32x16 s0, s1;
#pragma unroll
            for (int r = 0; r < 16; ++r) { s0[r] = 0.f; s1[r] = 0.f; }
#pragma unroll
            for (int ks = 0; ks < 4; ++ks) { s0 = MFMA32(kf[0][ks], qf[ks], s0); s1 = MFMA32(kf[1][ks], qf[ks], s1); }
            const int relb = (8 - w) * 64 + iq;
            float tm = -1e30f;
            if (w <= 5) {
                const float bc = bh[256];
#pragma unroll
                for (int r = 0; r < 16; ++r) { s0[r] = s0[r] * C2 + bc; s1[r] = s1[r] * C2 + bc; tm = fmaxf(tm, fmaxf(s0[r], s1[r])); }
            } else {
                float bv0[16], bv1[16];
#pragma unroll
                for (int r = 0; r < 16; ++r) { const int j0 = crow(r, hi); int i0 = relb - j0, i1 = relb - j0 - 32; i0 = (i0 > 128 ? 128 : i0) + 128; i1 = (i1 > 128 ? 128 : i1) + 128;
                    bv0[r] = bh[i0]; bv1[r] = bh[i1]; }
#pragma unroll
                for (int r = 0; r < 16; ++r) { s0[r] = s0[r] * C2 + bv0[r]; s1[r] = s1[r] * C2 + bv1[r]; tm = fmaxf(tm, fmaxf(s0[r], s1[r])); }
            }
            tm = fmaxf(tm, __shfl_xor(tm, 32));
            const float mn = fmaxf(mrun, tm); const float sc = __builtin_amdgcn_exp2f(mrun - mn); mrun = mn;
            float ps = 0.f;
#pragma unroll
            for (int r = 0; r < 16; ++r) { s0[r] = __builtin_amdgcn_exp2f(s0[r] - mn); s1[r] = __builtin_amdgcn_exp2f(s1[r] - mn); ps += s0[r] + s1[r]; o0[r] *= sc; o1[r] *= sc; }
            lrun = lrun * sc + ps;
            bf16x8 pf[2][2];
#pragma unroll
            for (int s2 = 0; s2 < 2; ++s2) {
                u32x4 a, bb;
                a.x = cvtpk(s0[8 * s2 + 0], s0[8 * s2 + 1]); a.y = cvtpk(s0[8 * s2 + 2], s0[8 * s2 + 3]); a.z = cvtpk(s0[8 * s2 + 4], s0[8 * s2 + 5]); a.w = cvtpk(s0[8 * s2 + 6], s0[8 * s2 + 7]);
                bb.x = cvtpk(s1[8 * s2 + 0], s1[8 * s2 + 1]); bb.y = cvtpk(s1[8 * s2 + 2], s1[8 * s2 + 3]); bb.z = cvtpk(s1[8 * s2 + 4], s1[8 * s2 + 5]); bb.w = cvtpk(s1[8 * s2 + 6], s1[8 * s2 + 7]);
                pf[0][s2] = __builtin_bit_cast(bf16x8, a); pf[1][s2] = __builtin_bit_cast(bf16x8, bb);
            }
#pragma unroll
            for (int kb = 0; kb < 2; ++kb)
#pragma unroll
                for (int s2 = 0; s2 < 2; ++s2) {
                    const unsigned off = (4 * kb + 2 * s2) * 512 + trb;
                    const bf16x8 v0 = cat8(trrd(vc + off), trrd(vc + off + 512));
                    const bf16x8 v1 = cat8(trrd(vc + 4096 + off), trrd(vc + 4096 + off + 512));
                    o0 = MFMA32(v0, pf[kb][s2], o0); o1 = MFMA32(v1, pf[kb][s2], o1);
                }
        }
    }
#undef ATT_ISSUE
    lrun += __shfl_xor(lrun, 32);
    const float inv = 1.0f / lrun;
    bf16* op = mixed + (tokg + qc * 64 + iq) * DM + MIX_ATT + h * 64 + 4 * hi;
#pragma unroll
    for (int rg = 0; rg < 4; ++rg) {
        u32x2 w0v, w1v;
        w0v.x = cvtpk(o0[4 * rg] * inv, o0[4 * rg + 1] * inv); w0v.y = cvtpk(o0[4 * rg + 2] * inv, o0[4 * rg + 3] * inv);
        w1v.x = cvtpk(o1[4 * rg] * inv, o1[4 * rg + 1] * inv); w1v.y = cvtpk(o1[4 * rg + 2] * inv, o1[4 * rg + 3] * inv);
        *(u32x2*)(op + 8 * rg) = w0v; *(u32x2*)(op + 32 + 8 * rg) = w1v;
    }
    asm volatile("s_waitcnt lgkmcnt(0)\n\ts_barrier" ::: "memory");
}

__device__ __forceinline__ void gla_kv_item(const bf16* proj, const float* bgate, float* kvT, float* decay, LAS unsigned char* vimg, int it, int lane) {
    asm volatile("" : "+v"(lane));
    const int h = it & 3; const size_t tok0 = (size_t)(it >> 2) * 64;
    const int r32 = lane & 31, hi = lane >> 5;
    LDS_FENCE();
    {
        const int kc = lane < 48 ? lane : 47;
        const bf16* zp = proj + tok0 * LDP + GZ + h * 48 + kc; const bf16* kp = proj + tok0 * LDP + GK + h * 48 + kc;
        const float bz = bgate[h * 48 + kc];
        float suf = 0.f;
#pragma unroll 32
        for (int t = 63; t >= 0; --t) {
            const float z = bf2f(zp[(size_t)t * LDP]) + bz, kk = bf2f(kp[(size_t)t * LDP]);
            const float la = (fminf(z, 0.f) - __logf(1.f + __expf(-fabsf(z)))) * (1.0f / 16.0f);
            const float kd = kk * __expf(suf); suf += la;
            if (lane < 48) *(LAS bf16*)(vimg + kc * 144 + t * 2) = (bf16)(cvtpk(kd, 0.f) & 0xffffu);
        }
        if (lane < 48) decay[(size_t)it * 48 + kc] = __expf(suf);
    }
    LDS_FENCE();
    bf16x8 kfr[2][4];
#pragma unroll
    for (int kb = 0; kb < 2; ++kb)
#pragma unroll
        for (int s = 0; s < 4; ++s) { const int kc = 32 * kb + r32; const int kcc = kc < 48 ? kc : 47;
            u32x4 a = *(const LAS u32x4*)(vimg + kcc * 144 + (16 * s + 8 * hi) * 2);
            if (kc >= 48) a = (u32x4){0u, 0u, 0u, 0u};
            kfr[kb][s] = __builtin_bit_cast(bf16x8, a); }
    LDS_FENCE();
#pragma unroll
    for (int i = 0; i < 12; ++i) { const int id = i * 64 + lane, t = id / 12, ch = id - 12 * t;
        const u32x4 val = *(const u32x4*)(proj + (tok0 + t) * LDP + GV + h * 96 + 8 * ch);
        *(LAS u32x4*)(vimg + (ch >> 2) * 4096 + (t >> 3) * 512 + (t & 7) * 64 + (ch & 3) * 16) = val; }
    f32x16 acc[3][2];
#pragma unroll
    for (int vb = 0; vb < 3; ++vb)
#pragma unroll
        for (int kb = 0; kb < 2; ++kb)
#pragma unroll
            for (int r = 0; r < 16; ++r) acc[vb][kb][r] = 0.f;
    LDS_FENCE();
    const unsigned trb = ((lane >> 4) & 1) * 32 + (lane & 3) * 8 + ((lane & 15) >> 2) * 64 + hi * 512;
#pragma unroll
    for (int s = 0; s < 4; ++s)
#pragma unroll
        for (int vb = 0; vb < 3; ++vb) { const unsigned off = vb * 4096 + (2 * s) * 512 + trb;
            const bf16x8 vf = cat8(trrd(vimg + off), trrd(vimg + off + 256));
            acc[vb][0] = MFMA32(vf, kfr[0][s], acc[vb][0]); acc[vb][1] = MFMA32(vf, kfr[1][s], acc[vb][1]); }
    float* dst = kvT + (size_t)it * 4608;
#pragma unroll
    for (int vb = 0; vb < 3; ++vb)
#pragma unroll
        for (int r = 0; r < 16; ++r) { const int v = 32 * vb + crow(r, hi);
            dst[v * 48 + r32] = acc[vb][0][r];
            if (r32 < 16) dst[v * 48 + 32 + r32] = acc[vb][1][r]; }
    LDS_FENCE();
}
__device__ __forceinline__ void gla_scan(const float* kvT, const float* decay, bf16* St, int gtid, int nthr) {
    for (int e = gtid; e < 32 * 4608; e += nthr) {
        const int bh = e / 4608, rem = e - bh * 4608, k = rem % 48, b = bh >> 2, h = bh & 3;
        float st = 0.f;
#pragma nounroll
        for (int c0 = 0; c0 < 64; c0 += 16) {
            float kv[16], dc[16];
#pragma unroll
            for (int j = 0; j < 16; ++j) { const size_t it = (size_t)(((b * 64 + c0 + j) << 2) + h); kv[j] = kvT[it * 4608 + rem]; dc[j] = decay[it * 48 + k]; }
#pragma unroll
            for (int j = 0; j < 16; ++j) { const size_t it = (size_t)(((b * 64 + c0 + j) << 2) + h); st = dc[j] * st + kv[j]; St[it * 4608 + rem] = (bf16)(cvtpk(st, 0.f) & 0xffffu); }
        }
    }
}
__device__ __forceinline__ void gla_out_item(const bf16* proj, const bf16* St, bf16* mixed, int it, int lane) {
    asm volatile("" : "+v"(lane));
    const int h = it & 3; const size_t tok0 = (size_t)(it >> 2) * 64;
    const int r32 = lane & 31, hi = lane >> 5;
    bf16x8 af[3][3], bq[2][3]; u32x2 gg[2][3][4];
#pragma unroll
    for (int vb = 0; vb < 3; ++vb)
#pragma unroll
        for (int ks = 0; ks < 3; ++ks) af[vb][ks] = *(const bf16x8*)(St + (size_t)it * 4608 + (32 * vb + r32) * 48 + 16 * ks + 8 * hi);
#pragma unroll
    for (int tb = 0; tb < 2; ++tb)
#pragma unroll
        for (int ks = 0; ks < 3; ++ks) bq[tb][ks] = *(const bf16x8*)(proj + (tok0 + 32 * tb + r32) * LDP + GQ + h * 48 + 16 * ks + 8 * hi);
#pragma unroll
    for (int tb = 0; tb < 2; ++tb)
#pragma unroll
        for (int vb = 0; vb < 3; ++vb)
#pragma unroll
            for (int rg = 0; rg < 4; ++rg) gg[tb][vb][rg] = *(const u32x2*)(proj + (tok0 + 32 * tb + r32) * LDP + GG + h * 96 + 32 * vb + 8 * rg + 4 * hi);
    f32x16 acc[3][2];
#pragma unroll
    for (int vb = 0; vb < 3; ++vb)
#pragma unroll
        for (int tb = 0; tb < 2; ++tb)
#pragma unroll
            for (int r = 0; r < 16; ++r) acc[vb][tb][r] = 0.f;
#pragma unroll
    for (int ks = 0; ks < 3; ++ks)
#pragma unroll
        for (int vb = 0; vb < 3; ++vb)
#pragma unroll
            for (int tb = 0; tb < 2; ++tb) acc[vb][tb] = MFMA32(af[vb][ks], bq[tb][ks], acc[vb][tb]);
    const float QS = 0.14433756729740643f;
#pragma unroll
    for (int tb = 0; tb < 2; ++tb) {
        float ss = 0.f;
#pragma unroll
        for (int vb = 0; vb < 3; ++vb)
#pragma unroll
            for (int r = 0; r < 16; ++r) { const float x = acc[vb][tb][r] * QS; acc[vb][tb][r] = x; ss += x * x; }
        ss += __shfl_xor(ss, 32);
        const float rn = __builtin_amdgcn_rsqf(ss * (1.0f / 96.0f) + EPS);
        const size_t tok = tok0 + 32 * tb + r32;
#pragma unroll
        for (int vb = 0; vb < 3; ++vb)
#pragma unroll
            for (int rg = 0; rg < 4; ++rg) { const int v0 = 32 * vb + 8 * rg + 4 * hi; const u32x2 g = gg[tb][vb][rg];
                const float g0 = bflo(g.x), g1 = bfhi(g.x), g2 = bflo(g.y), g3 = bfhi(g.y);
                const float y0 = acc[vb][tb][4 * rg + 0] * rn * (g0 / (1.f + __expf(-g0)));
                const float y1 = acc[vb][tb][4 * rg + 1] * rn * (g1 / (1.f + __expf(-g1)));
                const float y2 = acc[vb][tb][4 * rg + 2] * rn * (g2 / (1.f + __expf(-g2)));
                const float y3 = acc[vb][tb][4 * rg + 3] * rn * (g3 / (1.f + __expf(-g3)));
                u32x2 w; w.x = cvtpk(y0, y1); w.y = cvtpk(y2, y3);
                *(u32x2*)(mixed + tok * DM + MIX_GLA + h * 96 + v0) = w; }
    }
}
#define XB_TMO      128
#define XB_XCNT(j)  (256  + 64 * (j))
#define XB_XSUB(j)  (1280 + 64 * (j))
#define XB_XGEN(j)  (2304 + 64 * (j))
#define XB_TOP      3328
#define XB_TOPGEN   3392
#define XCD_BAR_WORDS 3456
#define XB_SPIN_CAP (1u << 18)

__device__ __forceinline__ unsigned xb_ld(unsigned* p)              { return __hip_atomic_load(p, __ATOMIC_RELAXED, __HIP_MEMORY_SCOPE_AGENT); }
__device__ __forceinline__ unsigned xb_add(unsigned* p, unsigned v) { return __hip_atomic_fetch_add(p, v, __ATOMIC_RELAXED, __HIP_MEMORY_SCOPE_AGENT); }
__device__ __forceinline__ unsigned xb_xcc_id() { return (unsigned)__builtin_amdgcn_s_getreg((3 << 11) | 20) & 0xFu; }
#define XB_SPIN(cond, bar) do { unsigned _sp = 0; while (cond) { __builtin_amdgcn_s_sleep(1); \
    if ((++_sp & 255u) == 0u) { if (xb_ld(&(bar)[XB_TMO])) break; if (_sp > XB_SPIN_CAP) { atomicAdd(&(bar)[XB_TMO], 1u); break; } } } } while (0)

struct XcdBarrier {
    unsigned* bar; unsigned x;
    volatile LAS unsigned* st;
};

__device__ __forceinline__ XcdBarrier xcd_barrier_post(unsigned* bar, volatile LAS unsigned* st) {
    XcdBarrier b; b.bar = bar; b.x = xb_xcc_id(); b.st = st;
    if (threadIdx.x == 0) (void)xb_add(&bar[XB_XCNT(b.x)], 1u);
    return b;
}
__device__ __forceinline__ void xcd_barrier_complete(unsigned* bar, unsigned x, unsigned& nloc, unsigned& nx) {
    const unsigned G = gridDim.x * gridDim.y * gridDim.z;
    unsigned sum, cnt, mine, sp = 0u;
    for (;;) {
        sum = 0u; cnt = 0u; mine = 0u;
#pragma unroll
        for (unsigned j = 0; j < 16; ++j) { const unsigned c = xb_ld(&bar[XB_XCNT(j)]); sum += c; cnt += (c > 0u) ? 1u : 0u; mine = (j == x) ? c : mine; }
        if (sum == G) break;
        __builtin_amdgcn_s_sleep(1);
        if ((++sp & 255u) == 0u) { if (xb_ld(&bar[XB_TMO])) break; if (sp > XB_SPIN_CAP) { atomicAdd(&bar[XB_TMO], 1u); break; } }
    }
    nloc = mine > 0u ? mine : 1u; nx = cnt > 0u ? cnt : 1u;
}

__device__ __forceinline__ void xcd_barrier(const XcdBarrier& b) {
    asm volatile("s_waitcnt vmcnt(0)" ::: "memory");
    __syncthreads();
    if (threadIdx.x == 0) {
        unsigned* bar = b.bar;
        __builtin_amdgcn_s_waitcnt(0);
        unsigned nloc = b.st[0], nx = b.st[1];
        if (nloc == 0u) { xcd_barrier_complete(bar, b.x, nloc, nx); b.st[0] = nloc; b.st[1] = nx; }
        const unsigned old = xb_add(&bar[XB_XSUB(b.x)], 1u);
        const unsigned gen = old / nloc;
        if (old + 1u == (gen + 1u) * nloc) {
            __builtin_amdgcn_fence(__ATOMIC_RELEASE, "agent");
            asm volatile("s_waitcnt vmcnt(0)" ::: "memory");
            const unsigned og = xb_add(&bar[XB_TOP], 1u);
            const unsigned tg = og / nx;
            if (og + 1u == (tg + 1u) * nx) xb_add(&bar[XB_TOPGEN], 1u);
            else XB_SPIN(xb_ld(&bar[XB_TOPGEN]) == tg, bar);
            __builtin_amdgcn_fence(__ATOMIC_ACQUIRE, "agent");
            xb_add(&bar[XB_XGEN(b.x)], 1u);
            asm volatile("s_waitcnt vmcnt(0)" ::: "memory");
        } else {
            XB_SPIN(xb_ld(&bar[XB_XGEN(b.x)]) == gen, bar);
            __builtin_amdgcn_fence(__ATOMIC_ACQUIRE, "agent");
            asm volatile("s_waitcnt vmcnt(0)" ::: "memory");
        }
    }
    __syncthreads();
}

#define KARGS() ({ CArgs* p_ = (CArgs*)__builtin_amdgcn_kernarg_segment_ptr(); size_t z_ = 0; asm volatile("" : "+s"(z_)); p_ + z_; })

__global__ void __launch_bounds__(NWAVES * 64, 2) mega_fwd(Args a) {
    extern __shared__ __attribute__((aligned(16))) unsigned char lds_raw[];
    cg::grid_group grid = cg::this_grid();
    LAS unsigned char* lds = (LAS unsigned char*)lds_raw;
    const int tid = threadIdx.x, lane = tid & 63, wave = __builtin_amdgcn_readfirstlane(tid >> 6);
    const int G = gridDim.x, bx = blockIdx.x;
    const int gw = bx * NWAVES + wave, ngw = G * NWAVES;
    unsigned char* ws = a.ws;
    bf16* hb = (bf16*)(ws + WS_HB); bf16* proj = (bf16*)(ws + WS_PROJ); bf16* mixed = (bf16*)(ws + WS_MIX); bf16* ffb = (bf16*)(ws + WS_FF);
    float* sspart = (float*)(ws + WS_SS); float* kvT = (float*)(ws + WS_KVT); float* decay = (float*)(ws + WS_DEC); bf16* St = (bf16*)(ws + WS_ST);
    float* out = a.out;
#if USE_XCD
    volatile LAS unsigned* MISC = (volatile LAS unsigned*)(lds + 143360);
    if (tid < 32) MISC[tid] = 0u;
    __syncthreads();
    XcdBarrier bar = xcd_barrier_post((unsigned*)(ws + WS_CTL) + 4096, MISC + 8);
#define GSYNC() xcd_barrier(bar)
#else
#define GSYNC() do { __threadfence(); grid.sync(); } while (0)
#endif

#ifndef REP_P0
#define REP_P0 1
#endif
#ifndef REP_B1
#define REP_B1 1
#endif
#ifndef REP_B23
#define REP_B23 1
#endif
#pragma nounroll
    for (int rep = 0; rep < REP_P0; ++rep) {
#if WSTAG
    p0_weights(KARGS(), (LAS float*)(lds + wave * 16384), 0, 1536, gw, ngw, lane);
    p0_weights(KARGS(), (LAS float*)(lds + wave * 16384), 2048, 4096, gw, ngw, lane);
    p0_weights(KARGS(), (LAS float*)(lds + wave * 16384), 6144, 7680, gw, ngw, lane);
    p0_weights(KARGS(), (LAS float*)(lds + wave * 16384), 8192, 10240, gw, ngw, lane);
#else
    p0_weights(KARGS(), (LAS float*)(lds + wave * 16384), 0, 12288, gw, ngw, lane);
#endif
    p0_rows(a.in[0], hb, sspart, gw, ngw, lane);
    }
#if USE_XCD
    if (G == 0x7fffffff) grid.sync();
    GSYNC();
#else
    __threadfence(); grid.sync();
#endif

#ifndef STAG_A
#define STAG_A 0
#endif
#ifndef STAG_D
#define STAG_D 0
#endif
#define STAGGER_WORK(lo_, hi_) do { if (WSTAG) { if (bx & 1) { int lane_s = threadIdx.x & 63; asm volatile("" : "+v"(lane_s)); \
        p0_weights(KARGS(), (LAS float*)(lds + wave * 16384), (lo_), (hi_), (bx >> 1) * NWAVES + wave, (G >> 1) * NWAVES, lane_s); } __syncthreads(); } } while (0)
#define LAUNDER(p) do { size_t z_ = 0; asm volatile("" : "+s"(z_)); (p) = (p) + z_; } while (0)
#pragma nounroll
    for (int l = 0; l < 2; ++l) {
        const unsigned char* wl = KARGS()->ws + WS_W + (size_t)l * W_LAYER;
#ifndef REP_GA
#define REP_GA 1
#endif
#ifndef REP_GD
#define REP_GD 1
#endif
#pragma nounroll
        for (int rg = 0; rg < REP_GA; ++rg) { const bf16* gA = ((bf16*)(KARGS()->ws + WS_HB)); const bf16* gB = (const bf16*)(wl + W_IN); LAUNDER(gA); LAUNDER(gB);
          STAGGER_WORK(l == 0 ? 1536 : 7680, l == 0 ? 2048 : 8192);
          pg8::Gemm g{gA, gB, MTOK, LDP, DM}; pg8::StaticOrder S; S.init(MTOK, LDP, G, bx);
#if PROBE_DRY
          if (rg + 1 < REP_GA) { pg8::EpiScaleBf16<0, true> E{((bf16*)(KARGS()->ws + WS_PROJ)), LDP, ((float*)(KARGS()->ws + WS_SS))};
          pg8::gemm_phase<pg8::EpiScaleBf16<0, true>, pg8::StaticOrder, true, true>(lds, g, S, E); } else
#endif
          { pg8::EpiScaleBf16<0> E{((bf16*)(KARGS()->ws + WS_PROJ)), LDP, ((float*)(KARGS()->ws + WS_SS))};
          pg8::gemm_phase<pg8::EpiScaleBf16<0>, pg8::StaticOrder, true, true>(lds, g, S, E); } }
        GSYNC();
        { bf16* projL = ((bf16*)(KARGS()->ws + WS_PROJ)); bf16* mixedL = ((bf16*)(KARGS()->ws + WS_MIX)); float* kvTL = ((float*)(KARGS()->ws + WS_KVT)); float* decayL = ((float*)(KARGS()->ws + WS_DEC)); bf16* StL = ((bf16*)(KARGS()->ws + WS_ST)); LAUNDER(projL); LAUNDER(mixedL); LAUNDER(kvTL); LAUNDER(decayL); LAUNDER(StL);
#pragma nounroll
        for (int rep = 0; rep < REP_B1; ++rep) {
#ifndef REP_CONV
#define REP_CONV 1
#endif
#ifndef REP_KV
#define REP_KV 1
#endif
#ifndef REP_ATT
#define REP_ATT 1
#endif
#ifndef REP_SCAN
#define REP_SCAN 1
#endif
#ifndef REP_OUT
#define REP_OUT 1
#endif
#ifndef NO_CONV
#pragma nounroll
        for (int rc = 0; rc < REP_CONV; ++rc)
        for (int bc = bx; bc < 512; bc += G)
            conv_item(projL, KARGS()->in[6] + l * 31 * 256, KARGS()->in[7] + l * 256, KARGS()->in[8] + l * 256, KARGS()->in[9] + l * 256, mixedL, lds, bc, tid, wave, lane);
#endif
        {
            LAS float* biasT = (LAS float*)(lds + 131072);
            int tidb = threadIdx.x; asm volatile("" : "+v"(tidb));
            for (int i = tidb; i < 6 * 257; i += NWAVES * 64) { const int hh = i / 257, j = i - hh * 257; biasT[hh * 260 + j] = KARGS()->in[10][(size_t)l * 6 * 257 + i] * LOG2E; }
            __syncthreads();
            LAS unsigned char* vimg = lds + wave * 16384;
#ifndef NO_GLAKV
#pragma nounroll
            for (int rc = 0; rc < REP_KV; ++rc)
            for (int it = gw; it < 2048; it += ngw) gla_kv_item(projL, KARGS()->in[4] + l * 192, kvTL, decayL, vimg, it, lane);
#endif
#ifndef NO_ATT
#pragma nounroll
            for (int rc = 0; rc < REP_ATT; ++rc)
#if ATT_BLOCK
            __syncthreads();
            for (int u = bx; u < 768; u += G) attn_block_unit(projL, mixedL, biasT, lds, u, wave, lane);
#else
            for (int u = gw; u < 6144; u += ngw) attn_unit(projL, mixedL, biasT, vimg, u, lane);
#endif
#endif
        }
        __syncthreads();
        }
        GSYNC();
#pragma nounroll
        for (int rep = 0; rep < REP_B23; ++rep) {
        LAUNDER(kvTL); LAUNDER(decayL); LAUNDER(StL);
#pragma nounroll
        for (int rc = 0; rc < REP_SCAN; ++rc)
        { int tids = threadIdx.x; asm volatile("" : "+v"(tids)); gla_scan(kvTL, decayL, StL, bx * (NWAVES * 64) + tids, G * NWAVES * 64); }
        GSYNC();
        LAUNDER(projL); LAUNDER(mixedL); LAUNDER(StL);
#ifndef NO_GLAOUT
#pragma nounroll
        for (int rc = 0; rc < REP_OUT; ++rc)
        for (int it = gw; it < 2048; it += ngw) gla_out_item(projL, StL, mixedL, it, lane);
#endif
        GSYNC();
        }
        }
#ifndef REP_GC
#define REP_GC 1
#endif
#ifndef REP_GE
#define REP_GE 1
#endif
        { const bf16* gA = ((bf16*)(KARGS()->ws + WS_MIX)); const bf16* gB = (const bf16*)(wl + W_OUT); LAUNDER(gA); LAUNDER(gB);
          pg8::Gemm g{gA, gB, MTOK, DM, DM}; pg8::StaticOrder S; S.init(MTOK, DM, G, bx);
          pg8::EpiResid E{((bf16*)(KARGS()->ws + WS_HB)), ((float*)(KARGS()->ws + WS_SS))};
          pg8::gemm_phase<pg8::EpiResid, pg8::StaticOrder, true, true>(lds, g, S, E); }
        GSYNC();
#pragma nounroll
        for (int rg = 0; rg < REP_GD; ++rg) { const bf16* gA = ((bf16*)(KARGS()->ws + WS_HB)); const bf16* gB = (const bf16*)(wl + W_UP); LAUNDER(gA); LAUNDER(gB);
          STAGGER_WORK(l == 0 ? 4096 : 10240, l == 0 ? 6144 : 12288);
          pg8::Gemm g{gA, gB, MTOK, FF, DM}; pg8::StaticOrder S; S.init(MTOK, FF, G, bx);
          pg8::EpiScaleBf16<1> E{((bf16*)(KARGS()->ws + WS_FF)), FF, ((float*)(KARGS()->ws + WS_SS))};
          pg8::gemm_phase<pg8::EpiScaleBf16<1>, pg8::StaticOrder, true, true>(lds, g, S, E); }
        GSYNC();
        { const bf16* gA = ((bf16*)(KARGS()->ws + WS_FF)); const bf16* gB = (const bf16*)(wl + W_DN); LAUNDER(gA); LAUNDER(gB);
          pg8::Gemm g{gA, gB, MTOK, DM, FF}; pg8::StaticOrder S; S.init(MTOK, DM, G, bx);
          pg8::EpiResid E{((bf16*)(KARGS()->ws + WS_HB)), ((float*)(KARGS()->ws + WS_SS))};
          pg8::gemm_phase<pg8::EpiResid, pg8::StaticOrder, true, true>(lds, g, S, E); }
        GSYNC();
    }
    { int lane2 = tid & 63; asm volatile("" : "+v"(lane2)); final_rows((KARGS()->out), ((bf16*)(KARGS()->ws + WS_HB)), ((float*)(KARGS()->ws + WS_SS)), KARGS()->in[15], gw, ngw, lane2); }
}

extern "C" void kernel_launch(void* const* d_in, const int* in_sizes, int n_in, void* d_out, int out_size, void* d_ws, size_t ws_size, hipStream_t stream) {
    static int grid = 0;
    if (grid == 0) {
        if (n_in != 16 || in_sizes[0] != MTOK * DM || out_size != MTOK * DM || ws_size < WS_END) { fprintf(stderr, "kernel_launch: unexpected shapes (n_in %d, ws %zu)\n", n_in, ws_size); grid = -1; return; }
        int dev = 0, cus = 0, per_cu = 0;
        if (hipGetDevice(&dev) != hipSuccess || hipDeviceGetAttribute(&cus, hipDeviceAttributeMultiprocessorCount, dev) != hipSuccess) { grid = -1; return; }
        if (hipFuncSetAttribute((const void*)mega_fwd, hipFuncAttributeMaxDynamicSharedMemorySize, LDS_BYTES) != hipSuccess) { fprintf(stderr, "kernel_launch: hipFuncSetAttribute failed\n"); grid = -1; return; }
        if (hipOccupancyMaxActiveBlocksPerMultiprocessor(&per_cu, (const void*)mega_fwd, NWAVES * 64, LDS_BYTES) != hipSuccess || per_cu < 1) { fprintf(stderr, "kernel_launch: occupancy query says %d blocks per CU\n", per_cu); (void)hipGetLastError(); grid = -1; return; }
        grid = cus;
    }
    if (grid < 0) return;
#if USE_XCD
    if (hipMemsetAsync((char*)d_ws + WS_CTL, 0, 65536, stream) != hipSuccess) { fprintf(stderr, "kernel_launch: memset failed\n"); return; }
#endif
    Args a{};
    for (int i = 0; i < 16; ++i) a.in[i] = (const float*)d_in[i];
    a.out = (float*)d_out; a.ws = (unsigned char*)d_ws;
    void* args[] = {&a};
    const hipError_t e = hipLaunchCooperativeKernel((const void*)mega_fwd, dim3(grid), dim3(NWAVES * 64), args, LDS_BYTES, stream);
    if (e != hipSuccess) fprintf(stderr, "kernel_launch: cooperative launch failed: %s (grid %d)\n", hipGetErrorString(e), grid);
}
```

```cpp
#include <hip/hip_runtime.h>
#include <hip/hip_cooperative_groups.h>
#include <cstdio>
#include <cstdint>
namespace cg = cooperative_groups;
#ifndef USE_XCD
#define USE_XCD 1
#endif
#ifndef PROBE_DRY
#define PROBE_DRY 0
#endif
#ifndef WSTAG
#define WSTAG 0
#endif
#ifndef ATT_BLOCK
#define ATT_BLOCK 1
#endif
namespace pg8 {
#define PG8_LAS __attribute__((address_space(3)))
typedef unsigned short bf16_t;
typedef short bf16x8 __attribute__((ext_vector_type(8)));
typedef float f32x4 __attribute__((ext_vector_type(4)));
typedef unsigned u32x4 __attribute__((ext_vector_type(4)));
constexpr int BM = 256, BK = 64, HALF = 128, HTB = HALF * BK * 2  , STAGE_BYTES = 8 * HTB, NXCD = 8, WGM = 8;

__host__ __device__ __forceinline__ int lds_byte(int r, int c) { const int st = (r >> 4) * 2 + (c >> 5), rr = r & 15, cc = c & 31, ob = rr * 64 + cc * 2; return st * 1024 + (ob ^ (((ob >> 9) & 1) << 5)); }
__host__ __device__ __forceinline__ void stage_rc(int b, int& R, int& C) { const int st = b / 1024, sb = b % 1024, swz = sb ^ (((sb >> 9) & 1) << 5); R = (st >> 1) * 16 + swz / 64; C = (st & 1) * 32 + (swz % 64) / 2; }
__host__ __device__ __forceinline__ int perm32(int rho) { const int n = rho >> 4, i = rho & 15; return 8 * (i >> 2) + 4 * n + (i & 3); }

struct Unit { int pm, pn; };
struct Gemm { const bf16_t* A; const bf16_t* Bt; int M, N, K; };

struct StaticOrder {
    int nM, nN, nwg, G, c;
    __host__ __device__ void init(int M, int N, int G_, int c_) { nM = M / BM; nN = N / BM; nwg = nM * nN; G = G_; c = c_; }
    __host__ __device__ bool next(int i, Unit& u) const {
        const long L = (long)i * G + c; if (L >= nwg) return false;
        int wgid = (int)L; { const int q = nwg / NXCD, r = nwg % NXCD, xcd = wgid % NXCD, off = wgid / NXCD; wgid = (xcd < r ? xcd * (q + 1) : r * (q + 1) + (xcd - r) * q) + off; }
        const int nig = WGM * nN, gid = wgid / nig, fm = gid * WGM, gsz = (nM - fm) < WGM ? (nM - fm) : WGM;
        u.pm = fm + ((wgid % nig) % gsz); u.pn = (wgid % nig) / gsz; return true;
    }
    __device__ __forceinline__ void a_ready(const Unit&) const {}
    __device__ __forceinline__ void done(const Unit&) const {}
};

__device__ __forceinline__ unsigned cvt_pk_bf16(float lo, float hi) { unsigned r; asm volatile("v_cvt_pk_bf16_f32 %0, %1, %2" : "=v"(r) : "v"(lo), "v"(hi)); return r; }

__device__ __forceinline__ unsigned cvtpk2(float lo, float hi) { typedef float f2_t __attribute__((ext_vector_type(2))); typedef __bf16 b2_t __attribute__((ext_vector_type(2))); f2_t v = {lo, hi}; b2_t b = __builtin_convertvector(v, b2_t); return __builtin_bit_cast(unsigned, b); }
__device__ __forceinline__ float row_rstd16(const float* sspart, int row, int fq) {
    const f32x4 p = *(const f32x4*)(sspart + (size_t)row * 16 + 4 * fq);
    float s = (p[0] + p[1]) + (p[2] + p[3]);
    s += __shfl_xor(s, 16); s += __shfl_xor(s, 32);
    return __builtin_amdgcn_rsqf(s * (1.0f / 1024.0f) + 1e-6f);
}
template <int ACT, bool DRY = false> struct EpiScaleBf16 {
    static constexpr bool PERM = true, AFTER_DRAIN = false;
    bf16_t* O; int ldc; const float* sspart;
    __device__ __forceinline__ void operator()(const f32x4 (&acc)[2][2][4][2], const Unit& u, int wr, int wc, int fr, int fq) const {
        const int row0 = u.pm * BM + wr * 64 + fr; const int col0 = u.pn * BM + wc * 32 + 8 * fq;
        float rs[2][4]; f32x4 pp[2][4];
#pragma unroll
        for (int ai = 0; ai < 2; ++ai)
#pragma unroll
            for (int m = 0; m < 4; ++m) pp[ai][m] = *(const f32x4*)(sspart + (size_t)(row0 + ai * HALF + m * 16) * 16 + 4 * fq);
        asm volatile("" : "+v"(pp[0][0]), "+v"(pp[0][1]), "+v"(pp[0][2]), "+v"(pp[0][3]), "+v"(pp[1][0]), "+v"(pp[1][1]), "+v"(pp[1][2]), "+v"(pp[1][3]));
#pragma unroll
        for (int ai = 0; ai < 2; ++ai)
#pragma unroll
            for (int m = 0; m < 4; ++m) { const f32x4 p = pp[ai][m]; rs[ai][m] = (p[0] + p[1]) + (p[2] + p[3]); }
#pragma unroll
        for (int ai = 0; ai < 2; ++ai)
#pragma unroll
            for (int m = 0; m < 4; ++m) { float s = rs[ai][m]; s += __shfl_xor(s, 16); s += __shfl_xor(s, 32); rs[ai][m] = __builtin_amdgcn_rsqf(s * (1.0f / 1024.0f) + 1e-6f); }
#pragma unroll
        for (int ai = 0; ai < 2; ++ai)
#pragma unroll
            for (int m = 0; m < 4; ++m) { const int row = row0 + ai * HALF + m * 16; const float r = rs[ai][m];
                bf16_t* rowp = O + (size_t)row * ldc + col0;
#pragma unroll
                for (int bj = 0; bj < 2; ++bj) { f32x4 v0 = acc[ai][bj][m][0] * r, v1 = acc[ai][bj][m][1] * r;
                    if (ACT == 1) {
#pragma unroll
                        for (int e = 0; e < 4; ++e) { const float a = fmaxf(v0[e], 0.f), b = fmaxf(v1[e], 0.f); v0[e] = a * a; v1[e] = b * b; } }
                    u32x4 w; w.x = cvtpk2(v0[0], v0[1]); w.y = cvtpk2(v0[2], v0[3]); w.z = cvtpk2(v1[0], v1[1]); w.w = cvtpk2(v1[2], v1[3]);
                    if (!DRY || w.x == 0x7fc17fc1u) *(u32x4*)(rowp + bj * HALF) = w; } }
    }
};
struct EpiResid {
    static constexpr bool PERM = false, AFTER_DRAIN = false;
    bf16_t* hb; float* sspart;
    __device__ __forceinline__ void operator()(const f32x4 (&acc)[2][2][4][2], const Unit& u, int wr, int wc, int fr, int fq) const {
        typedef unsigned u32x2v __attribute__((ext_vector_type(2)));
        const int col0 = u.pn * BM + wc * 32 + 4 * fq;
#pragma unroll
        for (int ai = 0; ai < 2; ++ai) {
            u32x2v bs[4][2][2];
#pragma unroll
            for (int m = 0; m < 4; ++m) { const size_t off = (size_t)(u.pm * BM + ai * HALF + wr * 64 + m * 16 + fr) * 1024 + col0;
#pragma unroll
                for (int bj = 0; bj < 2; ++bj)
#pragma unroll
                    for (int n = 0; n < 2; ++n) bs[m][bj][n] = *(const u32x2v*)(hb + off + bj * HALF + n * 16); }
            asm volatile("" : "+v"(bs[0][0][0]), "+v"(bs[0][0][1]), "+v"(bs[0][1][0]), "+v"(bs[0][1][1]), "+v"(bs[1][0][0]), "+v"(bs[1][0][1]), "+v"(bs[1][1][0]), "+v"(bs[1][1][1]),
                             "+v"(bs[2][0][0]), "+v"(bs[2][0][1]), "+v"(bs[2][1][0]), "+v"(bs[2][1][1]), "+v"(bs[3][0][0]), "+v"(bs[3][0][1]), "+v"(bs[3][1][0]), "+v"(bs[3][1][1]) :: "memory");
#pragma unroll
            for (int m = 0; m < 4; ++m) { const int r = u.pm * BM + ai * HALF + wr * 64 + m * 16 + fr; const size_t off = (size_t)r * 1024 + col0; float ss = 0.f;
#pragma unroll
                for (int bj = 0; bj < 2; ++bj)
#pragma unroll
                    for (int n = 0; n < 2; ++n) { const u32x2v b = bs[m][bj][n]; f32x4 o = acc[ai][bj][m][n];
                        o[0] += __uint_as_float(b.x << 16); o[1] += __uint_as_float(b.x & 0xffff0000u); o[2] += __uint_as_float(b.y << 16); o[3] += __uint_as_float(b.y & 0xffff0000u);
                        u32x2v w; w.x = cvtpk2(o[0], o[1]); w.y = cvtpk2(o[2], o[3]); *(u32x2v*)(hb + off + bj * HALF + n * 16) = w;
                        ss += (o[0] * o[0] + o[1] * o[1]) + (o[2] * o[2] + o[3] * o[3]); }
                ss += __shfl_xor(ss, 16); ss += __shfl_xor(ss, 32);
                if (fq == 0) sspart[(size_t)r * 16 + u.pn * 4 + wc] = ss; }
            asm volatile("" ::: "memory");
        }
    }
};
template <class Epi, class Sched, bool ALIGN_EPI = false, bool SP2 = false>
__device__ __forceinline__ void gemm_phase(PG8_LAS unsigned char* lds, const Gemm g, const Sched& S, const Epi& E) {
    int tid_ = threadIdx.x; asm volatile("" : "+v"(tid_));
    const int tid = tid_, wid = __builtin_amdgcn_readfirstlane(tid >> 6), lane = tid & 63, wr = wid >> 2, wc = wid & 3, fr = lane & 15, fq = lane >> 4;
    const int K = g.K, nt = K / BK;
    unsigned voffA[2], voffB[2];
#pragma unroll
    for (int i = 0; i < 2; ++i) { int R, C; stage_rc(tid * 16 + i * 8192, R, C); const int Rb = Epi::PERM ? ((R & ~31) + perm32(R & 31)) : R;
        voffA[i] = (unsigned)(R * K + C) * 2u; voffB[i] = (unsigned)(Rb * K + C) * 2u; }
    const size_t kstep = (size_t)(BK * 2);
    const size_t hstep = (size_t)HALF * K * 2;
    const size_t tstep = 2 * hstep;
    const unsigned ldsw = (unsigned)wid * 1024u;
    const int aoff = lds_byte(wr * 64 + fr, fq * 8), boff = lds_byte(wc * 32 + fr, fq * 8);
#define PG8_SA(b, h) (((b) * 2 + (h)) * HTB)
#define PG8_SB(b, h) ((4 + (b) * 2 + (h)) * HTB)
#define PG8_STAGE(bufoff, gbase, voff) do { _Pragma("unroll") for (int _i = 0; _i < 2; ++_i) \
        __builtin_amdgcn_global_load_lds((const unsigned*)((const char*)(gbase) + (voff)[_i]), (PG8_LAS unsigned*)(lds + (bufoff) + ldsw + _i * 8192), 16, 0, 0); } while (0)
#define PG8_LDA(dst, b, h) do { _Pragma("unroll") for (int m = 0; m < 4; ++m) _Pragma("unroll") for (int k = 0; k < 2; ++k) dst[m][k] = *(const PG8_LAS bf16x8*)(lds + PG8_SA(b, h) + aoff + m * 2048 + k * 1024); } while (0)
#define PG8_LDB(dst, b, h) do { _Pragma("unroll") for (int n = 0; n < 2; ++n) _Pragma("unroll") for (int k = 0; k < 2; ++k) dst[n][k] = *(const PG8_LAS bf16x8*)(lds + PG8_SB(b, h) + boff + n * 2048 + k * 1024); } while (0)
#define PG8_MMA(ai, bj, At, Bt) do { __builtin_amdgcn_s_setprio(1); _Pragma("unroll") for (int m = 0; m < 4; ++m) _Pragma("unroll") for (int n = 0; n < 2; ++n) _Pragma("unroll") for (int k = 0; k < 2; ++k) \
        acc[ai][bj][m][n] = __builtin_amdgcn_mfma_f32_16x16x32_bf16(Bt[n][k], At[m][k], acc[ai][bj][m][n], 0, 0, 0); __builtin_amdgcn_s_setprio(0); } while (0)
#define PG8_WAIT_V(n) asm volatile("s_waitcnt vmcnt(" #n ")" ::: "memory")
#define PG8_WAIT_L(n) asm volatile("s_waitcnt lgkmcnt(" #n ")" ::: "memory")
#define PG8_BAR __builtin_amdgcn_s_barrier()
#define PG8_SCHED __builtin_amdgcn_sched_barrier(0)
    Unit cur, nxt; int ui = 0;
    if (!S.next(0, cur)) return;
    f32x4 acc[2][2][4][2];
#pragma unroll
    for (int a = 0; a < 2; ++a)
#pragma unroll
        for (int b = 0; b < 2; ++b)
#pragma unroll
            for (int m = 0; m < 4; ++m)
#pragma unroll
                for (int n = 0; n < 2; ++n) acc[a][b][m][n] = (f32x4){0.f, 0.f, 0.f, 0.f};
    bf16x8 At[4][2], B0[2][2], B1[2][2];
    const char* cA = (const char*)g.A + (size_t)cur.pm * tstep; const char* cB = (const char*)g.Bt + (size_t)cur.pn * tstep;
    S.a_ready(cur);
    if constexpr (SP2) {
        PG8_STAGE(PG8_SB(0, 0), cB, voffB); PG8_STAGE(PG8_SB(0, 1), cB + hstep, voffB); PG8_STAGE(PG8_SA(0, 0), cA, voffA); PG8_STAGE(PG8_SA(0, 1), cA + hstep, voffA);
        if (wr == 1) PG8_BAR;
        PG8_WAIT_V(2); PG8_BAR;
        PG8_STAGE(PG8_SB(1, 0), cB + kstep, voffB); PG8_STAGE(PG8_SA(1, 0), cA + kstep, voffA); PG8_STAGE(PG8_SB(1, 1), cB + hstep + kstep, voffB);
        PG8_WAIT_V(6); PG8_BAR;
    } else {
        PG8_STAGE(PG8_SB(0, 0), cB, voffB); PG8_STAGE(PG8_SA(0, 0), cA, voffA); PG8_STAGE(PG8_SB(0, 1), cB + hstep, voffB); PG8_STAGE(PG8_SA(0, 1), cA + hstep, voffA);
        if (wr == 1) PG8_BAR;
        PG8_WAIT_V(4); PG8_BAR;
        PG8_STAGE(PG8_SB(1, 0), cB + kstep, voffB); PG8_STAGE(PG8_SA(1, 0), cA + kstep, voffA); PG8_STAGE(PG8_SB(1, 1), cB + hstep + kstep, voffB);
        PG8_WAIT_V(6); PG8_BAR;
    }
    for (;;) {
        const bool has_next = S.next(ui + 1, nxt);
        const char* nA = has_next ? (const char*)g.A + (size_t)nxt.pm * tstep : cA; const char* nB = has_next ? (const char*)g.Bt + (size_t)nxt.pn * tstep : cB;
        for (int t = 0; t < nt; t += 2) {
            const bool last = (t == nt - 2);
            const char* a1 = cA + (size_t)(t + 1) * kstep;
            const char* a2 = last ? nA : cA + (size_t)(t + 2) * kstep; const char* b2 = last ? nB : cB + (size_t)(t + 2) * kstep;
            const char* a3 = a2 + kstep; const char* b3 = b2 + kstep;
            if (last && has_next) S.a_ready(nxt);
            if constexpr (SP2) {
            PG8_LDB(B0, 0, 0); PG8_LDB(B1, 0, 1); PG8_SCHED; PG8_LDA(At, 0, 0); PG8_STAGE(PG8_SA(1, 1), a1 + hstep, voffA);
            PG8_WAIT_V(8); PG8_WAIT_L(0); PG8_BAR; PG8_MMA(0, 0, At, B0); PG8_MMA(0, 1, At, B1); PG8_BAR; PG8_SCHED;
            PG8_LDA(At, 0, 1); PG8_STAGE(PG8_SB(0, 0), b2, voffB); PG8_STAGE(PG8_SB(0, 1), b2 + hstep, voffB); PG8_STAGE(PG8_SA(0, 0), a2, voffA);
            PG8_WAIT_V(8); PG8_WAIT_L(0); PG8_BAR; PG8_MMA(1, 0, At, B0); PG8_MMA(1, 1, At, B1); PG8_BAR; PG8_SCHED;
            PG8_LDB(B0, 1, 0); PG8_LDB(B1, 1, 1); PG8_SCHED; PG8_LDA(At, 1, 0); PG8_STAGE(PG8_SA(0, 1), a2 + hstep, voffA);
            PG8_WAIT_V(8); PG8_WAIT_L(0); PG8_BAR; PG8_MMA(0, 0, At, B0); PG8_MMA(0, 1, At, B1); PG8_BAR; PG8_SCHED;
            PG8_LDA(At, 1, 1); PG8_STAGE(PG8_SB(1, 0), b3, voffB); PG8_STAGE(PG8_SB(1, 1), b3 + hstep, voffB); PG8_STAGE(PG8_SA(1, 0), a3, voffA);
            PG8_WAIT_V(8); PG8_WAIT_L(0); PG8_BAR; PG8_MMA(1, 0, At, B0); PG8_MMA(1, 1, At, B1); PG8_BAR; PG8_SCHED;
            } else {
            PG8_LDB(B0, 0, 0); PG8_SCHED; PG8_LDA(At, 0, 0); PG8_STAGE(PG8_SA(1, 1), a1 + hstep, voffA);
            PG8_WAIT_L(8); PG8_BAR; PG8_WAIT_L(0); PG8_MMA(0, 0, At, B0); PG8_BAR; PG8_SCHED;
            PG8_LDB(B1, 0, 1); PG8_STAGE(PG8_SB(0, 0), b2, voffB);
            PG8_BAR; PG8_WAIT_L(0); PG8_MMA(0, 1, At, B1); PG8_BAR;
            PG8_LDA(At, 0, 1); PG8_STAGE(PG8_SA(0, 0), a2, voffA);
            PG8_BAR; PG8_WAIT_L(0); PG8_MMA(1, 0, At, B0); PG8_BAR; PG8_SCHED;
            PG8_STAGE(PG8_SB(0, 1), b2 + hstep, voffB);
            PG8_WAIT_V(6); PG8_BAR; PG8_MMA(1, 1, At, B1); PG8_BAR;
            PG8_LDB(B0, 1, 0); PG8_SCHED; PG8_LDA(At, 1, 0); PG8_STAGE(PG8_SA(0, 1), a2 + hstep, voffA);
            PG8_WAIT_L(8); PG8_BAR; PG8_WAIT_L(0); PG8_MMA(0, 0, At, B0); PG8_BAR; PG8_SCHED;
            PG8_LDB(B1, 1, 1); PG8_STAGE(PG8_SB(1, 0), b3, voffB);
            PG8_BAR; PG8_WAIT_L(0); PG8_MMA(0, 1, At, B1); PG8_BAR;
            PG8_LDA(At, 1, 1); PG8_STAGE(PG8_SA(1, 0), a3, voffA);
            PG8_BAR; PG8_WAIT_L(0); PG8_MMA(1, 0, At, B0); PG8_BAR; PG8_SCHED;
            PG8_STAGE(PG8_SB(1, 1), b3 + hstep, voffB);
            PG8_WAIT_V(6); PG8_BAR; PG8_MMA(1, 1, At, B1); PG8_BAR;
            }
        }
        if constexpr (ALIGN_EPI) { if (wr == 0) PG8_BAR; }
        if constexpr (!Epi::AFTER_DRAIN) { E(acc, cur, wr, wc, fr, fq); S.done(cur); }
        if (!has_next) break;
#pragma unroll
        for (int a = 0; a < 2; ++a)
#pragma unroll
            for (int b = 0; b < 2; ++b)
#pragma unroll
                for (int m = 0; m < 4; ++m)
#pragma unroll
                    for (int n = 0; n < 2; ++n) acc[a][b][m][n] = (f32x4){0.f, 0.f, 0.f, 0.f};
        cur = nxt; cA = nA; cB = nB; ++ui;
        if constexpr (ALIGN_EPI) { if (wr == 1) PG8_BAR; }
    }
    PG8_WAIT_V(0);
    if constexpr (!ALIGN_EPI) { if (wr == 0) PG8_BAR; }
    PG8_BAR;
    if constexpr (Epi::AFTER_DRAIN) { E.fused(acc, cur, wr, wc, fr, fq, lds, wid, lane); S.done(cur); }
#undef PG8_SA
#undef PG8_SB
#undef PG8_STAGE
#undef PG8_LDA
#undef PG8_LDB
#undef PG8_MMA
#undef PG8_WAIT_V
#undef PG8_WAIT_L
#undef PG8_BAR
#undef PG8_SCHED
}
}

#define LAS __attribute__((address_space(3)))
typedef unsigned short bf16;
typedef short bf16x8 __attribute__((ext_vector_type(8)));
typedef float f32x4 __attribute__((ext_vector_type(4)));
typedef float f32x16 __attribute__((ext_vector_type(16)));
typedef unsigned u32x4 __attribute__((ext_vector_type(4)));
typedef unsigned u32x2 __attribute__((ext_vector_type(2)));
typedef short v4i16_t __attribute__((ext_vector_type(4)));

constexpr int NWAVES = 8;
constexpr int MTOK = 32768, DM = 1024, SEQ = 4096, NCH = 64, FF = 4096;
constexpr int DIN_SRC = 2832;
constexpr int LDP = 3072;
constexpr int GQ = 0, GK = 192, GV = 384, GG = 768, GZ = 1152, CU = 1344, AQ = 1856, AK = 2240, AV = 2624, PEND = 3008;
constexpr int MIX_GLA = 0, MIX_CONV = 384, MIX_ATT = 640;
constexpr float EPS = 1e-6f;
constexpr float LOG2E = 1.4426950408889634f;

constexpr size_t MiB = 1u << 20;
constexpr size_t WS_CTL = 0;
constexpr size_t WS_W = 1 * MiB, W_LAYER = 24 * MiB, W_IN = 0, W_OUT = 6 * MiB, W_UP = 8 * MiB, W_DN = 16 * MiB;
constexpr size_t WS_HB = 49 * MiB;
constexpr size_t WS_PROJ = 113 * MiB;
constexpr size_t WS_MIX = 305 * MiB;
constexpr size_t WS_FF = 113 * MiB;
constexpr size_t WS_SS = 369 * MiB;
constexpr size_t WS_KVT = 371 * MiB;
constexpr size_t WS_DEC = 407 * MiB;
constexpr size_t WS_ST = 408 * MiB;
constexpr size_t WS_END = 427 * MiB;

constexpr int LDS_BYTES = 147456;

__device__ __forceinline__ unsigned cvtpk(float lo, float hi) { typedef float f2_t __attribute__((ext_vector_type(2))); typedef __bf16 b2_t __attribute__((ext_vector_type(2))); f2_t v = {lo, hi}; b2_t b = __builtin_convertvector(v, b2_t); return __builtin_bit_cast(unsigned, b); }
__device__ __forceinline__ float bflo(unsigned u) { return __uint_as_float(u << 16); }
__device__ __forceinline__ float bfhi(unsigned u) { return __uint_as_float(u & 0xffff0000u); }
__device__ __forceinline__ float bf2f(bf16 u) { return __uint_as_float((unsigned)u << 16); }
__device__ __forceinline__ float wave_sum(float v) {
#pragma unroll
    for (int o = 1; o < 64; o <<= 1) v += __shfl_xor(v, o);
    return v;
}
__device__ __forceinline__ int crow(int r, int hi) { return (r & 3) + 8 * (r >> 2) + 4 * hi; }
__device__ __forceinline__ v4i16_t trrd(LAS const unsigned char* p) { return __builtin_amdgcn_ds_read_tr16_b64_v4i16((LAS v4i16_t*)p); }
__device__ __forceinline__ bf16x8 cat8(v4i16_t a, v4i16_t b) { return (bf16x8){a[0], a[1], a[2], a[3], b[0], b[1], b[2], b[3]}; }
#define MFMA32(a, b, c) __builtin_amdgcn_mfma_f32_32x32x16_bf16((a), (b), (c), 0, 0, 0)
#define LDS_FENCE() asm volatile("s_waitcnt lgkmcnt(0)" ::: "memory")

struct Args { const float* in[16]; float* out; unsigned char* ws; };
typedef const Args __attribute__((address_space(4))) CArgs;
__device__ __forceinline__ void p0_store_tile(LAS float* scr, bf16* WT, int K, int dst_row0, int k0, int lane) {
    LDS_FENCE();
    const int c = lane & 7;
#pragma unroll
    for (int j = 0; j < 4; ++j) { const int n = (lane >> 3) + 8 * j; const LAS float* s = scr + (8 * c) * 33 + n;
        u32x4 o; o.x = cvtpk(s[0 * 33], s[1 * 33]); o.y = cvtpk(s[2 * 33], s[3 * 33]); o.z = cvtpk(s[4 * 33], s[5 * 33]); o.w = cvtpk(s[6 * 33], s[7 * 33]);
        *(u32x4*)(WT + (size_t)(dst_row0 + n) * K + k0 + 8 * c) = o; }
    LDS_FENCE();
}
__device__ __forceinline__ void p0_copy_item(const float* W, int ldw, int src0, const float* gain, LAS float* scr, int k0, int lane) {
#pragma unroll
    for (int i = 0; i < 32; ++i) { const int kk = 2 * i + (lane >> 5); const float g = gain ? gain[k0 + kk] : 1.f;
        scr[kk * 33 + (lane & 31)] = W[(size_t)(k0 + kk) * ldw + src0 + (lane & 31)] * g; }
}
__device__ __forceinline__ void p0_weights(CArgs* ka, LAS float* scr, int lo, int hi, int gw, int ngw, int lane) {
    constexpr int I_IN = 16 * 96, I_OUT = 16 * 32, I_UP = 16 * 128, I_DN = 64 * 32, I_L = I_IN + I_OUT + I_UP + I_DN;
    unsigned char* ws = ka->ws;
    for (int it = lo + gw; it < hi; it += ngw) {
        const int l = it / I_L; int r = it - l * I_L;
        unsigned char* wl = ws + WS_W + (size_t)l * W_LAYER;
        if (r < I_IN) {
            const int kb = r / 96, nb = r % 96, k0 = 64 * kb, n0 = 32 * nb;
            const float* W = ka->in[2] + (size_t)l * DM * DIN_SRC; const float* gain = ka->in[1] + l * DM;
            if (n0 < GZ) p0_copy_item(W, DIN_SRC, n0, gain, scr, k0, lane);
            else if (n0 < CU) {
                const float* wg = ka->in[3] + (size_t)l * 16 * 192; const int j = n0 - GZ + (lane & 31);
                float wgc[16];
#pragma unroll
                for (int q = 0; q < 16; ++q) wgc[q] = wg[q * 192 + j];
#pragma unroll 4
                for (int i = 0; i < 32; ++i) { const int kk = 2 * i + (lane >> 5); const f32x4* wr = (const f32x4*)(W + (size_t)(k0 + kk) * DIN_SRC + 1152); float s = 0.f;
#pragma unroll
                    for (int q = 0; q < 4; ++q) { const f32x4 wv = wr[q]; s += (wv[0] * wgc[4 * q] + wv[1] * wgc[4 * q + 1]) + (wv[2] * wgc[4 * q + 2] + wv[3] * wgc[4 * q + 3]); }
                    scr[kk * 33 + (lane & 31)] = s * gain[k0 + kk]; }
            }
            else if (n0 < PEND) p0_copy_item(W, DIN_SRC, n0 - CU + 1168, gain, scr, k0, lane);
            else {
#pragma unroll 8
                for (int i = 0; i < 32; ++i) scr[(2 * i + (lane >> 5)) * 33 + (lane & 31)] = 0.f;
            }
            p0_store_tile(scr, (bf16*)(wl + W_IN), DM, n0, k0, lane);
            continue;
        }
        r -= I_IN;
        if (r < I_OUT) { const int kb = r / 32, nb = r % 32; p0_copy_item(ka->in[11] + (size_t)l * DM * DM, DM, 32 * nb, kb < 6 ? ka->in[5] + l * 384 : nullptr, scr, 64 * kb, lane);     p0_store_tile(scr, (bf16*)(wl + W_OUT), DM, 32 * nb, 64 * kb, lane); continue; }
        r -= I_OUT;
        if (r < I_UP) { const int kb = r / 128, nb = r % 128; p0_copy_item(ka->in[13] + (size_t)l * DM * FF, FF, 32 * nb, ka->in[12] + l * DM, scr, 64 * kb, lane); p0_store_tile(scr, (bf16*)(wl + W_UP), DM, 32 * nb, 64 * kb, lane); continue; }
        r -= I_UP;
        { const int kb = r / 32, nb = r % 32; p0_copy_item(ka->in[14] + (size_t)l * FF * DM, DM, 32 * nb, nullptr, scr, 64 * kb, lane); p0_store_tile(scr, (bf16*)(wl + W_DN), FF, 32 * nb, 64 * kb, lane); }
    }
}
__device__ __forceinline__ void p0_rows(const float* x, bf16* hb, float* sspart, int gw, int ngw, int lane) {
    for (int m0 = gw; m0 < MTOK; m0 += 4 * ngw) {
        f32x4 v[4][4];
#pragma unroll
        for (int q = 0; q < 4; ++q) { int m = m0 + q * ngw; m = m < MTOK ? m : m0; const f32x4* xr = (const f32x4*)(x + (size_t)m * DM) + lane;
#pragma unroll
            for (int j = 0; j < 4; ++j) v[q][j] = xr[64 * j]; }
        asm volatile("" : "+v"(v[0][0]), "+v"(v[0][1]), "+v"(v[0][2]), "+v"(v[0][3]), "+v"(v[1][0]), "+v"(v[1][1]), "+v"(v[1][2]), "+v"(v[1][3]),
                         "+v"(v[2][0]), "+v"(v[2][1]), "+v"(v[2][2]), "+v"(v[2][3]), "+v"(v[3][0]), "+v"(v[3][1]), "+v"(v[3][2]), "+v"(v[3][3]));
#pragma unroll
        for (int q = 0; q < 4; ++q) { const int m = m0 + q * ngw; if (m < MTOK) {
            float s = 0.f;
#pragma unroll
            for (int j = 0; j < 4; ++j) s += (v[q][j][0] * v[q][j][0] + v[q][j][1] * v[q][j][1]) + (v[q][j][2] * v[q][j][2] + v[q][j][3] * v[q][j][3]);
            s = wave_sum(s);
            u32x2* o = (u32x2*)(hb + (size_t)m * DM) + lane;
#pragma unroll
            for (int j = 0; j < 4; ++j) { u32x2 w; w.x = cvtpk(v[q][j][0], v[q][j][1]); w.y = cvtpk(v[q][j][2], v[q][j][3]); o[64 * j] = w; }
            if (lane < 16) sspart[(size_t)m * 16 + lane] = s * (1.0f / 16.0f); } }
    }
}
__device__ __forceinline__ void final_rows(float* out, const bf16* hb, const float* sspart, const float* g, int gw, int ngw, int lane) {
    f32x4 gv[4];
#pragma unroll
    for (int j = 0; j < 4; ++j) gv[j] = ((const f32x4*)g)[lane + 64 * j];
    for (int m0 = gw; m0 < MTOK; m0 += 4 * ngw) {
        u32x2 v[4][4]; float ps[4];
#pragma unroll
        for (int q = 0; q < 4; ++q) { int m = m0 + q * ngw; m = m < MTOK ? m : m0; const u32x2* xr = (const u32x2*)(hb + (size_t)m * DM) + lane;
            ps[q] = lane < 16 ? sspart[(size_t)m * 16 + lane] : 0.f;
#pragma unroll
            for (int j = 0; j < 4; ++j) v[q][j] = xr[64 * j]; }
        asm volatile("" : "+v"(v[0][0]), "+v"(v[0][1]), "+v"(v[0][2]), "+v"(v[0][3]), "+v"(v[1][0]), "+v"(v[1][1]), "+v"(v[1][2]), "+v"(v[1][3]),
                         "+v"(v[2][0]), "+v"(v[2][1]), "+v"(v[2][2]), "+v"(v[2][3]), "+v"(v[3][0]), "+v"(v[3][1]), "+v"(v[3][2]), "+v"(v[3][3]), "+v"(ps[0]), "+v"(ps[1]), "+v"(ps[2]), "+v"(ps[3]));
#pragma unroll
        for (int q = 0; q < 4; ++q) { const int m = m0 + q * ngw; if (m < MTOK) {
            const float rs = __builtin_amdgcn_rsqf(wave_sum(ps[q]) * (1.0f / 1024.0f) + EPS);
            f32x4* xr = (f32x4*)(out + (size_t)m * DM) + lane;
#pragma unroll
            for (int j = 0; j < 4; ++j) { f32x4 o; o[0] = bflo(v[q][j].x); o[1] = bfhi(v[q][j].x); o[2] = bflo(v[q][j].y); o[3] = bfhi(v[q][j].y); xr[64 * j] = o * rs * gv[j]; } } }
    }
}

__device__ __forceinline__ void conv_item(const bf16* proj, const float* wdw, const float* bdw, const float* lng, const float* lnb, bf16* mixed, LAS unsigned char* lds, int bc, int tid, int wave, int lane) {
    asm volatile("" : "+v"(lane), "+v"(tid));
    const int c = bc & 63; const size_t tokb = (size_t)(bc >> 6) * SEQ; const int t0 = c * 64;
    LAS float* gl = (LAS float*)lds;
    const int c4 = lane * 4;
    f32x4 wr[31];
#pragma unroll
    for (int j = 0; j < 31; ++j) wr[j] = *(const f32x4*)(wdw + j * 256 + c4);
    const f32x4 bias = *(const f32x4*)(bdw + c4);
    const f32x4 g = *(const f32x4*)(lng + c4), be = *(const f32x4*)(lnb + c4);
    {
        u32x2 av[12], gv[12];
#pragma unroll
        for (int ii = 0; ii < 12; ++ii) { const int idx = tid + ii * 512, row = idx >> 6, c4 = (idx & 63) * 4; int t = t0 - 30 + row; t = t < 0 ? 0 : (row > 93 ? t0 : t);
            const bf16* p = proj + (tokb + t) * LDP + CU + c4; av[ii] = *(const u32x2*)p; gv[ii] = *(const u32x2*)(p + 256); }
        asm volatile("" : "+v"(av[0]), "+v"(av[1]), "+v"(av[2]), "+v"(av[3]), "+v"(av[4]), "+v"(av[5]), "+v"(av[6]), "+v"(av[7]), "+v"(av[8]), "+v"(av[9]), "+v"(av[10]), "+v"(av[11]),
                         "+v"(gv[0]), "+v"(gv[1]), "+v"(gv[2]), "+v"(gv[3]), "+v"(gv[4]), "+v"(gv[5]), "+v"(gv[6]), "+v"(gv[7]), "+v"(gv[8]), "+v"(gv[9]), "+v"(gv[10]), "+v"(gv[11]));
#pragma unroll
        for (int ii = 0; ii < 12; ++ii) { const int idx = tid + ii * 512, row = idx >> 6, c4 = (idx & 63) * 4, t = t0 - 30 + row;
            const u32x2 a = av[ii], g = gv[ii];
            const float a0 = bflo(a.x), a1 = bfhi(a.x), a2 = bflo(a.y), a3 = bfhi(a.y), g0 = bflo(g.x), g1 = bfhi(g.x), g2 = bflo(g.y), g3 = bfhi(g.y);
            f32x4 v; v[0] = a0 / (1.f + __expf(-g0)); v[1] = a1 / (1.f + __expf(-g1)); v[2] = a2 / (1.f + __expf(-g2)); v[3] = a3 / (1.f + __expf(-g3));
            if (t < 0) v = (f32x4){0.f, 0.f, 0.f, 0.f};
            if (row < 94) *(LAS f32x4*)(gl + row * 256 + c4) = v; }
    }
    __syncthreads();
#pragma nounroll
    for (int tq = 0; tq < 2; ++tq) {
        f32x4 acc[4];
#pragma unroll
        for (int to = 0; to < 4; ++to) acc[to] = bias;
        const LAS float* gp = gl + (8 * wave + 4 * tq) * 256 + c4;
#pragma unroll
        for (int rin = 0; rin < 34; ++rin) { const f32x4 x = *(const LAS f32x4*)(gp + rin * 256);
#pragma unroll
            for (int to = 0; to < 4; ++to) { const int j = rin - to; if (j >= 0 && j <= 30) acc[to] += wr[j] * x; }
            if ((rin & 7) == 7) asm volatile("" ::: "memory"); }
#pragma unroll
        for (int to = 0; to < 4; ++to) {
            const f32x4 a = acc[to]; const float mean = wave_sum((a[0] + a[1]) + (a[2] + a[3])) * (1.0f / 256.0f);
            const f32x4 d = a - mean; const float var = wave_sum((d[0] * d[0] + d[1] * d[1]) + (d[2] * d[2] + d[3] * d[3])) * (1.0f / 256.0f);
            const float rs = __builtin_amdgcn_rsqf(var + EPS);
            f32x4 y = d * rs * g + be;
#pragma unroll
            for (int e = 0; e < 4; ++e) y[e] = y[e] / (1.f + __expf(-y[e]));
            u32x2 w; w.x = cvtpk(y[0], y[1]); w.y = cvtpk(y[2], y[3]);
            *(u32x2*)(mixed + (tokb + t0 + 8 * wave + 4 * tq + to) * DM + MIX_CONV + c4) = w;
        }
    }
    __syncthreads();
}

#define GLDS16(gp, lp) __builtin_amdgcn_global_load_lds((const unsigned*)(gp), (LAS unsigned*)(lp), 16, 0, 0)
__device__ __forceinline__ void attn_unit(const bf16* proj, bf16* mixed, const LAS float* biasT, LAS unsigned char* vimg, int u, int lane) {
    asm volatile("" : "+v"(lane));
    const int half = u & 1; int t = u >> 1; const int h = t % 6; t /= 6; const int c = t & 63;
    const int r32 = lane & 31, hi = lane >> 5;
    const size_t tok0 = (size_t)t * 64;
    const int iq = 32 * half + r32;
    const bf16* qp = proj + (tok0 + iq) * LDP + AQ + h * 64 + 8 * hi;
    bf16x8 qf[4];
#pragma unroll
    for (int ks = 0; ks < 4; ++ks) qf[ks] = *(const bf16x8*)(qp + 16 * ks);
    float mrun = -1e30f, lrun = 0.f; f32x16 o0, o1;
#pragma unroll
    for (int r = 0; r < 16; ++r) { o0[r] = 0.f; o1[r] = 0.f; }
    const LAS float* bh = biasT + h * 260;
    const unsigned trb = ((lane >> 4) & 1) * 32 + (lane & 3) * 8 + (4 * hi + ((lane & 15) >> 2)) * 64;
    const float C2 = 0.125f * LOG2E;
    const int w0 = (c < 8 ? 8 - c : 0);
    const unsigned koff = (unsigned)r32 * LDP + 8u * hi;
    const unsigned vdoff = (unsigned)(8 * (lane >> 5) + ((lane & 31) >> 2)) * LDP + 8u * (lane & 3);
    bf16x8 kf[2][4];
    { const bf16* kt = proj + (tok0 - (size_t)(8 - w0) * 64) * LDP + AK + h * 64; const bf16* vt = kt + (AV - AK);
#pragma unroll
      for (int kb = 0; kb < 2; ++kb)
#pragma unroll
          for (int ks = 0; ks < 4; ++ks) kf[kb][ks] = *(const bf16x8*)(kt + (koff + (unsigned)(kb * 32 * LDP + 16 * ks)));
#pragma unroll
      for (int p = 0; p < 8; ++p) GLDS16(vt + (vdoff + (unsigned)((16 * (p & 3)) * LDP + 32 * (p >> 2))), vimg + p * 1024);
      asm volatile("" ::: "memory"); }
    int buf = 0;
    for (int w = w0; w <= 8; ++w) {
        bf16x8 kn[2][4];
        { const int wn = w < 8 ? w + 1 : 8;
          const bf16* kt = proj + (tok0 - (size_t)(8 - wn) * 64) * LDP + AK + h * 64; const bf16* vt = kt + (AV - AK);
          LAS unsigned char* vb = vimg + (buf ^ 1) * 8192;
          LDS_FENCE();
#pragma unroll
          for (int kb = 0; kb < 2; ++kb)
#pragma unroll
              for (int ks = 0; ks < 4; ++ks) kn[kb][ks] = *(const bf16x8*)(kt + (koff + (unsigned)(kb * 32 * LDP + 16 * ks)));
#pragma unroll
          for (int p = 0; p < 8; ++p) GLDS16(vt + (vdoff + (unsigned)((16 * (p & 3)) * LDP + 32 * (p >> 2))), vb + p * 1024);
          asm volatile("" ::: "memory"); }
        f32x16 s0, s1;
#pragma unroll
        for (int r = 0; r < 16; ++r) { s0[r] = 0.f; s1[r] = 0.f; }
#pragma unroll
        for (int ks = 0; ks < 4; ++ks) { s0 = MFMA32(kf[0][ks], qf[ks], s0); s1 = MFMA32(kf[1][ks], qf[ks], s1); }
        const int relb = (8 - w) * 64 + iq;
        float tm = -1e30f;
        if (w <= 5) {
            const float bc = bh[256];
#pragma unroll
            for (int r = 0; r < 16; ++r) { s0[r] = s0[r] * C2 + bc; s1[r] = s1[r] * C2 + bc; tm = fmaxf(tm, fmaxf(s0[r], s1[r])); }
        } else {
            float bv0[16], bv1[16];
#pragma unroll
            for (int r = 0; r < 16; ++r) { const int j0 = crow(r, hi); int i0 = relb - j0, i1 = relb - j0 - 32; i0 = (i0 > 128 ? 128 : i0) + 128; i1 = (i1 > 128 ? 128 : i1) + 128;
                bv0[r] = bh[i0]; bv1[r] = bh[i1]; }
            LDS_FENCE();
#pragma unroll
            for (int r = 0; r < 16; ++r) { s0[r] = s0[r] * C2 + bv0[r]; s1[r] = s1[r] * C2 + bv1[r]; tm = fmaxf(tm, fmaxf(s0[r], s1[r])); }
        }
        tm = fmaxf(tm, __shfl_xor(tm, 32));
        const float mn = fmaxf(mrun, tm); const float sc = __builtin_amdgcn_exp2f(mrun - mn); mrun = mn;
        float ps = 0.f;
#pragma unroll
        for (int r = 0; r < 16; ++r) { s0[r] = __builtin_amdgcn_exp2f(s0[r] - mn); s1[r] = __builtin_amdgcn_exp2f(s1[r] - mn); ps += s0[r] + s1[r]; o0[r] *= sc; o1[r] *= sc; }
        lrun = lrun * sc + ps;
        bf16x8 pf[2][2];
#pragma unroll
        for (int s2 = 0; s2 < 2; ++s2) {
            u32x4 a, b;
            a.x = cvtpk(s0[8 * s2 + 0], s0[8 * s2 + 1]); a.y = cvtpk(s0[8 * s2 + 2], s0[8 * s2 + 3]); a.z = cvtpk(s0[8 * s2 + 4], s0[8 * s2 + 5]); a.w = cvtpk(s0[8 * s2 + 6], s0[8 * s2 + 7]);
            b.x = cvtpk(s1[8 * s2 + 0], s1[8 * s2 + 1]); b.y = cvtpk(s1[8 * s2 + 2], s1[8 * s2 + 3]); b.z = cvtpk(s1[8 * s2 + 4], s1[8 * s2 + 5]); b.w = cvtpk(s1[8 * s2 + 6], s1[8 * s2 + 7]);
            pf[0][s2] = __builtin_bit_cast(bf16x8, a); pf[1][s2] = __builtin_bit_cast(bf16x8, b);
        }
        asm volatile("s_waitcnt vmcnt(16)" ::: "memory");
        const LAS unsigned char* vc = vimg + buf * 8192;
#pragma unroll
        for (int kb = 0; kb < 2; ++kb)
#pragma unroll
            for (int s2 = 0; s2 < 2; ++s2) {
                const unsigned off = (4 * kb + 2 * s2) * 512 + trb;
                const bf16x8 v0 = cat8(trrd(vc + off), trrd(vc + off + 512));
                const bf16x8 v1 = cat8(trrd(vc + 4096 + off), trrd(vc + 4096 + off + 512));
                o0 = MFMA32(v0, pf[kb][s2], o0); o1 = MFMA32(v1, pf[kb][s2], o1);
            }
#pragma unroll
        for (int kb = 0; kb < 2; ++kb)
#pragma unroll
            for (int ks = 0; ks < 4; ++ks) kf[kb][ks] = kn[kb][ks];
        buf ^= 1;
    }
    lrun += __shfl_xor(lrun, 32);
    const float inv = 1.0f / lrun;
    bf16* op = mixed + (tok0 + iq) * DM + MIX_ATT + h * 64 + 4 * hi;
#pragma unroll
    for (int rg = 0; rg < 4; ++rg) {
        u32x2 w0v, w1v;
        w0v.x = cvtpk(o0[4 * rg] * inv, o0[4 * rg + 1] * inv); w0v.y = cvtpk(o0[4 * rg + 2] * inv, o0[4 * rg + 3] * inv);
        w1v.x = cvtpk(o1[4 * rg] * inv, o1[4 * rg + 1] * inv); w1v.y = cvtpk(o1[4 * rg + 2] * inv, o1[4 * rg + 3] * inv);
        *(u32x2*)(op + 8 * rg) = w0v; *(u32x2*)(op + 32 + 8 * rg) = w1v;
    }
    asm volatile("s_waitcnt vmcnt(0) lgkmcnt(0)" ::: "memory");
}

__device__ __forceinline__ void attn_block_unit(const bf16* proj, bf16* mixed, const LAS float* biasT, LAS unsigned char* ring, int u, int wave, int lane) {
    asm volatile("" : "+v"(lane));
    const int h = u % 6; const int bg = u / 6; const int g = bg & 15, b = bg >> 4;
    const int qc = wave >> 1, half = wave & 1;
    const int r32 = lane & 31, hi = lane >> 5;
    const size_t tokg = (size_t)b * SEQ + (size_t)g * 256;
    const int tlo = (g < 2) ? 8 - 4 * g : 0;
    const int ntile = 12 - tlo;
    const unsigned kdo = (unsigned)(32 * (wave >> 2) + r32) * LDP + 16u * (wave & 3) + 8u * hi;
    const unsigned vdo = (unsigned)(16 * (wave & 3) + 8 * hi + (r32 >> 2)) * LDP + 32u * (wave >> 2) + 8u * (lane & 3) + (unsigned)(AV - AK);
#define ATT_ISSUE(t_, st_) do { const bf16* kt_ = proj + (tokg + (size_t)(t_) * 64 - 512) * LDP + AK + h * 64; \
        GLDS16(kt_ + kdo, ring + (st_) * 16384 + wave * 1024); GLDS16(kt_ + vdo, ring + (st_) * 16384 + 8192 + wave * 1024); } while (0)
    const int iq = 32 * half + r32;
    const bf16* qp = proj + (tokg + qc * 64 + iq) * LDP + AQ + h * 64 + 8 * hi;
    bf16x8 qf[4];
#pragma unroll
    for (int ks = 0; ks < 4; ++ks) qf[ks] = *(const bf16x8*)(qp + 16 * ks);
    asm volatile("" ::: "memory");
    { const float C2q = 0.125f * LOG2E;
#pragma unroll
      for (int ks = 0; ks < 4; ++ks) { u32x4 q4 = __builtin_bit_cast(u32x4, qf[ks]);
#pragma unroll
          for (int e = 0; e < 4; ++e) q4[e] = cvtpk(bflo(q4[e]) * C2q, bfhi(q4[e]) * C2q);
          qf[ks] = __builtin_bit_cast(bf16x8, q4); } }
    ATT_ISSUE(tlo, 0); ATT_ISSUE(tlo + 1, 1); ATT_ISSUE(tlo + 2, 2);
    asm volatile("" ::: "memory");
    float mrun = -1e30f, lrun = 0.f; f32x16 o0, o1;
#pragma unroll
    for (int r = 0; r < 16; ++r) { o0[r] = 0.f; o1[r] = 0.f; }
    const LAS float* bh = biasT + h * 260;
    const unsigned trb = ((lane >> 4) & 1) * 32 + (lane & 3) * 8 + (4 * hi + ((lane & 15) >> 2)) * 64;
    for (int j = 0; j < ntile; ++j) {
        const int left = ntile - 1 - j;
        if (left >= 2) asm volatile("s_waitcnt vmcnt(4) lgkmcnt(0)\n\ts_barrier" ::: "memory");
        else if (left == 1) asm volatile("s_waitcnt vmcnt(2) lgkmcnt(0)\n\ts_barrier" ::: "memory");
        else asm volatile("s_waitcnt vmcnt(0) lgkmcnt(0)\n\ts_barrier" ::: "memory");
        if (j + 3 < ntile) { ATT_ISSUE(tlo + j + 3, (j + 3) & 3); }
        asm volatile("" ::: "memory");
        const int w = tlo + j - qc;
        if (w >= 0 && w <= 8) {
            const LAS unsigned char* kc = ring + (j & 3) * 16384; const LAS unsigned char* vc = kc + 8192;
            bf16x8 kf[2][4];
#pragma unroll
            for (int kb = 0; kb < 2; ++kb)
#pragma unroll
                for (int ks = 0; ks < 4; ++ks) kf[kb][ks] = *(const LAS bf16x8*)(kc + (kb * 4 + ks) * 1024 + 16 * lane);
            f32x16 s0, s1;
#pragma unroll
            for (int r = 0; r < 16; ++r) { s0[r] = 0.f; s1[r] = 0.f; }
#pragma unroll
            for (int ks = 0; ks < 4; ++ks) { s0 = MFMA32(kf[0][ks], qf[ks], s0); s1 = MFMA32(kf[1][ks], qf[ks], s1); }
            const int relb = (8 - w) * 64 + iq;
            float tm = -1e30f, boff = 0.f;
            if (w <= 5) {
                boff = bh[256];
#pragma unroll
                for (int r = 0; r < 16; ++r) tm = fmaxf(tm, fmaxf(s0[r], s1[r]));
                tm += boff;
            } else {
                float bv0[16], bv1[16];
#pragma unroll
                for (int r = 0; r < 16; ++r) { const int j0 = crow(r, hi); int i0 = relb - j0, i1 = relb - j0 - 32; i0 = (i0 > 128 ? 128 : i0) + 128; i1 = (i1 > 128 ? 128 : i1) + 128;
                    bv0[r] = bh[i0]; bv1[r] = bh[i1]; }
#pragma unroll
                for (int r = 0; r < 16; ++r) { s0[r] += bv0[r]; s1[r] += bv1[r]; tm = fmaxf(tm, fmaxf(s0[r], s1[r])); }
            }
            tm = fmaxf(tm, __shfl_xor(tm, 32));
            if (__any(tm > mrun + 8.0f)) {
                const float mn = fmaxf(mrun, tm); const float sc = __builtin_amdgcn_exp2f(mrun - mn); mrun = mn; lrun *= sc;
#pragma unroll
                for (int r = 0; r < 16; ++r) { o0[r] *= sc; o1[r] *= sc; }
            }
            const float sub = mrun - boff;
            float ps = 0.f;
#pragma unroll
            for (int r = 0; r < 16; ++r) { s0[r] = __builtin_amdgcn_exp2f(s0[r] - sub); s1[r] = __builtin_amdgcn_exp2f(s1[r] - sub); ps += s0[r] + s1[r]; }
            lrun += ps;
            bf16x8 pf[2][2];
#pragma unroll
            for (int s2 = 0; s2 < 2; ++s2) {
                u32x4 a, bb;
                a.x = cvtpk(s0[8 * s2 + 0], s0[8 * s2 + 1]); a.y = cvtpk(s0[8 * s2 + 2], s0[8 * s2 + 3]); a.z = cvtpk(s0[8 * s2 + 4], s0[8 * s2 + 5]); a.w = cvtpk(s0[8 * s2 + 6], s0[8 * s2 + 7]);
                bb.x = cvtpk(s1[8 * s2 + 0], s1[8 * s2 + 1]); bb.y = cvtpk(s1[8 * s2 + 2], s1[8 * s2 + 3]); bb.z = cvtpk(s1[8 * s2 + 4], s1[8 * s2 + 5]); bb.w = cvtpk(s1[8 * s2 + 6], s1[8 * s2 + 7]);
                pf[0][s2] = __builtin_bit_cast(bf16x8, a); pf[1][s2] = __builtin_bit_cast(bf16x8, bb);
            }
#pragma unroll
            for (int kb = 0; kb < 2; ++kb)
#pragma unroll
                for (int s2 = 0; s2 < 2; ++s2) {
                    const unsigned off = (4 * kb + 2 * s2) * 512 + trb;
                    const bf16x8 v0 = cat8(trrd(vc + off), trrd(vc + off + 512));
                    const bf16x8 v1 = cat8(trrd(vc + 4096 + off), trrd(vc + 4096 + off + 512));
                    o0 = MFMA32(v0, pf[kb][s2], o0); o1 = MFMA32(v1, pf[kb][s2], o1);
                }
        }
    }
#undef ATT_ISSUE
    lrun += __shfl_xor(lrun, 32);
    const float inv = 1.0f / lrun;
    bf16* op = mixed + (tokg + qc * 64 + iq) * DM + MIX_ATT + h * 64 + 4 * hi;
#pragma unroll
    for (int rg = 0; rg < 4; ++rg) {
        u32x2 w0v, w1v;
        w0v.x = cvtpk(o0[4 * rg] * inv, o0[4 * rg + 1] * inv); w0v.y = cvtpk(o0[4 * rg + 2] * inv, o0[4 * rg + 3] * inv);
        w1v.x = cvtpk(o1[4 * rg] * inv, o1[4 * rg + 1] * inv); w1v.y = cvtpk(o1[4 * rg + 2] * inv, o1[4 * rg + 3] * inv);
        *(u32x2*)(op + 8 * rg) = w0v; *(u32x2*)(op + 32 + 8 * rg) = w1v;
    }
    asm volatile("s_waitcnt lgkmcnt(0)\n\ts_barrier" ::: "memory");
}

__device__ __forceinline__ void gla_kv_item(const bf16* proj, const float* bgate, float* kvT, float* decay, LAS unsigned char* vimg, int it, int lane) {
    asm volatile("" : "+v"(lane));
    const int h = it & 3; const size_t tok0 = (size_t)(it >> 2) * 64;
    const int r32 = lane & 31, hi = lane >> 5;
    LDS_FENCE();
    {
        const int kc = lane < 48 ? lane : 47;
        const bf16* zp = proj + tok0 * LDP + GZ + h * 48 + kc; const bf16* kp = proj + tok0 * LDP + GK + h * 48 + kc;
        const float bz = bgate[h * 48 + kc];
        float suf = 0.f;
#pragma unroll
        for (int hb2 = 1; hb2 >= 0; --hb2) {
            bf16 zr[32], kr[32];
#pragma unroll
            for (int i = 0; i < 32; ++i) { zr[i] = zp[(size_t)(32 * hb2 + i) * LDP]; kr[i] = kp[(size_t)(32 * hb2 + i) * LDP]; }
            asm volatile("" ::: "memory");
#pragma unroll
            for (int i = 31; i >= 0; --i) { const int t = 32 * hb2 + i;
                const float z = bf2f(zr[i]) + bz, kk = bf2f(kr[i]);
                const float la = (fminf(z, 0.f) - __logf(1.f + __expf(-fabsf(z)))) * (1.0f / 16.0f);
                const float kd = kk * __expf(suf); suf += la;
                *(LAS bf16*)(vimg + lane * 144 + t * 2) = (bf16)(cvtpk(kd, 0.f) & 0xffffu); }
        }
        if (lane < 48) decay[(size_t)it * 48 + kc] = __expf(suf);
    }
    LDS_FENCE();
    bf16x8 kfr[2][4];
#pragma unroll
    for (int kb = 0; kb < 2; ++kb)
#pragma unroll
        for (int s = 0; s < 4; ++s) { const int kc = 32 * kb + r32; const int kcc = kc < 48 ? kc : 47;
            u32x4 a = *(const LAS u32x4*)(vimg + kcc * 144 + (16 * s + 8 * hi) * 2);
            if (kc >= 48) a = (u32x4){0u, 0u, 0u, 0u};
            kfr[kb][s] = __builtin_bit_cast(bf16x8, a); }
    LDS_FENCE();
    { u32x4 val[12];
#pragma unroll
      for (int i = 0; i < 12; ++i) { const int id = i * 64 + lane, t = id / 12, ch = id - 12 * t; val[i] = *(const u32x4*)(proj + (tok0 + t) * LDP + GV + h * 96 + 8 * ch); }
      asm volatile("" : "+v"(val[0]), "+v"(val[1]), "+v"(val[2]), "+v"(val[3]), "+v"(val[4]), "+v"(val[5]), "+v"(val[6]), "+v"(val[7]), "+v"(val[8]), "+v"(val[9]), "+v"(val[10]), "+v"(val[11]));
#pragma unroll
      for (int i = 0; i < 12; ++i) { const int id = i * 64 + lane, t = id / 12, ch = id - 12 * t; *(LAS u32x4*)(vimg + (ch >> 2) * 4096 + (t >> 3) * 512 + (t & 7) * 64 + (ch & 3) * 16) = val[i]; } }
    f32x16 acc[3][2];
#pragma unroll
    for (int vb = 0; vb < 3; ++vb)
#pragma unroll
        for (int kb = 0; kb < 2; ++kb)
#pragma unroll
            for (int r = 0; r < 16; ++r) acc[vb][kb][r] = 0.f;
    LDS_FENCE();
    const unsigned trb = ((lane >> 4) & 1) * 32 + (lane & 3) * 8 + ((lane & 15) >> 2) * 64 + hi * 512;
#pragma unroll
    for (int s = 0; s < 4; ++s)
#pragma unroll
        for (int vb = 0; vb < 3; ++vb) { const unsigned off = vb * 4096 + (2 * s) * 512 + trb;
            const bf16x8 vf = cat8(trrd(vimg + off), trrd(vimg + off + 256));
            acc[vb][0] = MFMA32(vf, kfr[0][s], acc[vb][0]); acc[vb][1] = MFMA32(vf, kfr[1][s], acc[vb][1]); }
    float* dst = kvT + (size_t)it * 4608;
#pragma unroll
    for (int vb = 0; vb < 3; ++vb)
#pragma unroll
        for (int r = 0; r < 16; ++r) { const int v = 32 * vb + crow(r, hi);
            dst[v * 48 + r32] = acc[vb][0][r];
            if (r32 < 16) dst[v * 48 + 32 + r32] = acc[vb][1][r]; }
    LDS_FENCE();
}
__device__ __forceinline__ void gla_scan(const float* kvT, const float* decay, bf16* St, int gtid, int nthr) {
    for (int e = gtid; e < 32 * 4608; e += nthr) {
        const int bh = e / 4608, rem = e - bh * 4608, k = rem % 48, b = bh >> 2, h = bh & 3;
        float st = 0.f;
#pragma nounroll
        for (int c0 = 0; c0 < 64; c0 += 16) {
            float kv[16], dc[16];
#pragma unroll
            for (int j = 0; j < 16; ++j) { const size_t it = (size_t)(((b * 64 + c0 + j) << 2) + h); kv[j] = kvT[it * 4608 + rem]; dc[j] = decay[it * 48 + k]; }
            asm volatile("" : "+v"(kv[0]), "+v"(kv[1]), "+v"(kv[2]), "+v"(kv[3]), "+v"(kv[4]), "+v"(kv[5]), "+v"(kv[6]), "+v"(kv[7]), "+v"(kv[8]), "+v"(kv[9]), "+v"(kv[10]), "+v"(kv[11]), "+v"(kv[12]), "+v"(kv[13]), "+v"(kv[14]), "+v"(kv[15]),
                             "+v"(dc[0]), "+v"(dc[1]), "+v"(dc[2]), "+v"(dc[3]), "+v"(dc[4]), "+v"(dc[5]), "+v"(dc[6]), "+v"(dc[7]), "+v"(dc[8]), "+v"(dc[9]), "+v"(dc[10]), "+v"(dc[11]), "+v"(dc[12]), "+v"(dc[13]));
#pragma unroll
            for (int j = 0; j < 16; ++j) { const size_t it = (size_t)(((b * 64 + c0 + j) << 2) + h); st = dc[j] * st + kv[j]; St[it * 4608 + rem] = (bf16)(cvtpk(st, 0.f) & 0xffffu); }
        }
    }
}
__device__ __forceinline__ void gla_out_item(const bf16* proj, const bf16* St, bf16* mixed, int it, int lane) {
    asm volatile("" : "+v"(lane));
    const int h = it & 3; const size_t tok0 = (size_t)(it >> 2) * 64;
    const int r32 = lane & 31, hi = lane >> 5;
    bf16x8 af[3][3], bq[2][3]; u32x2 gg[2][3][4];
#pragma unroll
    for (int vb = 0; vb < 3; ++vb)
#pragma unroll
        for (int ks = 0; ks < 3; ++ks) af[vb][ks] = *(const bf16x8*)(St + (size_t)it * 4608 + (32 * vb + r32) * 48 + 16 * ks + 8 * hi);
#pragma unroll
    for (int tb = 0; tb < 2; ++tb)
#pragma unroll
        for (int ks = 0; ks < 3; ++ks) bq[tb][ks] = *(const bf16x8*)(proj + (tok0 + 32 * tb + r32) * LDP + GQ + h * 48 + 16 * ks + 8 * hi);
#pragma unroll
    for (int tb = 0; tb < 2; ++tb)
#pragma unroll
        for (int vb = 0; vb < 3; ++vb)
#pragma unroll
            for (int rg = 0; rg < 4; ++rg) gg[tb][vb][rg] = *(const u32x2*)(proj + (tok0 + 32 * tb + r32) * LDP + GG + h * 96 + 32 * vb + 8 * rg + 4 * hi);
    asm volatile("" : "+v"(af[0][0]), "+v"(af[0][1]), "+v"(af[0][2]), "+v"(af[1][0]), "+v"(af[1][1]), "+v"(af[1][2]), "+v"(af[2][0]), "+v"(af[2][1]), "+v"(af[2][2]),
                     "+v"(bq[0][0]), "+v"(bq[0][1]), "+v"(bq[0][2]), "+v"(bq[1][0]), "+v"(bq[1][1]), "+v"(bq[1][2]));
    f32x16 acc[3][2];
#pragma unroll
    for (int vb = 0; vb < 3; ++vb)
#pragma unroll
        for (int tb = 0; tb < 2; ++tb)
#pragma unroll
            for (int r = 0; r < 16; ++r) acc[vb][tb][r] = 0.f;
#pragma unroll
    for (int ks = 0; ks < 3; ++ks)
#pragma unroll
        for (int vb = 0; vb < 3; ++vb)
#pragma unroll
            for (int tb = 0; tb < 2; ++tb) acc[vb][tb] = MFMA32(af[vb][ks], bq[tb][ks], acc[vb][tb]);
    const float QS = 0.14433756729740643f;
#pragma unroll
    for (int tb = 0; tb < 2; ++tb) {
        float ss = 0.f;
#pragma unroll
        for (int vb = 0; vb < 3; ++vb)
#pragma unroll
            for (int r = 0; r < 16; ++r) { const float x = acc[vb][tb][r] * QS; acc[vb][tb][r] = x; ss += x * x; }
        ss += __shfl_xor(ss, 32);
        const float rn = __builtin_amdgcn_rsqf(ss * (1.0f / 96.0f) + EPS);
        const size_t tok = tok0 + 32 * tb + r32;
#pragma unroll
        for (int vb = 0; vb < 3; ++vb)
#pragma unroll
            for (int rg = 0; rg < 4; ++rg) { const int v0 = 32 * vb + 8 * rg + 4 * hi; const u32x2 g = gg[tb][vb][rg];
                const float g0 = bflo(g.x), g1 = bfhi(g.x), g2 = bflo(g.y), g3 = bfhi(g.y);
                const float y0 = acc[vb][tb][4 * rg + 0] * rn * (g0 / (1.f + __expf(-g0)));
                const float y1 = acc[vb][tb][4 * rg + 1] * rn * (g1 / (1.f + __expf(-g1)));
                const float y2 = acc[vb][tb][4 * rg + 2] * rn * (g2 / (1.f + __expf(-g2)));
                const float y3 = acc[vb][tb][4 * rg + 3] * rn * (g3 / (1.f + __expf(-g3)));
                u32x2 w; w.x = cvtpk(y0, y1); w.y = cvtpk(y2, y3);
                *(u32x2*)(mixed + tok * DM + MIX_GLA + h * 96 + v0) = w; }
    }
}
#define XB_TMO      128
#define XB_XCNT(j)  (256  + 64 * (j))
#define XB_XSUB(j)  (1280 + 64 * (j))
#define XB_XGEN(j)  (2304 + 64 * (j))
#define XB_TOP      3328
#define XB_TOPGEN   3392
#define XCD_BAR_WORDS 3456
#define XB_SPIN_CAP (1u << 18)

__device__ __forceinline__ unsigned xb_ld(unsigned* p)              { return __hip_atomic_load(p, __ATOMIC_RELAXED, __HIP_MEMORY_SCOPE_AGENT); }
__device__ __forceinline__ unsigned xb_add(unsigned* p, unsigned v) { return __hip_atomic_fetch_add(p, v, __ATOMIC_RELAXED, __HIP_MEMORY_SCOPE_AGENT); }
__device__ __forceinline__ unsigned xb_xcc_id() { return (unsigned)__builtin_amdgcn_s_getreg((3 << 11) | 20) & 0xFu; }
#define XB_SPIN(cond, bar) do { unsigned _sp = 0; while (cond) { __builtin_amdgcn_s_sleep(1); \
    if ((++_sp & 255u) == 0u) { if (xb_ld(&(bar)[XB_TMO])) break; if (_sp > XB_SPIN_CAP) { atomicAdd(&(bar)[XB_TMO], 1u); break; } } } } while (0)

struct XcdBarrier {
    unsigned* bar; unsigned x;
    volatile LAS unsigned* st;
};

__device__ __forceinline__ XcdBarrier xcd_barrier_post(unsigned* bar, volatile LAS unsigned* st) {
    XcdBarrier b; b.bar = bar; b.x = xb_xcc_id(); b.st = st;
    if (threadIdx.x == 0) (void)xb_add(&bar[XB_XCNT(b.x)], 1u);
    return b;
}
__device__ __forceinline__ void xcd_barrier_complete(unsigned* bar, unsigned x, unsigned& nloc, unsigned& nx) {
    const unsigned G = gridDim.x * gridDim.y * gridDim.z;
    unsigned sum, cnt, mine, sp = 0u;
    for (;;) {
        sum = 0u; cnt = 0u; mine = 0u;
#pragma unroll
        for (unsigned j = 0; j < 16; ++j) { const unsigned c = xb_ld(&bar[XB_XCNT(j)]); sum += c; cnt += (c > 0u) ? 1u : 0u; mine = (j == x) ? c : mine; }
        if (sum == G) break;
        __builtin_amdgcn_s_sleep(1);
        if ((++sp & 255u) == 0u) { if (xb_ld(&bar[XB_TMO])) break; if (sp > XB_SPIN_CAP) { atomicAdd(&bar[XB_TMO], 1u); break; } }
    }
    nloc = mine > 0u ? mine : 1u; nx = cnt > 0u ? cnt : 1u;
}

__device__ __forceinline__ void xcd_barrier(const XcdBarrier& b) {
    asm volatile("s_waitcnt vmcnt(0)" ::: "memory");
    __syncthreads();
    if (threadIdx.x == 0) {
        unsigned* bar = b.bar;
        __builtin_amdgcn_s_waitcnt(0);
        unsigned nloc = b.st[0], nx = b.st[1];
        if (nloc == 0u) { xcd_barrier_complete(bar, b.x, nloc, nx); b.st[0] = nloc; b.st[1] = nx; }
        const unsigned old = xb_add(&bar[XB_XSUB(b.x)], 1u);
        const unsigned gen = old / nloc;
        if (old + 1u == (gen + 1u) * nloc) {
            __builtin_amdgcn_fence(__ATOMIC_RELEASE, "agent");
            asm volatile("s_waitcnt vmcnt(0)" ::: "memory");
            const unsigned og = xb_add(&bar[XB_TOP], 1u);
            const unsigned tg = og / nx;
            if (og + 1u == (tg + 1u) * nx) xb_add(&bar[XB_TOPGEN], 1u);
            else XB_SPIN(xb_ld(&bar[XB_TOPGEN]) == tg, bar);
            __builtin_amdgcn_fence(__ATOMIC_ACQUIRE, "agent");
            xb_add(&bar[XB_XGEN(b.x)], 1u);
            asm volatile("s_waitcnt vmcnt(0)" ::: "memory");
        } else {
            XB_SPIN(xb_ld(&bar[XB_XGEN(b.x)]) == gen, bar);
            __builtin_amdgcn_fence(__ATOMIC_ACQUIRE, "agent");
            asm volatile("s_waitcnt vmcnt(0)" ::: "memory");
        }
    }
    __syncthreads();
}

#define KARGS() ({ CArgs* p_ = (CArgs*)__builtin_amdgcn_kernarg_segment_ptr(); size_t z_ = 0; asm volatile("" : "+s"(z_)); p_ + z_; })

__global__ void __launch_bounds__(NWAVES * 64, 2) mega_fwd(Args a) {
    extern __shared__ __attribute__((aligned(16))) unsigned char lds_raw[];
    cg::grid_group grid = cg::this_grid();
    LAS unsigned char* lds = (LAS unsigned char*)lds_raw;
    const int tid = threadIdx.x, lane = tid & 63, wave = __builtin_amdgcn_readfirstlane(tid >> 6);
    const int G = gridDim.x, bx = blockIdx.x;
    const int gw = bx * NWAVES + wave, ngw = G * NWAVES;
    unsigned char* ws = a.ws;
    bf16* hb = (bf16*)(ws + WS_HB); bf16* proj = (bf16*)(ws + WS_PROJ); bf16* mixed = (bf16*)(ws + WS_MIX); bf16* ffb = (bf16*)(ws + WS_FF);
    float* sspart = (float*)(ws + WS_SS); float* kvT = (float*)(ws + WS_KVT); float* decay = (float*)(ws + WS_DEC); bf16* St = (bf16*)(ws + WS_ST);
    float* out = a.out;
#if USE_XCD
    volatile LAS unsigned* MISC = (volatile LAS unsigned*)(lds + 143360);
    if (tid < 32) MISC[tid] = 0u;
    __syncthreads();
    XcdBarrier bar = xcd_barrier_post((unsigned*)(ws + WS_CTL) + 4096, MISC + 8);
#define GSYNC() xcd_barrier(bar)
#else
#define GSYNC() do { __threadfence(); grid.sync(); } while (0)
#endif

#ifndef REP_P0
#define REP_P0 1
#endif
#ifndef REP_B1
#define REP_B1 1
#endif
#ifndef REP_B23
#define REP_B23 1
#endif
#pragma nounroll
    for (int rep = 0; rep < REP_P0; ++rep) {
#if WSTAG
    p0_weights(KARGS(), (LAS float*)(lds + wave * 16384), 0, 1536, gw, ngw, lane);
    p0_weights(KARGS(), (LAS float*)(lds + wave * 16384), 2048, 4096, gw, ngw, lane);
    p0_weights(KARGS(), (LAS float*)(lds + wave * 16384), 6144, 7680, gw, ngw, lane);
    p0_weights(KARGS(), (LAS float*)(lds + wave * 16384), 8192, 10240, gw, ngw, lane);
#else
    p0_weights(KARGS(), (LAS float*)(lds + wave * 16384), 0, 12288, gw, ngw, lane);
#endif
    p0_rows(a.in[0], hb, sspart, gw, ngw, lane);
    }
#if USE_XCD
    if (G == 0x7fffffff) grid.sync();
    GSYNC();
#else
    __threadfence(); grid.sync();
#endif

#ifndef STAG_A
#define STAG_A 0
#endif
#ifndef STAG_D
#define STAG_D 0
#endif
#define STAGGER_WORK(lo_, hi_) do { if (WSTAG) { if (bx & 1) { int lane_s = threadIdx.x & 63; asm volatile("" : "+v"(lane_s)); \
        p0_weights(KARGS(), (LAS float*)(lds + wave * 16384), (lo_), (hi_), (bx >> 1) * NWAVES + wave, (G >> 1) * NWAVES, lane_s); } __syncthreads(); } } while (0)
#define LAUNDER(p) do { size_t z_ = 0; asm volatile("" : "+s"(z_)); (p) = (p) + z_; } while (0)
#pragma nounroll
    for (int l = 0; l < 2; ++l) {
        const unsigned char* wl = KARGS()->ws + WS_W + (size_t)l * W_LAYER;
#ifndef REP_GA
#define REP_GA 1
#endif
#ifndef REP_GD
#define REP_GD 1
#endif
#pragma nounroll
        for (int rg = 0; rg < REP_GA; ++rg) { const bf16* gA = ((bf16*)(KARGS()->ws + WS_HB)); const bf16* gB = (const bf16*)(wl + W_IN); LAUNDER(gA); LAUNDER(gB);
          STAGGER_WORK(l == 0 ? 1536 : 7680, l == 0 ? 2048 : 8192);
          pg8::Gemm g{gA, gB, MTOK, LDP, DM}; pg8::StaticOrder S; S.init(MTOK, LDP, G, bx);
#if PROBE_DRY
          if (rg + 1 < REP_GA) { pg8::EpiScaleBf16<0, true> E{((bf16*)(KARGS()->ws + WS_PROJ)), LDP, ((float*)(KARGS()->ws + WS_SS))};
          pg8::gemm_phase<pg8::EpiScaleBf16<0, true>, pg8::StaticOrder, true, true>(lds, g, S, E); } else
#endif
          { pg8::EpiScaleBf16<0> E{((bf16*)(KARGS()->ws + WS_PROJ)), LDP, ((float*)(KARGS()->ws + WS_SS))};
          pg8::gemm_phase<pg8::EpiScaleBf16<0>, pg8::StaticOrder, true, true>(lds, g, S, E); } }
        GSYNC();
        { bf16* projL = ((bf16*)(KARGS()->ws + WS_PROJ)); bf16* mixedL = ((bf16*)(KARGS()->ws + WS_MIX)); float* kvTL = ((float*)(KARGS()->ws + WS_KVT)); float* decayL = ((float*)(KARGS()->ws + WS_DEC)); bf16* StL = ((bf16*)(KARGS()->ws + WS_ST)); LAUNDER(projL); LAUNDER(mixedL); LAUNDER(kvTL); LAUNDER(decayL); LAUNDER(StL);
#pragma nounroll
        for (int rep = 0; rep < REP_B1; ++rep) {
#ifndef REP_CONV
#define REP_CONV 1
#endif
#ifndef REP_KV
#define REP_KV 1
#endif
#ifndef REP_ATT
#define REP_ATT 1
#endif
#ifndef REP_SCAN
#define REP_SCAN 1
#endif
#ifndef REP_OUT
#define REP_OUT 1
#endif
#ifndef NO_CONV
#pragma nounroll
        for (int rc = 0; rc < REP_CONV; ++rc)
        for (int bc = bx; bc < 512; bc += G)
            conv_item(projL, KARGS()->in[6] + l * 31 * 256, KARGS()->in[7] + l * 256, KARGS()->in[8] + l * 256, KARGS()->in[9] + l * 256, mixedL, lds, bc, tid, wave, lane);
#endif
        {
            LAS float* biasT = (LAS float*)(lds + 131072);
            int tidb = threadIdx.x; asm volatile("" : "+v"(tidb));
            for (int i = tidb; i < 6 * 257; i += NWAVES * 64) { const int hh = i / 257, j = i - hh * 257; biasT[hh * 260 + j] = KARGS()->in[10][(size_t)l * 6 * 257 + i] * LOG2E; }
            __syncthreads();
            LAS unsigned char* vimg = lds + wave * 16384;
#ifndef NO_GLAKV
#pragma nounroll
            for (int rc = 0; rc < REP_KV; ++rc)
            for (int it = gw; it < 2048; it += ngw) gla_kv_item(projL, KARGS()->in[4] + l * 192, kvTL, decayL, vimg, it, lane);
#endif
#ifndef NO_ATT
#pragma nounroll
            for (int rc = 0; rc < REP_ATT; ++rc)
#if ATT_BLOCK
            __syncthreads();
            for (int u = bx; u < 768; u += G) attn_block_unit(projL, mixedL, biasT, lds, u, wave, lane);
#else
            for (int u = gw; u < 6144; u += ngw) attn_unit(projL, mixedL, biasT, vimg, u, lane);
#endif
#endif
        }
        __syncthreads();
        }
        GSYNC();
#pragma nounroll
        for (int rep = 0; rep < REP_B23; ++rep) {
        LAUNDER(kvTL); LAUNDER(decayL); LAUNDER(StL);
#pragma nounroll
        for (int rc = 0; rc < REP_SCAN; ++rc)
        { int tids = threadIdx.x; asm volatile("" : "+v"(tids)); gla_scan(kvTL, decayL, StL, bx * (NWAVES * 64) + tids, G * NWAVES * 64); }
        GSYNC();
        LAUNDER(projL); LAUNDER(mixedL); LAUNDER(StL);
#ifndef NO_GLAOUT
#pragma nounroll
        for (int rc = 0; rc < REP_OUT; ++rc)
        for (int it = gw; it < 2048; it += ngw) gla_out_item(projL, StL, mixedL, it, lane);
#endif
        GSYNC();
        }
        }
#ifndef REP_GC
#define REP_GC 1
#endif
#ifndef REP_GE
#define REP_GE 1
#endif
        { const bf16* gA = ((bf16*)(KARGS()->ws + WS_MIX)); const bf16* gB = (const bf16*)(wl + W_OUT); LAUNDER(gA); LAUNDER(gB);
          pg8::Gemm g{gA, gB, MTOK, DM, DM}; pg8::StaticOrder S; S.init(MTOK, DM, G, bx);
          pg8::EpiResid E{((bf16*)(KARGS()->ws + WS_HB)), ((float*)(KARGS()->ws + WS_SS))};
          pg8::gemm_phase<pg8::EpiResid, pg8::StaticOrder, true, true>(lds, g, S, E); }
        GSYNC();
#pragma nounroll
        for (int rg = 0; rg < REP_GD; ++rg) { const bf16* gA = ((bf16*)(KARGS()->ws + WS_HB)); const bf16* gB = (const bf16*)(wl + W_UP); LAUNDER(gA); LAUNDER(gB);
          STAGGER_WORK(l == 0 ? 4096 : 10240, l == 0 ? 6144 : 12288);
          pg8::Gemm g{gA, gB, MTOK, FF, DM}; pg8::StaticOrder S; S.init(MTOK, FF, G, bx);
          pg8::EpiScaleBf16<1> E{((bf16*)(KARGS()->ws + WS_FF)), FF, ((float*)(KARGS()->ws + WS_SS))};
          pg8::gemm_phase<pg8::EpiScaleBf16<1>, pg8::StaticOrder, true, true>(lds, g, S, E); }
        GSYNC();
        { const bf16* gA = ((bf16*)(KARGS()->ws + WS_FF)); const bf16* gB = (const bf16*)(wl + W_DN); LAUNDER(gA); LAUNDER(gB);
          pg8::Gemm g{gA, gB, MTOK, DM, FF}; pg8::StaticOrder S; S.init(MTOK, DM, G, bx);
          pg8::EpiResid E{((bf16*)(KARGS()->ws + WS_HB)), ((float*)(KARGS()->ws + WS_SS))};
          pg8::gemm_phase<pg8::EpiResid, pg8::StaticOrder, true, true>(lds, g, S, E); }
        GSYNC();
    }
    { int lane2 = tid & 63; asm volatile("" : "+v"(lane2)); final_rows((KARGS()->out), ((bf16*)(KARGS()->ws + WS_HB)), ((float*)(KARGS()->ws + WS_SS)), KARGS()->in[15], gw, ngw, lane2); }
}

extern "C" void kernel_launch(void* const* d_in, const int* in_sizes, int n_in, void* d_out, int out_size, void* d_ws, size_t ws_size, hipStream_t stream) {
    static int grid = 0;
    if (grid == 0) {
        if (n_in != 16 || in_sizes[0] != MTOK * DM || out_size != MTOK * DM || ws_size < WS_END) { fprintf(stderr, "kernel_launch: unexpected shapes (n_in %d, ws %zu)\n", n_in, ws_size); grid = -1; return; }
        int dev = 0, cus = 0, per_cu = 0;
        if (hipGetDevice(&dev) != hipSuccess || hipDeviceGetAttribute(&cus, hipDeviceAttributeMultiprocessorCount, dev) != hipSuccess) { grid = -1; return; }
        if (hipFuncSetAttribute((const void*)mega_fwd, hipFuncAttributeMaxDynamicSharedMemorySize, LDS_BYTES) != hipSuccess) { fprintf(stderr, "kernel_launch: hipFuncSetAttribute failed\n"); grid = -1; return; }
        if (hipOccupancyMaxActiveBlocksPerMultiprocessor(&per_cu, (const void*)mega_fwd, NWAVES * 64, LDS_BYTES) != hipSuccess || per_cu < 1) { fprintf(stderr, "kernel_launch: occupancy query says %d blocks per CU\n", per_cu); (void)hipGetLastError(); grid = -1; return; }
        grid = cus;
    }
    if (grid < 0) return;
#if USE_XCD
    if (hipMemsetAsync((char*)d_ws + WS_CTL, 0, 65536, stream) != hipSuccess) { fprintf(stderr, "kernel_launch: memset failed\n"); return; }
#endif
    Args a{};
    for (int i = 0; i < 16; ++i) a.in[i] = (const float*)d_in[i];
    a.out = (float*)d_out; a.ws = (unsigned char*)d_ws;
    void* args[] = {&a};
    const hipError_t e = hipLaunchCooperativeKernel((const void*)mega_fwd, dim3(grid), dim3(NWAVES * 64), args, LDS_BYTES, stream);
    if (e != hipSuccess) fprintf(stderr, "kernel_launch: cooperative launch failed: %s (grid %d)\n", hipGetErrorString(e), grid);
}
```

```cpp
#include <hip/hip_runtime.h>
#include <hip/hip_cooperative_groups.h>
#include <cstdio>
#include <cstdint>
namespace cg = cooperative_groups;
#ifndef USE_XCD
#define USE_XCD 1
#endif
#ifndef PROBE_DRY
#define PROBE_DRY 0
#endif
#define STAG_A 0
#define STAG_D 0
#ifndef PG_SP2
#define PG_SP2 true
#endif
#ifndef ATT_IGLP
#define ATT_IGLP -1
#endif
#ifndef STREAM_NT
#define STREAM_NT 1
#endif
#ifndef WSTAG
#define WSTAG 1
#endif
#ifndef ATT_BLOCK
#define ATT_BLOCK 1
#endif
#ifndef ATT_PAIR
#define ATT_PAIR 1
#endif
#if ATT_PAIR
#define ATT_UNIT_FN attn_pair_unit
#else
#define ATT_UNIT_FN attn_block_unit
#endif
namespace pg8 {
#define PG8_LAS __attribute__((address_space(3)))
typedef unsigned short bf16_t;
typedef short bf16x8 __attribute__((ext_vector_type(8)));
typedef float f32x4 __attribute__((ext_vector_type(4)));
typedef unsigned u32x4 __attribute__((ext_vector_type(4)));
constexpr int BM = 256, BK = 64, HALF = 128, HTB = HALF * BK * 2  , STAGE_BYTES = 8 * HTB, NXCD = 8, WGM = 8;

__host__ __device__ __forceinline__ int lds_byte(int r, int c) { const int st = (r >> 4) * 2 + (c >> 5), rr = r & 15, cc = c & 31, ob = rr * 64 + cc * 2; return st * 1024 + (ob ^ (((ob >> 9) & 1) << 5)); }
__host__ __device__ __forceinline__ void stage_rc(int b, int& R, int& C) { const int st = b / 1024, sb = b % 1024, swz = sb ^ (((sb >> 9) & 1) << 5); R = (st >> 1) * 16 + swz / 64; C = (st & 1) * 32 + (swz % 64) / 2; }
__host__ __device__ __forceinline__ int perm32(int rho) { const int n = rho >> 4, i = rho & 15; return 8 * (i >> 2) + 4 * n + (i & 3); }

struct Unit { int pm, pn; };
struct Gemm { const bf16_t* A; const bf16_t* Bt; int M, N, K; };

struct StaticOrder {
    int nM, nN, nwg, G, c;
    __host__ __device__ void init(int M, int N, int G_, int c_) { nM = M / BM; nN = N / BM; nwg = nM * nN; G = G_; c = c_; }
    __host__ __device__ bool next(int i, Unit& u) const {
        const long L = (long)i * G + c; if (L >= nwg) return false;
        int wgid = (int)L; { const int q = nwg / NXCD, r = nwg % NXCD, xcd = wgid % NXCD, off = wgid / NXCD; wgid = (xcd < r ? xcd * (q + 1) : r * (q + 1) + (xcd - r) * q) + off; }
        const int nig = WGM * nN, gid = wgid / nig, fm = gid * WGM, gsz = (nM - fm) < WGM ? (nM - fm) : WGM;
        u.pm = fm + ((wgid % nig) % gsz); u.pn = (wgid % nig) / gsz; return true;
    }
    __device__ __forceinline__ void a_ready(const Unit&) const {}
    __device__ __forceinline__ void done(const Unit&) const {}
};

__device__ __forceinline__ unsigned cvt_pk_bf16(float lo, float hi) { unsigned r; asm volatile("v_cvt_pk_bf16_f32 %0, %1, %2" : "=v"(r) : "v"(lo), "v"(hi)); return r; }

__device__ __forceinline__ unsigned cvtpk2(float lo, float hi) { typedef float f2_t __attribute__((ext_vector_type(2))); typedef __bf16 b2_t __attribute__((ext_vector_type(2))); f2_t v = {lo, hi}; b2_t b = __builtin_convertvector(v, b2_t); return __builtin_bit_cast(unsigned, b); }
#ifndef EPI_WT
#define EPI_WT 0
#endif
#ifndef EPI_WT8
#define EPI_WT8 0
#endif
__device__ __forceinline__ void st16_wt(void* p, u32x4 v) {
#if EPI_WT
    asm volatile("global_store_dwordx4 %0, %1, off sc1\n\ts_nop 1" :: "v"(p), "v"(v) : "memory");
#else
    *(u32x4*)p = v;
#endif
}
typedef unsigned u32x2w __attribute__((ext_vector_type(2)));
__device__ __forceinline__ void st8_wt(void* p, u32x2w v) {
#if EPI_WT8
    asm volatile("global_store_dwordx2 %0, %1, off sc1" :: "v"(p), "v"(v) : "memory");
#else
    *(u32x2w*)p = v;
#endif
}
__device__ __forceinline__ float row_rstd16(const float* sspart, int row, int fq) {
    const f32x4 p = *(const f32x4*)(sspart + (size_t)row * 16 + 4 * fq);
    float s = (p[0] + p[1]) + (p[2] + p[3]);
    s += __shfl_xor(s, 16); s += __shfl_xor(s, 32);
    return __builtin_amdgcn_rsqf(s * (1.0f / 1024.0f) + 1e-6f);
}
template <int ACT, bool DRY = false> struct EpiScaleBf16 {
    static constexpr bool PERM = true, AFTER_DRAIN = false;
    bf16_t* O; int ldc; const float* sspart;
    __device__ __forceinline__ void operator()(const f32x4 (&acc)[2][2][4][2], const Unit& u, int wr, int wc, int fr, int fq) const {
        const int row0 = u.pm * BM + wr * 64 + fr; const int col0 = u.pn * BM + wc * 32 + 8 * fq;
        float rs[2][4]; f32x4 pp[2][4];
#pragma unroll
        for (int ai = 0; ai < 2; ++ai)
#pragma unroll
            for (int m = 0; m < 4; ++m) pp[ai][m] = *(const f32x4*)(sspart + (size_t)(row0 + ai * HALF + m * 16) * 16 + 4 * fq);
        asm volatile("" : "+v"(pp[0][0]), "+v"(pp[0][1]), "+v"(pp[0][2]), "+v"(pp[0][3]), "+v"(pp[1][0]), "+v"(pp[1][1]), "+v"(pp[1][2]), "+v"(pp[1][3]));
#pragma unroll
        for (int ai = 0; ai < 2; ++ai)
#pragma unroll
            for (int m = 0; m < 4; ++m) { const f32x4 p = pp[ai][m]; rs[ai][m] = (p[0] + p[1]) + (p[2] + p[3]); }
#pragma unroll
        for (int ai = 0; ai < 2; ++ai)
#pragma unroll
            for (int m = 0; m < 4; ++m) { float s = rs[ai][m]; s += __shfl_xor(s, 16); s += __shfl_xor(s, 32); rs[ai][m] = __builtin_amdgcn_rsqf(s * (1.0f / 1024.0f) + 1e-6f); }
#pragma unroll
        for (int ai = 0; ai < 2; ++ai)
#pragma unroll
            for (int m = 0; m < 4; ++m) { const int row = row0 + ai * HALF + m * 16; const float r = rs[ai][m];
                bf16_t* rowp = O + (size_t)row * ldc + col0;
#pragma unroll
                for (int bj = 0; bj < 2; ++bj) { f32x4 v0 = acc[ai][bj][m][0] * r, v1 = acc[ai][bj][m][1] * r;
                    if (ACT == 1) {
#pragma unroll
                        for (int e = 0; e < 4; ++e) { const float a = fmaxf(v0[e], 0.f), b = fmaxf(v1[e], 0.f); v0[e] = a * a; v1[e] = b * b; } }
                    u32x4 w; w.x = cvtpk2(v0[0], v0[1]); w.y = cvtpk2(v0[2], v0[3]); w.z = cvtpk2(v1[0], v1[1]); w.w = cvtpk2(v1[2], v1[3]);
                    if (!DRY || w.x == 0x7fc17fc1u) st16_wt(rowp + bj * HALF, w); } }
    }
};
struct EpiResid {
    static constexpr bool PERM = false, AFTER_DRAIN = false;
    const bf16_t* hin; bf16_t* hb; float* sspart;
    __device__ __forceinline__ void operator()(const f32x4 (&acc)[2][2][4][2], const Unit& u, int wr, int wc, int fr, int fq) const {
        typedef unsigned u32x2v __attribute__((ext_vector_type(2)));
        const int col0 = u.pn * BM + wc * 32 + 4 * fq;
#pragma unroll
        for (int ai = 0; ai < 2; ++ai) {
            u32x2v bs[4][2][2];
#pragma unroll
            for (int m = 0; m < 4; ++m) { const size_t off = (size_t)(u.pm * BM + ai * HALF + wr * 64 + m * 16 + fr) * 1024 + col0;
#pragma unroll
                for (int bj = 0; bj < 2; ++bj)
#pragma unroll
                    for (int n = 0; n < 2; ++n) bs[m][bj][n] = *(const u32x2v*)(hin + off + bj * HALF + n * 16); }
            asm volatile("" : "+v"(bs[0][0][0]), "+v"(bs[0][0][1]), "+v"(bs[0][1][0]), "+v"(bs[0][1][1]), "+v"(bs[1][0][0]), "+v"(bs[1][0][1]), "+v"(bs[1][1][0]), "+v"(bs[1][1][1]),
                             "+v"(bs[2][0][0]), "+v"(bs[2][0][1]), "+v"(bs[2][1][0]), "+v"(bs[2][1][1]), "+v"(bs[3][0][0]), "+v"(bs[3][0][1]), "+v"(bs[3][1][0]), "+v"(bs[3][1][1]) :: "memory");
#pragma unroll
            for (int m = 0; m < 4; ++m) { const int r = u.pm * BM + ai * HALF + wr * 64 + m * 16 + fr; const size_t off = (size_t)r * 1024 + col0; float ss = 0.f;
#pragma unroll
                for (int bj = 0; bj < 2; ++bj)
#pragma unroll
                    for (int n = 0; n < 2; ++n) { const u32x2v b = bs[m][bj][n]; f32x4 o = acc[ai][bj][m][n];
                        o[0] += __uint_as_float(b.x << 16); o[1] += __uint_as_float(b.x & 0xffff0000u); o[2] += __uint_as_float(b.y << 16); o[3] += __uint_as_float(b.y & 0xffff0000u);
                        u32x2v w; w.x = cvtpk2(o[0], o[1]); w.y = cvtpk2(o[2], o[3]); st8_wt(hb + off + bj * HALF + n * 16, w);
                        ss += (o[0] * o[0] + o[1] * o[1]) + (o[2] * o[2] + o[3] * o[3]); }
                ss += __shfl_xor(ss, 16); ss += __shfl_xor(ss, 32);
                if (fq == 0) sspart[(size_t)r * 16 + u.pn * 4 + wc] = ss; }
            asm volatile("" ::: "memory");
        }
    }
};
template <class Epi, class Sched, bool ALIGN_EPI = false, bool SP2 = false>
__device__ __forceinline__ void gemm_phase(PG8_LAS unsigned char* lds, const Gemm g, const Sched& S, const Epi& E) {
    int tid_ = threadIdx.x; asm volatile("" : "+v"(tid_));
    const int tid = tid_, wid = __builtin_amdgcn_readfirstlane(tid >> 6), lane = tid & 63, wr = wid >> 2, wc = wid & 3, fr = lane & 15, fq = lane >> 4;
    const int K = g.K, nt = K / BK;
    unsigned voffA[2], voffB[2];
#pragma unroll
    for (int i = 0; i < 2; ++i) { int R, C; stage_rc(tid * 16 + i * 8192, R, C); const int Rb = Epi::PERM ? ((R & ~31) + perm32(R & 31)) : R;
        voffA[i] = (unsigned)(R * K + C) * 2u; voffB[i] = (unsigned)(Rb * K + C) * 2u; }
    const size_t kstep = (size_t)(BK * 2);
    const size_t hstep = (size_t)HALF * K * 2;
    const size_t tstep = 2 * hstep;
    const unsigned ldsw = (unsigned)wid * 1024u;
    const int aoff = lds_byte(wr * 64 + fr, fq * 8), boff = lds_byte(wc * 32 + fr, fq * 8);
#define PG8_SA(b, h) (((b) * 2 + (h)) * HTB)
#define PG8_SB(b, h) ((4 + (b) * 2 + (h)) * HTB)
#define PG8_STAGE(bufoff, gbase, voff) do { _Pragma("unroll") for (int _i = 0; _i < 2; ++_i) \
        __builtin_amdgcn_global_load_lds((const unsigned*)((const char*)(gbase) + (voff)[_i]), (PG8_LAS unsigned*)(lds + (bufoff) + ldsw + _i * 8192), 16, 0, 0); } while (0)
#define PG8_LDA(dst, b, h) do { _Pragma("unroll") for (int m = 0; m < 4; ++m) _Pragma("unroll") for (int k = 0; k < 2; ++k) dst[m][k] = *(const PG8_LAS bf16x8*)(lds + PG8_SA(b, h) + aoff + m * 2048 + k * 1024); } while (0)
#define PG8_LDB(dst, b, h) do { _Pragma("unroll") for (int n = 0; n < 2; ++n) _Pragma("unroll") for (int k = 0; k < 2; ++k) dst[n][k] = *(const PG8_LAS bf16x8*)(lds + PG8_SB(b, h) + boff + n * 2048 + k * 1024); } while (0)
#define PG8_MMA(ai, bj, At, Bt) do { __builtin_amdgcn_s_setprio(1); _Pragma("unroll") for (int m = 0; m < 4; ++m) _Pragma("unroll") for (int n = 0; n < 2; ++n) _Pragma("unroll") for (int k = 0; k < 2; ++k) \
        acc[ai][bj][m][n] = __builtin_amdgcn_mfma_f32_16x16x32_bf16(Bt[n][k], At[m][k], acc[ai][bj][m][n], 0, 0, 0); __builtin_amdgcn_s_setprio(0); } while (0)
#define PG8_WAIT_V(n) asm volatile("s_waitcnt vmcnt(" #n ")" ::: "memory")
#define PG8_WAIT_L(n) asm volatile("s_waitcnt lgkmcnt(" #n ")" ::: "memory")
#define PG8_BAR __builtin_amdgcn_s_barrier()
#define PG8_SCHED __builtin_amdgcn_sched_barrier(0)
    Unit cur, nxt; int ui = 0;
    if (!S.next(0, cur)) return;
    f32x4 acc[2][2][4][2];
#pragma unroll
    for (int a = 0; a < 2; ++a)
#pragma unroll
        for (int b = 0; b < 2; ++b)
#pragma unroll
            for (int m = 0; m < 4; ++m)
#pragma unroll
                for (int n = 0; n < 2; ++n) acc[a][b][m][n] = (f32x4){0.f, 0.f, 0.f, 0.f};
    bf16x8 At[4][2], B0[2][2], B1[2][2];
    const char* cA = (const char*)g.A + (size_t)cur.pm * tstep; const char* cB = (const char*)g.Bt + (size_t)cur.pn * tstep;
    S.a_ready(cur);
    if constexpr (SP2) {
        PG8_STAGE(PG8_SB(0, 0), cB, voffB); PG8_STAGE(PG8_SB(0, 1), cB + hstep, voffB); PG8_STAGE(PG8_SA(0, 0), cA, voffA); PG8_STAGE(PG8_SA(0, 1), cA + hstep, voffA);
        if (wr == 1) PG8_BAR;
        PG8_WAIT_V(2); PG8_BAR;
        PG8_STAGE(PG8_SB(1, 0), cB + kstep, voffB); PG8_STAGE(PG8_SA(1, 0), cA + kstep, voffA); PG8_STAGE(PG8_SB(1, 1), cB + hstep + kstep, voffB);
        PG8_WAIT_V(6); PG8_BAR;
    } else {
        PG8_STAGE(PG8_SB(0, 0), cB, voffB); PG8_STAGE(PG8_SA(0, 0), cA, voffA); PG8_STAGE(PG8_SB(0, 1), cB + hstep, voffB); PG8_STAGE(PG8_SA(0, 1), cA + hstep, voffA);
        if (wr == 1) PG8_BAR;
        PG8_WAIT_V(4); PG8_BAR;
        PG8_STAGE(PG8_SB(1, 0), cB + kstep, voffB); PG8_STAGE(PG8_SA(1, 0), cA + kstep, voffA); PG8_STAGE(PG8_SB(1, 1), cB + hstep + kstep, voffB);
        PG8_WAIT_V(6); PG8_BAR;
    }
    for (;;) {
        const bool has_next = S.next(ui + 1, nxt);
        const char* nA = has_next ? (const char*)g.A + (size_t)nxt.pm * tstep : cA; const char* nB = has_next ? (const char*)g.Bt + (size_t)nxt.pn * tstep : cB;
        for (int t = 0; t < nt; t += 2) {
            const bool last = (t == nt - 2);
            const char* a1 = cA + (size_t)(t + 1) * kstep;
            const char* a2 = last ? nA : cA + (size_t)(t + 2) * kstep; const char* b2 = last ? nB : cB + (size_t)(t + 2) * kstep;
            const char* a3 = a2 + kstep; const char* b3 = b2 + kstep;
            if (last && has_next) S.a_ready(nxt);
            if constexpr (SP2) {
            PG8_LDB(B0, 0, 0); PG8_LDB(B1, 0, 1); PG8_SCHED; PG8_LDA(At, 0, 0); PG8_STAGE(PG8_SA(1, 1), a1 + hstep, voffA);
            PG8_WAIT_V(8); PG8_WAIT_L(0); PG8_BAR; PG8_MMA(0, 0, At, B0); PG8_MMA(0, 1, At, B1); PG8_BAR; PG8_SCHED;
            PG8_LDA(At, 0, 1); PG8_STAGE(PG8_SB(0, 0), b2, voffB); PG8_STAGE(PG8_SB(0, 1), b2 + hstep, voffB); PG8_STAGE(PG8_SA(0, 0), a2, voffA);
            PG8_WAIT_V(8); PG8_WAIT_L(0); PG8_BAR; PG8_MMA(1, 0, At, B0); PG8_MMA(1, 1, At, B1); PG8_BAR; PG8_SCHED;
            PG8_LDB(B0, 1, 0); PG8_LDB(B1, 1, 1); PG8_SCHED; PG8_LDA(At, 1, 0); PG8_STAGE(PG8_SA(0, 1), a2 + hstep, voffA);
            PG8_WAIT_V(8); PG8_WAIT_L(0); PG8_BAR; PG8_MMA(0, 0, At, B0); PG8_MMA(0, 1, At, B1); PG8_BAR; PG8_SCHED;
            PG8_LDA(At, 1, 1); PG8_STAGE(PG8_SB(1, 0), b3, voffB); PG8_STAGE(PG8_SB(1, 1), b3 + hstep, voffB); PG8_STAGE(PG8_SA(1, 0), a3, voffA);
            PG8_WAIT_V(8); PG8_WAIT_L(0); PG8_BAR; PG8_MMA(1, 0, At, B0); PG8_MMA(1, 1, At, B1); PG8_BAR; PG8_SCHED;
            } else {
            PG8_LDB(B0, 0, 0); PG8_SCHED; PG8_LDA(At, 0, 0); PG8_STAGE(PG8_SA(1, 1), a1 + hstep, voffA);
            PG8_WAIT_L(8); PG8_BAR; PG8_WAIT_L(0); PG8_MMA(0, 0, At, B0); PG8_BAR; PG8_SCHED;
            PG8_LDB(B1, 0, 1); PG8_STAGE(PG8_SB(0, 0), b2, voffB);
            PG8_BAR; PG8_WAIT_L(0); PG8_MMA(0, 1, At, B1); PG8_BAR;
            PG8_LDA(At, 0, 1); PG8_STAGE(PG8_SA(0, 0), a2, voffA);
            PG8_BAR; PG8_WAIT_L(0); PG8_MMA(1, 0, At, B0); PG8_BAR; PG8_SCHED;
            PG8_STAGE(PG8_SB(0, 1), b2 + hstep, voffB);
            PG8_WAIT_V(6); PG8_BAR; PG8_MMA(1, 1, At, B1); PG8_BAR;
            PG8_LDB(B0, 1, 0); PG8_SCHED; PG8_LDA(At, 1, 0); PG8_STAGE(PG8_SA(0, 1), a2 + hstep, voffA);
            PG8_WAIT_L(8); PG8_BAR; PG8_WAIT_L(0); PG8_MMA(0, 0, At, B0); PG8_BAR; PG8_SCHED;
            PG8_LDB(B1, 1, 1); PG8_STAGE(PG8_SB(1, 0), b3, voffB);
            PG8_BAR; PG8_WAIT_L(0); PG8_MMA(0, 1, At, B1); PG8_BAR;
            PG8_LDA(At, 1, 1); PG8_STAGE(PG8_SA(1, 0), a3, voffA);
            PG8_BAR; PG8_WAIT_L(0); PG8_MMA(1, 0, At, B0); PG8_BAR; PG8_SCHED;
            PG8_STAGE(PG8_SB(1, 1), b3 + hstep, voffB);
            PG8_WAIT_V(6); PG8_BAR; PG8_MMA(1, 1, At, B1); PG8_BAR;
            }
        }
        if constexpr (ALIGN_EPI) { if (wr == 0) PG8_BAR; }
        if constexpr (!Epi::AFTER_DRAIN) { E(acc, cur, wr, wc, fr, fq); S.done(cur); }
        if (!has_next) break;
#pragma unroll
        for (int a = 0; a < 2; ++a)
#pragma unroll
            for (int b = 0; b < 2; ++b)
#pragma unroll
                for (int m = 0; m < 4; ++m)
#pragma unroll
                    for (int n = 0; n < 2; ++n) acc[a][b][m][n] = (f32x4){0.f, 0.f, 0.f, 0.f};
        cur = nxt; cA = nA; cB = nB; ++ui;
        if constexpr (ALIGN_EPI) { if (wr == 1) PG8_BAR; }
    }
    PG8_WAIT_V(0);
    if constexpr (!ALIGN_EPI) { if (wr == 0) PG8_BAR; }
    PG8_BAR;
    if constexpr (Epi::AFTER_DRAIN) { E.fused(acc, cur, wr, wc, fr, fq, lds, wid, lane); S.done(cur); }
#undef PG8_SA
#undef PG8_SB
#undef PG8_STAGE
#undef PG8_LDA
#undef PG8_LDB
#undef PG8_MMA
#undef PG8_WAIT_V
#undef PG8_WAIT_L
#undef PG8_BAR
#undef PG8_SCHED
}
}

#define LAS __attribute__((address_space(3)))
typedef unsigned short bf16;
typedef short bf16x8 __attribute__((ext_vector_type(8)));
typedef float f32x4 __attribute__((ext_vector_type(4)));
typedef float f32x16 __attribute__((ext_vector_type(16)));
typedef unsigned u32x4 __attribute__((ext_vector_type(4)));
typedef unsigned u32x2 __attribute__((ext_vector_type(2)));
typedef short v4i16_t __attribute__((ext_vector_type(4)));

constexpr int NWAVES = 8;
constexpr int MTOK = 32768, DM = 1024, SEQ = 4096, NCH = 64, FF = 4096;
constexpr int DIN_SRC = 2832;
constexpr int LDP = 3072;
constexpr int GQ = 0, GK = 192, GV = 384, GG = 768, GZ = 1152, CU = 1344, AQ = 1856, AK = 2240, AV = 2624, PEND = 3008;
constexpr int MIX_GLA = 0, MIX_CONV = 384, MIX_ATT = 640;
constexpr float EPS = 1e-6f;
constexpr float LOG2E = 1.4426950408889634f;

constexpr size_t MiB = 1u << 20;
constexpr size_t WS_CTL = 0;
constexpr size_t WS_W = 1 * MiB, W_LAYER = 24 * MiB, W_IN = 0, W_OUT = 6 * MiB, W_UP = 8 * MiB, W_DN = 16 * MiB;
constexpr size_t WS_HB = 49 * MiB;
constexpr size_t WS_PROJ = 113 * MiB;
constexpr size_t WS_MIX = 305 * MiB;
constexpr size_t WS_FF = 113 * MiB;
constexpr size_t WS_SS = 369 * MiB;
constexpr size_t WS_KVT = 371 * MiB;
constexpr size_t WS_DEC = 407 * MiB;
constexpr size_t WS_ST = 408 * MiB;
constexpr size_t WS_END = 427 * MiB;

constexpr int LDS_BYTES = 147456;

__device__ __forceinline__ unsigned cvtpk(float lo, float hi) { typedef float f2_t __attribute__((ext_vector_type(2))); typedef __bf16 b2_t __attribute__((ext_vector_type(2))); f2_t v = {lo, hi}; b2_t b = __builtin_convertvector(v, b2_t); return __builtin_bit_cast(unsigned, b); }
__device__ __forceinline__ float bflo(unsigned u) { return __uint_as_float(u << 16); }
__device__ __forceinline__ float bfhi(unsigned u) { return __uint_as_float(u & 0xffff0000u); }
__device__ __forceinline__ float bf2f(bf16 u) { return __uint_as_float((unsigned)u << 16); }
__device__ __forceinline__ float dpp_add(float v, int dummy) { return v; }
#define DPP_ADD(v, ctrl) ((v) + __builtin_bit_cast(float, __builtin_amdgcn_update_dpp(0, __builtin_bit_cast(int, (v)), (ctrl), 0xf, 0xf, true)))
__device__ __forceinline__ float wave_sum(float v) {
    v = DPP_ADD(v, 0xB1); v = DPP_ADD(v, 0x4E); v = DPP_ADD(v, 0x141); v = DPP_ADD(v, 0x140);
    const int iv = __builtin_bit_cast(int, v);
    const float r0 = __builtin_bit_cast(float, __builtin_amdgcn_readlane(iv, 0)), r1 = __builtin_bit_cast(float, __builtin_amdgcn_readlane(iv, 16));
    const float r2 = __builtin_bit_cast(float, __builtin_amdgcn_readlane(iv, 32)), r3 = __builtin_bit_cast(float, __builtin_amdgcn_readlane(iv, 48));
    return (r0 + r1) + (r2 + r3);
}
__device__ __forceinline__ float fast_sigmoid(float x) { return __builtin_amdgcn_rcpf(1.f + __expf(-x)); }
__device__ __forceinline__ int crow(int r, int hi) { return (r & 3) + 8 * (r >> 2) + 4 * hi; }
__device__ __forceinline__ v4i16_t trrd(LAS const unsigned char* p) { return __builtin_amdgcn_ds_read_tr16_b64_v4i16((LAS v4i16_t*)p); }
__device__ __forceinline__ bf16x8 cat8(v4i16_t a, v4i16_t b) { return (bf16x8){a[0], a[1], a[2], a[3], b[0], b[1], b[2], b[3]}; }
#define MFMA32(a, b, c) __builtin_amdgcn_mfma_f32_32x32x16_bf16((a), (b), (c), 0, 0, 0)
#define LDS_FENCE() asm volatile("s_waitcnt lgkmcnt(0)" ::: "memory")

struct Args { const float* in[16]; float* out; unsigned char* ws; };
typedef const Args __attribute__((address_space(4))) CArgs;
__device__ __forceinline__ void p0_store_tile(LAS float* scr, bf16* WT, int K, int dst_row0, int k0, const float* gain, int lane) {
    const int c = lane & 7;
    f32x4 g0 = (f32x4){1.f, 1.f, 1.f, 1.f}, g1 = g0;
    if (gain) { g0 = *(const f32x4*)(gain + k0 + 8 * c); g1 = *(const f32x4*)(gain + k0 + 8 * c + 4); }
    LDS_FENCE();
#pragma unroll
    for (int j = 0; j < 4; ++j) { const int n = (lane >> 3) + 8 * j; const LAS float* s = scr + (8 * c) * 33 + n;
        u32x4 o; o.x = cvtpk(s[0 * 33] * g0[0], s[1 * 33] * g0[1]); o.y = cvtpk(s[2 * 33] * g0[2], s[3 * 33] * g0[3]); o.z = cvtpk(s[4 * 33] * g1[0], s[5 * 33] * g1[1]); o.w = cvtpk(s[6 * 33] * g1[2], s[7 * 33] * g1[3]);
        *(u32x4*)(WT + (size_t)(dst_row0 + n) * K + k0 + 8 * c) = o; }
    LDS_FENCE();
}
__device__ __forceinline__ void p0_copy_item(const float* W, int ldw, int src0, LAS float* scr, int k0, int lane) {
    float wv[32];
#pragma unroll
    for (int i = 0; i < 32; ++i) { const float* wp = W + (size_t)(k0 + 2 * i + (lane >> 5)) * ldw + src0 + (lane & 31); wv[i] = STREAM_NT ? __builtin_nontemporal_load(wp) : *wp; }
    asm volatile("" : "+v"(wv[0]), "+v"(wv[1]), "+v"(wv[2]), "+v"(wv[3]), "+v"(wv[4]), "+v"(wv[5]), "+v"(wv[6]), "+v"(wv[7]), "+v"(wv[8]), "+v"(wv[9]), "+v"(wv[10]), "+v"(wv[11]), "+v"(wv[12]), "+v"(wv[13]), "+v"(wv[14]), "+v"(wv[15]),
                     "+v"(wv[16]), "+v"(wv[17]), "+v"(wv[18]), "+v"(wv[19]), "+v"(wv[20]), "+v"(wv[21]), "+v"(wv[22]), "+v"(wv[23]), "+v"(wv[24]), "+v"(wv[25]), "+v"(wv[26]), "+v"(wv[27]), "+v"(wv[28]), "+v"(wv[29]));
#pragma unroll
    for (int i = 0; i < 32; ++i) scr[(2 * i + (lane >> 5)) * 33 + (lane & 31)] = wv[i];
}
__device__ __forceinline__ void p0_weights(CArgs* ka, LAS float* scr, int lo, int hi, int gw, int ngw, int lane) {
    constexpr int I_IN = 16 * 96, I_OUT = 16 * 32, I_UP = 16 * 128, I_DN = 64 * 32, I_L = I_IN + I_OUT + I_UP + I_DN;
    unsigned char* ws = ka->ws;
    for (int it = lo + gw; it < hi; it += ngw) {
        const int l = it / I_L; int r = it - l * I_L;
        unsigned char* wl = ws + WS_W + (size_t)l * W_LAYER;
        if (r < I_IN) {
            const int kb = r / 96, nb = r % 96, k0 = 64 * kb, n0 = 32 * nb;
            const float* W = ka->in[2] + (size_t)l * DM * DIN_SRC; const float* gain = ka->in[1] + l * DM;
            if (n0 < GZ) p0_copy_item(W, DIN_SRC, n0, scr, k0, lane);
            else if (n0 < CU) {
                const float* wg = ka->in[3] + (size_t)l * 16 * 192; const int j = n0 - GZ + (lane & 31);
                float wgc[16];
#pragma unroll
                for (int q = 0; q < 16; ++q) wgc[q] = wg[q * 192 + j];
#pragma unroll 4
                for (int i = 0; i < 32; ++i) { const int kk = 2 * i + (lane >> 5); const f32x4* wr = (const f32x4*)(W + (size_t)(k0 + kk) * DIN_SRC + 1152); float s = 0.f;
#pragma unroll
                    for (int q = 0; q < 4; ++q) { const f32x4 wv = wr[q]; s += (wv[0] * wgc[4 * q] + wv[1] * wgc[4 * q + 1]) + (wv[2] * wgc[4 * q + 2] + wv[3] * wgc[4 * q + 3]); }
                    scr[kk * 33 + (lane & 31)] = s; }
            }
            else if (n0 < PEND) p0_copy_item(W, DIN_SRC, n0 - CU + 1168, scr, k0, lane);
            else {
#pragma unroll 8
                for (int i = 0; i < 32; ++i) scr[(2 * i + (lane >> 5)) * 33 + (lane & 31)] = 0.f;
            }
            p0_store_tile(scr, (bf16*)(wl + W_IN), DM, n0, k0, gain, lane);
            continue;
        }
        r -= I_IN;
        if (r < I_OUT) { const int kb = r / 32, nb = r % 32; p0_copy_item(ka->in[11] + (size_t)l * DM * DM, DM, 32 * nb, scr, 64 * kb, lane);
            p0_store_tile(scr, (bf16*)(wl + W_OUT), DM, 32 * nb, 64 * kb, kb < 6 ? ka->in[5] + l * 384 : nullptr, lane); continue; }
        r -= I_OUT;
        if (r < I_UP) { const int kb = r / 128, nb = r % 128; p0_copy_item(ka->in[13] + (size_t)l * DM * FF, FF, 32 * nb, scr, 64 * kb, lane); p0_store_tile(scr, (bf16*)(wl + W_UP), DM, 32 * nb, 64 * kb, ka->in[12] + l * DM, lane); continue; }
        r -= I_UP;
        { const int kb = r / 32, nb = r % 32; p0_copy_item(ka->in[14] + (size_t)l * FF * DM, DM, 32 * nb, scr, 64 * kb, lane); p0_store_tile(scr, (bf16*)(wl + W_DN), FF, 32 * nb, 64 * kb, nullptr, lane); }
    }
}
__device__ __forceinline__ void p0_rows(const float* x, bf16* hb, float* sspart, int gw, int ngw, int lane) {
    for (int m0 = gw; m0 < MTOK; m0 += 4 * ngw) {
        f32x4 v[4][4];
#pragma unroll
        for (int q = 0; q < 4; ++q) { int m = m0 + q * ngw; m = m < MTOK ? m : m0; const f32x4* xr = (const f32x4*)(x + (size_t)m * DM) + lane;
#pragma unroll
            for (int j = 0; j < 4; ++j) v[q][j] = STREAM_NT ? __builtin_nontemporal_load(xr + 64 * j) : xr[64 * j]; }
        asm volatile("" : "+v"(v[0][0]), "+v"(v[0][1]), "+v"(v[0][2]), "+v"(v[0][3]), "+v"(v[1][0]), "+v"(v[1][1]), "+v"(v[1][2]), "+v"(v[1][3]),
                         "+v"(v[2][0]), "+v"(v[2][1]), "+v"(v[2][2]), "+v"(v[2][3]), "+v"(v[3][0]), "+v"(v[3][1]), "+v"(v[3][2]), "+v"(v[3][3]));
#pragma unroll
        for (int q = 0; q < 4; ++q) { const int m = m0 + q * ngw; if (m < MTOK) {
            float s = 0.f;
#pragma unroll
            for (int j = 0; j < 4; ++j) s += (v[q][j][0] * v[q][j][0] + v[q][j][1] * v[q][j][1]) + (v[q][j][2] * v[q][j][2] + v[q][j][3] * v[q][j][3]);
            s = wave_sum(s);
            u32x2* o = (u32x2*)(hb + (size_t)m * DM) + lane;
#pragma unroll
            for (int j = 0; j < 4; ++j) { u32x2 w; w.x = cvtpk(v[q][j][0], v[q][j][1]); w.y = cvtpk(v[q][j][2], v[q][j][3]); o[64 * j] = w; }
            if (lane < 16) sspart[(size_t)m * 16 + lane] = s * (1.0f / 16.0f); } }
    }
}
__device__ __forceinline__ void final_rows(float* out, const bf16* hb, const float* sspart, const float* g, int gw, int ngw, int lane) {
    f32x4 gv[4];
#pragma unroll
    for (int j = 0; j < 4; ++j) gv[j] = ((const f32x4*)g)[lane + 64 * j];
    for (int m0 = gw; m0 < MTOK; m0 += 4 * ngw) {
        u32x2 v[4][4]; float ps[4];
#pragma unroll
        for (int q = 0; q < 4; ++q) { int m = m0 + q * ngw; m = m < MTOK ? m : m0; const u32x2* xr = (const u32x2*)(hb + (size_t)m * DM) + lane;
            ps[q] = lane < 16 ? sspart[(size_t)m * 16 + lane] : 0.f;
#pragma unroll
            for (int j = 0; j < 4; ++j) v[q][j] = STREAM_NT ? __builtin_nontemporal_load(xr + 64 * j) : xr[64 * j]; }
        asm volatile("" : "+v"(v[0][0]), "+v"(v[0][1]), "+v"(v[0][2]), "+v"(v[0][3]), "+v"(v[1][0]), "+v"(v[1][1]), "+v"(v[1][2]), "+v"(v[1][3]),
                         "+v"(v[2][0]), "+v"(v[2][1]), "+v"(v[2][2]), "+v"(v[2][3]), "+v"(v[3][0]), "+v"(v[3][1]), "+v"(v[3][2]), "+v"(v[3][3]), "+v"(ps[0]), "+v"(ps[1]), "+v"(ps[2]), "+v"(ps[3]));
#pragma unroll
        for (int q = 0; q < 4; ++q) { const int m = m0 + q * ngw; if (m < MTOK) {
            const float rs = __builtin_amdgcn_rsqf(wave_sum(ps[q]) * (1.0f / 1024.0f) + EPS);
            f32x4* xr = (f32x4*)(out + (size_t)m * DM) + lane;
#pragma unroll
            for (int j = 0; j < 4; ++j) { f32x4 o; o[0] = bflo(v[q][j].x); o[1] = bfhi(v[q][j].x); o[2] = bflo(v[q][j].y); o[3] = bfhi(v[q][j].y); { const f32x4 ov = o * rs * gv[j]; if (STREAM_NT) __builtin_nontemporal_store(ov, xr + 64 * j); else xr[64 * j] = ov; } } } }
    }
}

__device__ __forceinline__ void conv_item(const bf16* proj, const float* wdw, const float* bdw, const float* lng, const float* lnb, bf16* mixed, LAS unsigned char* lds, int bc, int tid, int wave, int lane) {
    asm volatile("" : "+v"(lane), "+v"(tid));
    const int c = bc & 63; const size_t tokb = (size_t)(bc >> 6) * SEQ; const int t0 = c * 64;
    LAS float* gl = (LAS float*)lds;
    const int c4 = lane * 4;
    f32x4 wr[31];
#pragma unroll
    for (int j = 0; j < 31; ++j) wr[j] = *(const f32x4*)(wdw + j * 256 + c4);
    const f32x4 bias = *(const f32x4*)(bdw + c4);
    const f32x4 g = *(const f32x4*)(lng + c4), be = *(const f32x4*)(lnb + c4);
    {
        u32x2 av[12], gv[12];
#pragma unroll
        for (int ii = 0; ii < 12; ++ii) { const int idx = tid + ii * 512, row = idx >> 6, c4 = (idx & 63) * 4; int t = t0 - 30 + row; t = t < 0 ? 0 : (row > 93 ? t0 : t);
            const bf16* p = proj + (tokb + t) * LDP + CU + c4; av[ii] = STREAM_NT ? __builtin_nontemporal_load((const u32x2*)p) : *(const u32x2*)p; gv[ii] = STREAM_NT ? __builtin_nontemporal_load((const u32x2*)(p + 256)) : *(const u32x2*)(p + 256); }
        asm volatile("" : "+v"(av[0]), "+v"(av[1]), "+v"(av[2]), "+v"(av[3]), "+v"(av[4]), "+v"(av[5]), "+v"(av[6]), "+v"(av[7]), "+v"(av[8]), "+v"(av[9]), "+v"(av[10]), "+v"(av[11]),
                         "+v"(gv[0]), "+v"(gv[1]), "+v"(gv[2]), "+v"(gv[3]), "+v"(gv[4]), "+v"(gv[5]), "+v"(gv[6]), "+v"(gv[7]), "+v"(gv[8]), "+v"(gv[9]), "+v"(gv[10]), "+v"(gv[11]));
#pragma unroll
        for (int ii = 0; ii < 12; ++ii) { const int idx = tid + ii * 512, row = idx >> 6, c4 = (idx & 63) * 4, t = t0 - 30 + row;
            const u32x2 a = av[ii], g = gv[ii];
            const float a0 = bflo(a.x), a1 = bfhi(a.x), a2 = bflo(a.y), a3 = bfhi(a.y), g0 = bflo(g.x), g1 = bfhi(g.x), g2 = bflo(g.y), g3 = bfhi(g.y);
            f32x4 v; v[0] = a0 * fast_sigmoid(g0); v[1] = a1 * fast_sigmoid(g1); v[2] = a2 * fast_sigmoid(g2); v[3] = a3 * fast_sigmoid(g3);
            if (t < 0) v = (f32x4){0.f, 0.f, 0.f, 0.f};
            if (row < 94) *(LAS f32x4*)(gl + row * 256 + c4) = v; }
    }
    __syncthreads();
#pragma nounroll
    for (int tq = 0; tq < 2; ++tq) {
        f32x4 acc[4];
#pragma unroll
        for (int to = 0; to < 4; ++to) acc[to] = bias;
        const LAS float* gp = gl + (8 * wave + 4 * tq) * 256 + c4;
#pragma unroll
        for (int g0 = 0; g0 < 36; g0 += 12) {
            f32x4 x[12];
#pragma unroll
            for (int q = 0; q < 12; ++q) { const int rin = g0 + q < 34 ? g0 + q : 33; x[q] = *(const LAS f32x4*)(gp + rin * 256); }
            asm volatile("" : "+v"(x[0]), "+v"(x[1]), "+v"(x[2]), "+v"(x[3]), "+v"(x[4]), "+v"(x[5]), "+v"(x[6]), "+v"(x[7]), "+v"(x[8]), "+v"(x[9]), "+v"(x[10]), "+v"(x[11]));
#pragma unroll
            for (int q = 0; q < 12; ++q) { const int rin = g0 + q;
#pragma unroll
                for (int to = 0; to < 4; ++to) { const int j = rin - to; if (rin < 34 && j >= 0 && j <= 30) acc[to] += wr[j] * x[q]; } }
        }
#pragma unroll
        for (int to = 0; to < 4; ++to) {
            const f32x4 a = acc[to]; const float mean = wave_sum((a[0] + a[1]) + (a[2] + a[3])) * (1.0f / 256.0f);
            const f32x4 d = a - mean; const float var = wave_sum((d[0] * d[0] + d[1] * d[1]) + (d[2] * d[2] + d[3] * d[3])) * (1.0f / 256.0f);
            const float rs = __builtin_amdgcn_rsqf(var + EPS);
            f32x4 y = d * rs * g + be;
#pragma unroll
            for (int e = 0; e < 4; ++e) y[e] = y[e] * fast_sigmoid(y[e]);
            u32x2 w; w.x = cvtpk(y[0], y[1]); w.y = cvtpk(y[2], y[3]);
            *(u32x2*)(mixed + (tokb + t0 + 8 * wave + 4 * tq + to) * DM + MIX_CONV + c4) = w;
        }
    }
    __syncthreads();
}

#define GLDS16(gp, lp) __builtin_amdgcn_global_load_lds((const unsigned*)(gp), (LAS unsigned*)(lp), 16, 0, 0)
__device__ __forceinline__ void glds16_asm(const void* gsrc, unsigned lds_dst) { unsigned keep;
    asm volatile("s_mov_b32 %0, m0\n\ts_mov_b32 m0, %2\n\ts_nop 0\n\tglobal_load_lds_dwordx4 %1, off\n\ts_mov_b32 m0, %0" : "=&s"(keep) : "v"(gsrc), "s"(lds_dst) : "memory"); }
__device__ __forceinline__ void attn_unit(const bf16* proj, bf16* mixed, const LAS float* biasT, LAS unsigned char* vimg, int u, int lane) {
    asm volatile("" : "+v"(lane));
    const int half = u & 1; int t = u >> 1; const int h = t % 6; t /= 6; const int c = t & 63;
    const int r32 = lane & 31, hi = lane >> 5;
    const size_t tok0 = (size_t)t * 64;
    const int iq = 32 * half + r32;
    const bf16* qp = proj + (tok0 + iq) * LDP + AQ + h * 64 + 8 * hi;
    bf16x8 qf[4];
#pragma unroll
    for (int ks = 0; ks < 4; ++ks) qf[ks] = *(const bf16x8*)(qp + 16 * ks);
    float mrun = -1e30f, lrun = 0.f; f32x16 o0, o1;
#pragma unroll
    for (int r = 0; r < 16; ++r) { o0[r] = 0.f; o1[r] = 0.f; }
    const LAS float* bh = biasT + h * 260;
    const unsigned trb = ((lane >> 4) & 1) * 32 + (lane & 3) * 8 + (4 * hi + ((lane & 15) >> 2)) * 64;
    const float C2 = 0.125f * LOG2E;
    const int w0 = (c < 8 ? 8 - c : 0);
    const unsigned koff = (unsigned)r32 * LDP + 8u * hi;
    const unsigned vdoff = (unsigned)(8 * (lane >> 5) + ((lane & 31) >> 2)) * LDP + 8u * (lane & 3);
    bf16x8 kf[2][4];
    { const bf16* kt = proj + (tok0 - (size_t)(8 - w0) * 64) * LDP + AK + h * 64; const bf16* vt = kt + (AV - AK);
#pragma unroll
      for (int kb = 0; kb < 2; ++kb)
#pragma unroll
          for (int ks = 0; ks < 4; ++ks) kf[kb][ks] = *(const bf16x8*)(kt + (koff + (unsigned)(kb * 32 * LDP + 16 * ks)));
#pragma unroll
      for (int p = 0; p < 8; ++p) GLDS16(vt + (vdoff + (unsigned)((16 * (p & 3)) * LDP + 32 * (p >> 2))), vimg + p * 1024);
      asm volatile("" ::: "memory"); }
    int buf = 0;
    for (int w = w0; w <= 8; ++w) {
        bf16x8 kn[2][4];
        { const int wn = w < 8 ? w + 1 : 8;
          const bf16* kt = proj + (tok0 - (size_t)(8 - wn) * 64) * LDP + AK + h * 64; const bf16* vt = kt + (AV - AK);
          LAS unsigned char* vb = vimg + (buf ^ 1) * 8192;
          LDS_FENCE();
#pragma unroll
          for (int kb = 0; kb < 2; ++kb)
#pragma unroll
              for (int ks = 0; ks < 4; ++ks) kn[kb][ks] = *(const bf16x8*)(kt + (koff + (unsigned)(kb * 32 * LDP + 16 * ks)));
#pragma unroll
          for (int p = 0; p < 8; ++p) GLDS16(vt + (vdoff + (unsigned)((16 * (p & 3)) * LDP + 32 * (p >> 2))), vb + p * 1024);
          asm volatile("" ::: "memory"); }
        f32x16 s0, s1;
#pragma unroll
        for (int r = 0; r < 16; ++r) { s0[r] = 0.f; s1[r] = 0.f; }
#pragma unroll
        for (int ks = 0; ks < 4; ++ks) { s0 = MFMA32(kf[0][ks], qf[ks], s0); s1 = MFMA32(kf[1][ks], qf[ks], s1); }
        const int relb = (8 - w) * 64 + iq;
        float tm = -1e30f;
        if (w <= 5) {
            const float bc = bh[256];
#pragma unroll
            for (int r = 0; r < 16; ++r) { s0[r] = s0[r] * C2 + bc; s1[r] = s1[r] * C2 + bc; tm = fmaxf(tm, fmaxf(s0[r], s1[r])); }
        } else {
            float bv0[16], bv1[16];
#pragma unroll
            for (int r = 0; r < 16; ++r) { const int j0 = crow(r, hi); int i0 = relb - j0, i1 = relb - j0 - 32; i0 = (i0 > 128 ? 128 : i0) + 128; i1 = (i1 > 128 ? 128 : i1) + 128;
                bv0[r] = bh[i0]; bv1[r] = bh[i1]; }
            LDS_FENCE();
#pragma unroll
            for (int r = 0; r < 16; ++r) { s0[r] = s0[r] * C2 + bv0[r]; s1[r] = s1[r] * C2 + bv1[r]; tm = fmaxf(tm, fmaxf(s0[r], s1[r])); }
        }
        tm = fmaxf(tm, __shfl_xor(tm, 32));
        const float mn = fmaxf(mrun, tm); const float sc = __builtin_amdgcn_exp2f(mrun - mn); mrun = mn;
        float ps = 0.f;
#pragma unroll
        for (int r = 0; r < 16; ++r) { s0[r] = __builtin_amdgcn_exp2f(s0[r] - mn); s1[r] = __builtin_amdgcn_exp2f(s1[r] - mn); ps += s0[r] + s1[r]; o0[r] *= sc; o1[r] *= sc; }
        lrun = lrun * sc + ps;
        bf16x8 pf[2][2];
#pragma unroll
        for (int s2 = 0; s2 < 2; ++s2) {
            u32x4 a, b;
            a.x = cvtpk(s0[8 * s2 + 0], s0[8 * s2 + 1]); a.y = cvtpk(s0[8 * s2 + 2], s0[8 * s2 + 3]); a.z = cvtpk(s0[8 * s2 + 4], s0[8 * s2 + 5]); a.w = cvtpk(s0[8 * s2 + 6], s0[8 * s2 + 7]);
            b.x = cvtpk(s1[8 * s2 + 0], s1[8 * s2 + 1]); b.y = cvtpk(s1[8 * s2 + 2], s1[8 * s2 + 3]); b.z = cvtpk(s1[8 * s2 + 4], s1[8 * s2 + 5]); b.w = cvtpk(s1[8 * s2 + 6], s1[8 * s2 + 7]);
            pf[0][s2] = __builtin_bit_cast(bf16x8, a); pf[1][s2] = __builtin_bit_cast(bf16x8, b);
        }
        asm volatile("s_waitcnt vmcnt(16)" ::: "memory");
        const LAS unsigned char* vc = vimg + buf * 8192;
#pragma unroll
        for (int kb = 0; kb < 2; ++kb)
#pragma unroll
            for (int s2 = 0; s2 < 2; ++s2) {
                const unsigned off = (4 * kb + 2 * s2) * 512 + trb;
                const bf16x8 v0 = cat8(trrd(vc + off), trrd(vc + off + 512));
                const bf16x8 v1 = cat8(trrd(vc + 4096 + off), trrd(vc + 4096 + off + 512));
                o0 = MFMA32(v0, pf[kb][s2], o0); o1 = MFMA32(v1, pf[kb][s2], o1);
            }
#pragma unroll
        for (int kb = 0; kb < 2; ++kb)
#pragma unroll
            for (int ks = 0; ks < 4; ++ks) kf[kb][ks] = kn[kb][ks];
        buf ^= 1;
    }
    lrun += __shfl_xor(lrun, 32);
    const float inv = 1.0f / lrun;
    bf16* op = mixed + (tok0 + iq) * DM + MIX_ATT + h * 64 + 4 * hi;
#pragma unroll
    for (int rg = 0; rg < 4; ++rg) {
        u32x2 w0v, w1v;
        w0v.x = cvtpk(o0[4 * rg] * inv, o0[4 * rg + 1] * inv); w0v.y = cvtpk(o0[4 * rg + 2] * inv, o0[4 * rg + 3] * inv);
        w1v.x = cvtpk(o1[4 * rg] * inv, o1[4 * rg + 1] * inv); w1v.y = cvtpk(o1[4 * rg + 2] * inv, o1[4 * rg + 3] * inv);
        *(u32x2*)(op + 8 * rg) = w0v; *(u32x2*)(op + 32 + 8 * rg) = w1v;
    }
    asm volatile("s_waitcnt vmcnt(0) lgkmcnt(0)" ::: "memory");
}

__device__ __forceinline__ void attn_block_unit(const bf16* proj, bf16* mixed, const LAS float* biasT, LAS unsigned char* ring, int u, int wave, int lane) {
    asm volatile("" : "+v"(lane));
    const int h = u % 6; const int bg = u / 6; const int g = bg & 15, b = bg >> 4;
    const int qc = wave >> 1, half = wave & 1;
    const int r32 = lane & 31, hi = lane >> 5;
    const size_t tokg = (size_t)b * SEQ + (size_t)g * 256;
    const int tlo = (g < 2) ? 8 - 4 * g : 0;
    const int ntile = 12 - tlo;
    const unsigned kdo = (unsigned)(32 * (wave >> 2) + r32) * LDP + 16u * (wave & 3) + 8u * hi;
    const unsigned vdo = (unsigned)(16 * (wave & 3) + 8 * hi + (r32 >> 2)) * LDP + 32u * (wave >> 2) + 8u * (lane & 3) + (unsigned)(AV - AK);
#define ATT_ISSUE(t_, st_) do { const bf16* kt_ = proj + (tokg + (size_t)(t_) * 64 - 512) * LDP + AK + h * 64; \
        glds16_asm(kt_ + kdo, (unsigned)__builtin_amdgcn_readfirstlane((int)(ring0 + (unsigned)((st_) * 16384 + wave * 1024)))); \
        glds16_asm(kt_ + vdo, (unsigned)__builtin_amdgcn_readfirstlane((int)(ring0 + (unsigned)((st_) * 16384 + 8192 + wave * 1024)))); } while (0)
    const unsigned ring0 = (unsigned)(uintptr_t)ring;
    const int iq = 32 * half + r32;
    const bf16* qp = proj + (tokg + qc * 64 + iq) * LDP + AQ + h * 64 + 8 * hi;
    bf16x8 qf[4];
#pragma unroll
    for (int ks = 0; ks < 4; ++ks) qf[ks] = *(const bf16x8*)(qp + 16 * ks);
    asm volatile("" ::: "memory");
    { const float C2q = 0.125f * LOG2E;
#pragma unroll
      for (int ks = 0; ks < 4; ++ks) { u32x4 q4 = __builtin_bit_cast(u32x4, qf[ks]);
#pragma unroll
          for (int e = 0; e < 4; ++e) q4[e] = cvtpk(bflo(q4[e]) * C2q, bfhi(q4[e]) * C2q);
          qf[ks] = __builtin_bit_cast(bf16x8, q4); } }
    ATT_ISSUE(tlo, 0); ATT_ISSUE(tlo + 1, 1); ATT_ISSUE(tlo + 2, 2);
    asm volatile("" ::: "memory");
    float mrun = -1e30f, lrun = 0.f; f32x16 o0, o1;
#pragma unroll
    for (int r = 0; r < 16; ++r) { o0[r] = 0.f; o1[r] = 0.f; }
    const LAS float* bh = biasT + h * 260;
    const unsigned trb = ((lane >> 4) & 1) * 32 + (lane & 3) * 8 + (4 * hi + ((lane & 15) >> 2)) * 64;
    for (int j = 0; j < ntile; ++j) {
        const int left = ntile - 1 - j;
        if (left >= 2) asm volatile("s_waitcnt vmcnt(4) lgkmcnt(0)\n\ts_barrier" ::: "memory");
        else if (left == 1) asm volatile("s_waitcnt vmcnt(2) lgkmcnt(0)\n\ts_barrier" ::: "memory");
        else asm volatile("s_waitcnt vmcnt(0) lgkmcnt(0)\n\ts_barrier" ::: "memory");
        if (j + 3 < ntile) { ATT_ISSUE(tlo + j + 3, (j + 3) & 3); }
        asm volatile("" ::: "memory");
        const int w = tlo + j - qc;
        if (w >= 0 && w <= 8) {
            const LAS unsigned char* kc = ring + (j & 3) * 16384; const LAS unsigned char* vc = kc + 8192;
            bf16x8 kf[2][4];
#pragma unroll
            for (int kb = 0; kb < 2; ++kb)
#pragma unroll
                for (int ks = 0; ks < 4; ++ks) kf[kb][ks] = *(const LAS bf16x8*)(kc + (kb * 4 + ks) * 1024 + 16 * lane);
            f32x16 s0, s1;
#pragma unroll
            for (int r = 0; r < 16; ++r) { s0[r] = 0.f; s1[r] = 0.f; }
#pragma unroll
            for (int ks = 0; ks < 4; ++ks) { s0 = MFMA32(kf[0][ks], qf[ks], s0); s1 = MFMA32(kf[1][ks], qf[ks], s1); }
            const int relb = (8 - w) * 64 + iq;
            float tm = -1e30f, boff = 0.f;
            if (w <= 5) {
                boff = bh[256];
#pragma unroll
                for (int r = 0; r < 16; ++r) tm = fmaxf(tm, fmaxf(s0[r], s1[r]));
                tm += boff;
            } else {
                float bv0[16], bv1[16];
#pragma unroll
                for (int r = 0; r < 16; ++r) { const int j0 = crow(r, hi); int i0 = relb - j0, i1 = relb - j0 - 32; i0 = (i0 > 128 ? 128 : i0) + 128; i1 = (i1 > 128 ? 128 : i1) + 128;
                    bv0[r] = bh[i0]; bv1[r] = bh[i1]; }
#pragma unroll
                for (int r = 0; r < 16; ++r) { s0[r] += bv0[r]; s1[r] += bv1[r]; tm = fmaxf(tm, fmaxf(s0[r], s1[r])); }
            }
            tm = fmaxf(tm, __shfl_xor(tm, 32));
            if (__any(tm > mrun + 8.0f)) {
                const float mn = fmaxf(mrun, tm); const float sc = __builtin_amdgcn_exp2f(mrun - mn); mrun = mn; lrun *= sc;
#pragma unroll
                for (int r = 0; r < 16; ++r) { o0[r] *= sc; o1[r] *= sc; }
            }
            const float sub = mrun - boff;
            float ps = 0.f;
#pragma unroll
            for (int r = 0; r < 16; ++r) { s0[r] = __builtin_amdgcn_exp2f(s0[r] - sub); s1[r] = __builtin_amdgcn_exp2f(s1[r] - sub); ps += s0[r] + s1[r]; }
            lrun += ps;
            bf16x8 pf[2][2];
#pragma unroll
            for (int s2 = 0; s2 < 2; ++s2) {
                u32x4 a, bb;
                a.x = cvtpk(s0[8 * s2 + 0], s0[8 * s2 + 1]); a.y = cvtpk(s0[8 * s2 + 2], s0[8 * s2 + 3]); a.z = cvtpk(s0[8 * s2 + 4], s0[8 * s2 + 5]); a.w = cvtpk(s0[8 * s2 + 6], s0[8 * s2 + 7]);
                bb.x = cvtpk(s1[8 * s2 + 0], s1[8 * s2 + 1]); bb.y = cvtpk(s1[8 * s2 + 2], s1[8 * s2 + 3]); bb.z = cvtpk(s1[8 * s2 + 4], s1[8 * s2 + 5]); bb.w = cvtpk(s1[8 * s2 + 6], s1[8 * s2 + 7]);
                pf[0][s2] = __builtin_bit_cast(bf16x8, a); pf[1][s2] = __builtin_bit_cast(bf16x8, bb);
            }
#pragma unroll
            for (int kb = 0; kb < 2; ++kb)
#pragma unroll
                for (int s2 = 0; s2 < 2; ++s2) {
                    const unsigned off = (4 * kb + 2 * s2) * 512 + trb;
                    const bf16x8 v0 = cat8(trrd(vc + off), trrd(vc + off + 512));
                    const bf16x8 v1 = cat8(trrd(vc + 4096 + off), trrd(vc + 4096 + off + 512));
                    o0 = MFMA32(v0, pf[kb][s2], o0); o1 = MFMA32(v1, pf[kb][s2], o1);
                }
        }
    }
#undef ATT_ISSUE
    lrun += __shfl_xor(lrun, 32);
    const float inv = 1.0f / lrun;
    bf16* op = mixed + (tokg + qc * 64 + iq) * DM + MIX_ATT + h * 64 + 4 * hi;
#pragma unroll
    for (int rg = 0; rg < 4; ++rg) {
        u32x2 w0v, w1v;
        w0v.x = cvtpk(o0[4 * rg] * inv, o0[4 * rg + 1] * inv); w0v.y = cvtpk(o0[4 * rg + 2] * inv, o0[4 * rg + 3] * inv);
        w1v.x = cvtpk(o1[4 * rg] * inv, o1[4 * rg + 1] * inv); w1v.y = cvtpk(o1[4 * rg + 2] * inv, o1[4 * rg + 3] * inv);
        *(u32x2*)(op + 8 * rg) = w0v; *(u32x2*)(op + 32 + 8 * rg) = w1v;
    }
    asm volatile("s_waitcnt lgkmcnt(0)\n\ts_barrier" ::: "memory");
}

__device__ __forceinline__ void attn_pair_unit(const bf16* proj, bf16* mixed, const LAS float* biasT, LAS unsigned char* ring, int u, int wave, int lane) {
    asm volatile("" : "+v"(lane));
    const int hp = u % 3; const int bg = u / 3; const int g2 = bg & 31, b = bg >> 5;
    const int sub = wave >> 2, w4 = wave & 3; const int h = 2 * hp + sub;
    const int qc = w4 >> 1, half = w4 & 1;
    const int r32 = lane & 31, hi = lane >> 5;
    const size_t tokg = (size_t)b * SEQ + (size_t)g2 * 128;
    const int tlo = (g2 < 4) ? 8 - 2 * g2 : 0;
    const int ntile = 10 - tlo;
    LAS unsigned char* ringS = ring + sub * 65536;
    unsigned kdo[2], vdo[2];
#pragma unroll
    for (int q = 0; q < 2; ++q) { const int p = 2 * w4 + q;
        kdo[q] = (unsigned)(32 * (p >> 2) + r32) * LDP + 16u * (p & 3) + 8u * hi;
        vdo[q] = (unsigned)(16 * (p & 3) + 8 * hi + (r32 >> 2)) * LDP + 32u * (p >> 2) + 8u * (lane & 3) + (unsigned)(AV - AK); }
#define ATT_ISSUE(t_, st_) do { const bf16* kt_ = proj + (tokg + (size_t)(t_) * 64 - 512) * LDP + AK + h * 64; \
        _Pragma("unroll") for (int q_ = 0; q_ < 2; ++q_) { \
        glds16_asm(kt_ + kdo[q_], (unsigned)__builtin_amdgcn_readfirstlane((int)(ring0 + (unsigned)((st_) * 16384 + (2 * w4 + q_) * 1024)))); \
        glds16_asm(kt_ + vdo[q_], (unsigned)__builtin_amdgcn_readfirstlane((int)(ring0 + (unsigned)((st_) * 16384 + 8192 + (2 * w4 + q_) * 1024)))); } } while (0)
    const unsigned ring0 = (unsigned)(uintptr_t)ringS;
    const int iq = 32 * half + r32;
    const bf16* qp = proj + (tokg + qc * 64 + iq) * LDP + AQ + h * 64 + 8 * hi;
    bf16x8 qf[4];
#pragma unroll
    for (int ks = 0; ks < 4; ++ks) qf[ks] = *(const bf16x8*)(qp + 16 * ks);
    asm volatile("" ::: "memory");
    { const float C2q = 0.125f * LOG2E;
#pragma unroll
      for (int ks = 0; ks < 4; ++ks) { u32x4 q4 = __builtin_bit_cast(u32x4, qf[ks]);
#pragma unroll
          for (int e = 0; e < 4; ++e) q4[e] = cvtpk(bflo(q4[e]) * C2q, bfhi(q4[e]) * C2q);
          qf[ks] = __builtin_bit_cast(bf16x8, q4); } }
    ATT_ISSUE(tlo, 0); ATT_ISSUE(tlo + 1, 1); if (ntile > 2) { ATT_ISSUE(tlo + 2, 2); }
    asm volatile("" ::: "memory");
    float mrun = -1e30f, lrun = 0.f; f32x16 o0, o1;
#pragma unroll
    for (int r = 0; r < 16; ++r) { o0[r] = 0.f; o1[r] = 0.f; }
    const LAS float* bh = biasT + h * 260;
    const unsigned trb = ((lane >> 4) & 1) * 32 + (lane & 3) * 8 + (4 * hi + ((lane & 15) >> 2)) * 64;
    for (int j = 0; j < ntile; ++j) {
        const int left = ntile - 1 - j;
        if (left >= 2) asm volatile("s_waitcnt vmcnt(8) lgkmcnt(0)\n\ts_barrier" ::: "memory");
        else if (left == 1) asm volatile("s_waitcnt vmcnt(4) lgkmcnt(0)\n\ts_barrier" ::: "memory");
        else asm volatile("s_waitcnt vmcnt(0) lgkmcnt(0)\n\ts_barrier" ::: "memory");
        if (j + 3 < ntile) { ATT_ISSUE(tlo + j + 3, (j + 3) & 3); }
        asm volatile("" ::: "memory");
        const int w = tlo + j - qc;
        if (w >= 0 && w <= 8) {
#if ATT_IGLP >= 0
            __builtin_amdgcn_iglp_opt(ATT_IGLP);
#endif
            const LAS unsigned char* kc = ringS + (j & 3) * 16384; const LAS unsigned char* vc = kc + 8192;
            bf16x8 kf[2][4];
#pragma unroll
            for (int kb = 0; kb < 2; ++kb)
#pragma unroll
                for (int ks = 0; ks < 4; ++ks) kf[kb][ks] = *(const LAS bf16x8*)(kc + (kb * 4 + ks) * 1024 + 16 * lane);
            f32x16 s0, s1;
#pragma unroll
            for (int r = 0; r < 16; ++r) { s0[r] = 0.f; s1[r] = 0.f; }
            __builtin_amdgcn_s_setprio(1);
#pragma unroll
            for (int ks = 0; ks < 4; ++ks) { s0 = MFMA32(kf[0][ks], qf[ks], s0); s1 = MFMA32(kf[1][ks], qf[ks], s1); }
            __builtin_amdgcn_s_setprio(0);
            bf16x8 vf[2][2][2];
#pragma unroll
            for (int kb = 0; kb < 2; ++kb)
#pragma unroll
                for (int s2 = 0; s2 < 2; ++s2) { const unsigned off = (4 * kb + 2 * s2) * 512 + trb;
                    vf[kb][s2][0] = cat8(trrd(vc + off), trrd(vc + off + 512)); vf[kb][s2][1] = cat8(trrd(vc + 4096 + off), trrd(vc + 4096 + off + 512)); }
            asm volatile("" ::: "memory");
            const int relb = (8 - w) * 64 + iq;
            float tm = -1e30f, boff = 0.f;
            if (w <= 5) {
                boff = bh[256];
#pragma unroll
                for (int r = 0; r < 16; ++r) tm = fmaxf(tm, fmaxf(s0[r], s1[r]));
                tm += boff;
            } else {
                float bv0[16], bv1[16];
#pragma unroll
                for (int r = 0; r < 16; ++r) { const int j0 = crow(r, hi); int i0 = relb - j0, i1 = relb - j0 - 32; i0 = (i0 > 128 ? 128 : i0) + 128; i1 = (i1 > 128 ? 128 : i1) + 128;
                    bv0[r] = bh[i0]; bv1[r] = bh[i1]; }
#pragma unroll
                for (int r = 0; r < 16; ++r) { s0[r] += bv0[r]; s1[r] += bv1[r]; tm = fmaxf(tm, fmaxf(s0[r], s1[r])); }
            }
            { auto rr = __builtin_amdgcn_permlane32_swap(__float_as_uint(tm), __float_as_uint(tm), false, false); tm = fmaxf(__uint_as_float(rr[0]), __uint_as_float(rr[1])); }
            if (__any(tm > mrun + 8.0f)) {
                const float mn = fmaxf(mrun, tm); const float sc = __builtin_amdgcn_exp2f(mrun - mn); mrun = mn; lrun *= sc;
#pragma unroll
                for (int r = 0; r < 16; ++r) { o0[r] *= sc; o1[r] *= sc; }
            }
            const float sub = mrun - boff;
            float ps = 0.f;
#pragma unroll
            for (int r = 0; r < 16; ++r) { s0[r] = __builtin_amdgcn_exp2f(s0[r] - sub); s1[r] = __builtin_amdgcn_exp2f(s1[r] - sub); ps += s0[r] + s1[r]; }
            lrun += ps;
            bf16x8 pf[2][2];
#pragma unroll
            for (int s2 = 0; s2 < 2; ++s2) {
                u32x4 a, bb;
                a.x = cvtpk(s0[8 * s2 + 0], s0[8 * s2 + 1]); a.y = cvtpk(s0[8 * s2 + 2], s0[8 * s2 + 3]); a.z = cvtpk(s0[8 * s2 + 4], s0[8 * s2 + 5]); a.w = cvtpk(s0[8 * s2 + 6], s0[8 * s2 + 7]);
                bb.x = cvtpk(s1[8 * s2 + 0], s1[8 * s2 + 1]); bb.y = cvtpk(s1[8 * s2 + 2], s1[8 * s2 + 3]); bb.z = cvtpk(s1[8 * s2 + 4], s1[8 * s2 + 5]); bb.w = cvtpk(s1[8 * s2 + 6], s1[8 * s2 + 7]);
                pf[0][s2] = __builtin_bit_cast(bf16x8, a); pf[1][s2] = __builtin_bit_cast(bf16x8, bb);
            }
#pragma unroll
            for (int kb = 0; kb < 2; ++kb)
#pragma unroll
                for (int s2 = 0; s2 < 2; ++s2) {
                    o0 = MFMA32(vf[kb][s2][0], pf[kb][s2], o0); o1 = MFMA32(vf[kb][s2][1], pf[kb][s2], o1);
                }
        }
    }
#undef ATT_ISSUE
    lrun += __shfl_xor(lrun, 32);
    const float inv = 1.0f / lrun;
    bf16* op = mixed + (tokg + qc * 64 + iq) * DM + MIX_ATT + h * 64 + 4 * hi;
#pragma unroll
    for (int rg = 0; rg < 4; ++rg) {
        u32x2 w0v, w1v;
        w0v.x = cvtpk(o0[4 * rg] * inv, o0[4 * rg + 1] * inv); w0v.y = cvtpk(o0[4 * rg + 2] * inv, o0[4 * rg + 3] * inv);
        w1v.x = cvtpk(o1[4 * rg] * inv, o1[4 * rg + 1] * inv); w1v.y = cvtpk(o1[4 * rg + 2] * inv, o1[4 * rg + 3] * inv);
        *(u32x2*)(op + 8 * rg) = w0v; *(u32x2*)(op + 32 + 8 * rg) = w1v;
    }
    asm volatile("s_waitcnt lgkmcnt(0)\n\ts_barrier" ::: "memory");
}

__device__ __forceinline__ void gla_kv_item(const bf16* proj, const float* bgate, float* kvT, float* decay, LAS unsigned char* vimg, int it, int lane) {
    asm volatile("" : "+v"(lane));
    const int h = it & 3; const size_t tok0 = (size_t)(it >> 2) * 64;
    const int r32 = lane & 31, hi = lane >> 5;
    LDS_FENCE();
    {
        const int kc = lane < 48 ? lane : 47;
        const bf16* zp = proj + tok0 * LDP + GZ + h * 48 + kc; const bf16* kp = proj + tok0 * LDP + GK + h * 48 + kc;
        const float bz = bgate[h * 48 + kc];
        float suf = 0.f;
#pragma unroll
        for (int hb2 = 1; hb2 >= 0; --hb2) {
            bf16 zr[32], kr[32];
#pragma unroll
            for (int i = 0; i < 32; ++i) { zr[i] = STREAM_NT ? __builtin_nontemporal_load(zp + (size_t)(32 * hb2 + i) * LDP) : zp[(size_t)(32 * hb2 + i) * LDP]; kr[i] = STREAM_NT ? __builtin_nontemporal_load(kp + (size_t)(32 * hb2 + i) * LDP) : kp[(size_t)(32 * hb2 + i) * LDP]; }
            asm volatile("" ::: "memory");
#pragma unroll
            for (int i = 31; i >= 0; --i) { const int t = 32 * hb2 + i;
                const float z = bf2f(zr[i]) + bz, kk = bf2f(kr[i]);
                const float la = (fminf(z, 0.f) - __logf(1.f + __expf(-fabsf(z)))) * (1.0f / 16.0f);
                const float kd = kk * __expf(suf); suf += la;
                *(LAS bf16*)(vimg + lane * 144 + t * 2) = (bf16)(cvtpk(kd, 0.f) & 0xffffu); }
        }
        if (lane < 48) decay[(size_t)it * 48 + kc] = __expf(suf);
    }
    LDS_FENCE();
    bf16x8 kfr[2][4];
#pragma unroll
    for (int kb = 0; kb < 2; ++kb)
#pragma unroll
        for (int s = 0; s < 4; ++s) { const int kc = 32 * kb + r32; const int kcc = kc < 48 ? kc : 47;
            u32x4 a = *(const LAS u32x4*)(vimg + kcc * 144 + (16 * s + 8 * hi) * 2);
            if (kc >= 48) a = (u32x4){0u, 0u, 0u, 0u};
            kfr[kb][s] = __builtin_bit_cast(bf16x8, a); }
    LDS_FENCE();
    { u32x4 val[12];
#pragma unroll
      for (int i = 0; i < 12; ++i) { const int id = i * 64 + lane, t = id / 12, ch = id - 12 * t; { const u32x4* vp_ = (const u32x4*)(proj + (tok0 + t) * LDP + GV + h * 96 + 8 * ch); val[i] = STREAM_NT ? __builtin_nontemporal_load(vp_) : *vp_; } }
      asm volatile("" : "+v"(val[0]), "+v"(val[1]), "+v"(val[2]), "+v"(val[3]), "+v"(val[4]), "+v"(val[5]), "+v"(val[6]), "+v"(val[7]), "+v"(val[8]), "+v"(val[9]), "+v"(val[10]), "+v"(val[11]));
#pragma unroll
      for (int i = 0; i < 12; ++i) { const int id = i * 64 + lane, t = id / 12, ch = id - 12 * t; *(LAS u32x4*)(vimg + (ch >> 2) * 4096 + (t >> 3) * 512 + (t & 7) * 64 + (ch & 3) * 16) = val[i]; } }
    f32x16 acc[3][2];
#pragma unroll
    for (int vb = 0; vb < 3; ++vb)
#pragma unroll
        for (int kb = 0; kb < 2; ++kb)
#pragma unroll
            for (int r = 0; r < 16; ++r) acc[vb][kb][r] = 0.f;
    LDS_FENCE();
    const unsigned trb = ((lane >> 4) & 1) * 32 + (lane & 3) * 8 + ((lane & 15) >> 2) * 64 + hi * 512;
#pragma unroll
    for (int s = 0; s < 4; ++s)
#pragma unroll
        for (int vb = 0; vb < 3; ++vb) { const unsigned off = vb * 4096 + (2 * s) * 512 + trb;
            const bf16x8 vf = cat8(trrd(vimg + off), trrd(vimg + off + 256));
            acc[vb][0] = MFMA32(vf, kfr[0][s], acc[vb][0]); acc[vb][1] = MFMA32(vf, kfr[1][s], acc[vb][1]); }
    float* dst = kvT + (size_t)it * 4608;
#pragma unroll
    for (int vb = 0; vb < 3; ++vb)
#pragma unroll
        for (int r = 0; r < 16; ++r) { const int v = 32 * vb + crow(r, hi);
            dst[v * 48 + r32] = acc[vb][0][r];
            if (r32 < 16) dst[v * 48 + 32 + r32] = acc[vb][1][r]; }
    LDS_FENCE();
}
__device__ __forceinline__ void gla_scan(const float* kvT, const float* decay, bf16* St, int gtid, int nthr) {
    for (int e = gtid; e < 32 * 4608; e += nthr) {
        const int bh = e / 4608, rem = e - bh * 4608, k = rem % 48, b = bh >> 2, h = bh & 3;
        float st = 0.f;
#pragma nounroll
        for (int c0 = 0; c0 < 64; c0 += 16) {
            float kv[16], dc[16];
#pragma unroll
            for (int j = 0; j < 16; ++j) { const size_t it = (size_t)(((b * 64 + c0 + j) << 2) + h); kv[j] = STREAM_NT ? __builtin_nontemporal_load(kvT + it * 4608 + rem) : kvT[it * 4608 + rem]; dc[j] = decay[it * 48 + k]; }
            asm volatile("" : "+v"(kv[0]), "+v"(kv[1]), "+v"(kv[2]), "+v"(kv[3]), "+v"(kv[4]), "+v"(kv[5]), "+v"(kv[6]), "+v"(kv[7]), "+v"(kv[8]), "+v"(kv[9]), "+v"(kv[10]), "+v"(kv[11]), "+v"(kv[12]), "+v"(kv[13]), "+v"(kv[14]), "+v"(kv[15]),
                             "+v"(dc[0]), "+v"(dc[1]), "+v"(dc[2]), "+v"(dc[3]), "+v"(dc[4]), "+v"(dc[5]), "+v"(dc[6]), "+v"(dc[7]), "+v"(dc[8]), "+v"(dc[9]), "+v"(dc[10]), "+v"(dc[11]), "+v"(dc[12]), "+v"(dc[13]));
#pragma unroll
            for (int j = 0; j < 16; ++j) { const size_t it = (size_t)(((b * 64 + c0 + j) << 2) + h); st = dc[j] * st + kv[j]; St[it * 4608 + rem] = (bf16)(cvtpk(st, 0.f) & 0xffffu); }
        }
    }
}
__device__ __forceinline__ void gla_out_item(const bf16* proj, const bf16* St, bf16* mixed, int it, int lane) {
    asm volatile("" : "+v"(lane));
    const int h = it & 3; const size_t tok0 = (size_t)(it >> 2) * 64;
    const int r32 = lane & 31, hi = lane >> 5;
    bf16x8 af[3][3], bq[2][3]; u32x2 gg[2][3][4];
#pragma unroll
    for (int vb = 0; vb < 3; ++vb)
#pragma unroll
        for (int ks = 0; ks < 3; ++ks) { const bf16x8* p_ = (const bf16x8*)(St + (size_t)it * 4608 + (32 * vb + r32) * 48 + 16 * ks + 8 * hi); af[vb][ks] = STREAM_NT ? __builtin_nontemporal_load(p_) : *p_; }
#pragma unroll
    for (int tb = 0; tb < 2; ++tb)
#pragma unroll
        for (int ks = 0; ks < 3; ++ks) { const bf16x8* p_ = (const bf16x8*)(proj + (tok0 + 32 * tb + r32) * LDP + GQ + h * 48 + 16 * ks + 8 * hi); bq[tb][ks] = STREAM_NT ? __builtin_nontemporal_load(p_) : *p_; }
#pragma unroll
    for (int tb = 0; tb < 2; ++tb)
#pragma unroll
        for (int vb = 0; vb < 3; ++vb)
#pragma unroll
            for (int rg = 0; rg < 4; ++rg) { const u32x2* p_ = (const u32x2*)(proj + (tok0 + 32 * tb + r32) * LDP + GG + h * 96 + 32 * vb + 8 * rg + 4 * hi); gg[tb][vb][rg] = STREAM_NT ? __builtin_nontemporal_load(p_) : *p_; }
    asm volatile("" : "+v"(af[0][0]), "+v"(af[0][1]), "+v"(af[0][2]), "+v"(af[1][0]), "+v"(af[1][1]), "+v"(af[1][2]), "+v"(af[2][0]), "+v"(af[2][1]), "+v"(af[2][2]),
                     "+v"(bq[0][0]), "+v"(bq[0][1]), "+v"(bq[0][2]), "+v"(bq[1][0]), "+v"(bq[1][1]), "+v"(bq[1][2]));
    f32x16 acc[3][2];
#pragma unroll
    for (int vb = 0; vb < 3; ++vb)
#pragma unroll
        for (int tb = 0; tb < 2; ++tb)
#pragma unroll
            for (int r = 0; r < 16; ++r) acc[vb][tb][r] = 0.f;
#pragma unroll
    for (int ks = 0; ks < 3; ++ks)
#pragma unroll
        for (int vb = 0; vb < 3; ++vb)
#pragma unroll
            for (int tb = 0; tb < 2; ++tb) acc[vb][tb] = MFMA32(af[vb][ks], bq[tb][ks], acc[vb][tb]);
    const float QS = 0.14433756729740643f;
#pragma unroll
    for (int tb = 0; tb < 2; ++tb) {
        float ss = 0.f;
#pragma unroll
        for (int vb = 0; vb < 3; ++vb)
#pragma unroll
            for (int r = 0; r < 16; ++r) { const float x = acc[vb][tb][r] * QS; acc[vb][tb][r] = x; ss += x * x; }
        ss += __shfl_xor(ss, 32);
        const float rn = __builtin_amdgcn_rsqf(ss * (1.0f / 96.0f) + EPS);
        const size_t tok = tok0 + 32 * tb + r32;
#pragma unroll
        for (int vb = 0; vb < 3; ++vb)
#pragma unroll
            for (int rg = 0; rg < 4; ++rg) { const int v0 = 32 * vb + 8 * rg + 4 * hi; const u32x2 g = gg[tb][vb][rg];
                const float g0 = bflo(g.x), g1 = bfhi(g.x), g2 = bflo(g.y), g3 = bfhi(g.y);
                const float y0 = acc[vb][tb][4 * rg + 0] * rn * (g0 * fast_sigmoid(g0));
                const float y1 = acc[vb][tb][4 * rg + 1] * rn * (g1 * fast_sigmoid(g1));
                const float y2 = acc[vb][tb][4 * rg + 2] * rn * (g2 * fast_sigmoid(g2));
                const float y3 = acc[vb][tb][4 * rg + 3] * rn * (g3 * fast_sigmoid(g3));
                u32x2 w; w.x = cvtpk(y0, y1); w.y = cvtpk(y2, y3);
                *(u32x2*)(mixed + tok * DM + MIX_GLA + h * 96 + v0) = w; }
    }
}
#define XB_TMO      128
#define XB_XCNT(j)  (256  + 64 * (j))
#define XB_XSUB(j)  (1280 + 64 * (j))
#define XB_XGEN(j)  (2304 + 64 * (j))
#define XB_TOP      3328
#define XB_TOPGEN   3392
#define XCD_BAR_WORDS 3456
#define XB_SPIN_CAP (1u << 18)

__device__ __forceinline__ unsigned xb_ld(unsigned* p)              { return __hip_atomic_load(p, __ATOMIC_RELAXED, __HIP_MEMORY_SCOPE_AGENT); }
__device__ __forceinline__ unsigned xb_add(unsigned* p, unsigned v) { return __hip_atomic_fetch_add(p, v, __ATOMIC_RELAXED, __HIP_MEMORY_SCOPE_AGENT); }
__device__ __forceinline__ unsigned xb_xcc_id() { return (unsigned)__builtin_amdgcn_s_getreg((3 << 11) | 20) & 0xFu; }
#define XB_SPIN(cond, bar) do { unsigned _sp = 0; while (cond) { __builtin_amdgcn_s_sleep(1); \
    if ((++_sp & 255u) == 0u) { if (xb_ld(&(bar)[XB_TMO])) break; if (_sp > XB_SPIN_CAP) { atomicAdd(&(bar)[XB_TMO], 1u); break; } } } } while (0)

struct XcdBarrier {
    unsigned* bar; unsigned x;
    volatile LAS unsigned* st;
};

__device__ __forceinline__ XcdBarrier xcd_barrier_post(unsigned* bar, volatile LAS unsigned* st) {
    XcdBarrier b; b.bar = bar; b.x = xb_xcc_id(); b.st = st;
    if (threadIdx.x == 0) (void)xb_add(&bar[XB_XCNT(b.x)], 1u);
    return b;
}
__device__ __forceinline__ void xcd_barrier_complete(unsigned* bar, unsigned x, unsigned& nloc, unsigned& nx) {
    const unsigned G = gridDim.x * gridDim.y * gridDim.z;
    unsigned sum, cnt, mine, sp = 0u;
    for (;;) {
        sum = 0u; cnt = 0u; mine = 0u;
#pragma unroll
        for (unsigned j = 0; j < 16; ++j) { const unsigned c = xb_ld(&bar[XB_XCNT(j)]); sum += c; cnt += (c > 0u) ? 1u : 0u; mine = (j == x) ? c : mine; }
        if (sum == G) break;
        __builtin_amdgcn_s_sleep(1);
        if ((++sp & 255u) == 0u) { if (xb_ld(&bar[XB_TMO])) break; if (sp > XB_SPIN_CAP) { atomicAdd(&bar[XB_TMO], 1u); break; } }
    }
    nloc = mine > 0u ? mine : 1u; nx = cnt > 0u ? cnt : 1u;
}

__device__ __forceinline__ void xcd_barrier(const XcdBarrier& b) {
    asm volatile("s_waitcnt vmcnt(0)" ::: "memory");
    __syncthreads();
    if (threadIdx.x == 0) {
        unsigned* bar = b.bar;
        __builtin_amdgcn_s_waitcnt(0);
        unsigned nloc = b.st[0], nx = b.st[1];
        if (nloc == 0u) { xcd_barrier_complete(bar, b.x, nloc, nx); b.st[0] = nloc; b.st[1] = nx; }
        const unsigned old = xb_add(&bar[XB_XSUB(b.x)], 1u);
        const unsigned gen = old / nloc;
        if (old + 1u == (gen + 1u) * nloc) {
            __builtin_amdgcn_fence(__ATOMIC_RELEASE, "agent");
            asm volatile("s_waitcnt vmcnt(0)" ::: "memory");
            const unsigned og = xb_add(&bar[XB_TOP], 1u);
            const unsigned tg = og / nx;
            if (og + 1u == (tg + 1u) * nx) xb_add(&bar[XB_TOPGEN], 1u);
            else XB_SPIN(xb_ld(&bar[XB_TOPGEN]) == tg, bar);
            __builtin_amdgcn_fence(__ATOMIC_ACQUIRE, "agent");
            xb_add(&bar[XB_XGEN(b.x)], 1u);
            asm volatile("s_waitcnt vmcnt(0)" ::: "memory");
        } else {
            XB_SPIN(xb_ld(&bar[XB_XGEN(b.x)]) == gen, bar);
            __builtin_amdgcn_fence(__ATOMIC_ACQUIRE, "agent");
            asm volatile("s_waitcnt vmcnt(0)" ::: "memory");
        }
    }
    __syncthreads();
}

#define KARGS() ({ CArgs* p_ = (CArgs*)__builtin_amdgcn_kernarg_segment_ptr(); size_t z_ = 0; asm volatile("" : "+s"(z_)); p_ + z_; })

__global__ void __launch_bounds__(NWAVES * 64, 2) mega_fwd(Args a) {
    extern __shared__ __attribute__((aligned(16))) unsigned char lds_raw[];
    cg::grid_group grid = cg::this_grid();
    LAS unsigned char* lds = (LAS unsigned char*)lds_raw;
    const int tid = threadIdx.x, lane = tid & 63, wave = __builtin_amdgcn_readfirstlane(tid >> 6);
    const int G = gridDim.x, bx = blockIdx.x;
    const int gw = bx * NWAVES + wave, ngw = G * NWAVES;
    unsigned char* ws = a.ws;
    bf16* hb = (bf16*)(ws + WS_HB); bf16* proj = (bf16*)(ws + WS_PROJ); bf16* mixed = (bf16*)(ws + WS_MIX); bf16* ffb = (bf16*)(ws + WS_FF);
    float* sspart = (float*)(ws + WS_SS); float* kvT = (float*)(ws + WS_KVT); float* decay = (float*)(ws + WS_DEC); bf16* St = (bf16*)(ws + WS_ST);
    float* out = a.out;
#if USE_XCD
    volatile LAS unsigned* MISC = (volatile LAS unsigned*)(lds + 143360);
    if (tid < 32) MISC[tid] = 0u;
    __syncthreads();
    XcdBarrier bar = xcd_barrier_post((unsigned*)(ws + WS_CTL) + 4096, MISC + 8);
#define GSYNC() xcd_barrier(bar)
#else
#define GSYNC() do { __threadfence(); grid.sync(); } while (0)
#endif

#ifndef REP_P0
#define REP_P0 1
#endif
#ifndef REP_B1
#define REP_B1 1
#endif
#ifndef REP_B23
#define REP_B23 1
#endif
#pragma nounroll
    for (int rep = 0; rep < REP_P0; ++rep) {
#if WSTAG
    p0_weights(KARGS(), (LAS float*)(lds + wave * 16384), 0, 2048, gw, ngw, lane);
    p0_weights(KARGS(), (LAS float*)(lds + wave * 16384), 4096, 6144, gw, ngw, lane);
    p0_weights(KARGS(), (LAS float*)(lds + wave * 16384), 10240, 12288, gw, ngw, lane);
#else
    p0_weights(KARGS(), (LAS float*)(lds + wave * 16384), 0, 12288, gw, ngw, lane);
#endif
    p0_rows(a.in[0], hb, sspart, gw, ngw, lane);
    }
#if USE_XCD
    if (G == 0x7fffffff) grid.sync();
    GSYNC();
#else
    __threadfence(); grid.sync();
#endif

#ifndef STAG_A
#define STAG_A 0
#endif
#ifndef STAG_D
#define STAG_D 0
#endif
#define STAGGER_WORK(lo_, hi_) do { if (WSTAG) { if (bx & 1) { int lane_s = threadIdx.x & 63; asm volatile("" : "+v"(lane_s)); \
        p0_weights(KARGS(), (LAS float*)(lds + wave * 16384), (lo_), (hi_), (bx >> 1) * NWAVES + wave, (G >> 1) * NWAVES, lane_s); } __syncthreads(); } } while (0)
#ifndef STAG_A
#define STAG_A 0
#endif
#ifndef STAG_D
#define STAG_D 0
#endif
#define STAGGER_IDLE(ticks) do { if ((ticks) > 0 && (bx & 1)) { const unsigned long long t0_ = __builtin_amdgcn_s_memrealtime(); while (__builtin_amdgcn_s_memrealtime() - t0_ < (unsigned long long)(ticks)) __builtin_amdgcn_s_sleep(8); } } while (0)
#define LAUNDER(p) do { size_t z_ = 0; asm volatile("" : "+s"(z_)); (p) = (p) + z_; } while (0)
#pragma nounroll
    for (int l = 0; l < 2; ++l) {
        const unsigned char* wl = KARGS()->ws + WS_W + (size_t)l * W_LAYER;
#ifndef REP_GA
#define REP_GA 1
#endif
#ifndef REP_GD
#define REP_GD 1
#endif
#pragma nounroll
        for (int rg = 0; rg < REP_GA; ++rg) { const bf16* gA = ((bf16*)(KARGS()->ws + WS_HB)); const bf16* gB = (const bf16*)(wl + W_IN); LAUNDER(gA); LAUNDER(gB);
          STAGGER_IDLE(STAG_A);
          pg8::Gemm g{gA, gB, MTOK, LDP, DM}; pg8::StaticOrder S; S.init(MTOK, LDP, G, bx);
#if PROBE_DRY
          if (rg + 1 < REP_GA) { pg8::EpiScaleBf16<0, true> E{((bf16*)(KARGS()->ws + WS_PROJ)), LDP, ((float*)(KARGS()->ws + WS_SS))};
          pg8::gemm_phase<pg8::EpiScaleBf16<0, true>, pg8::StaticOrder, true, PG_SP2>(lds, g, S, E); } else
#endif
          { pg8::EpiScaleBf16<0> E{((bf16*)(KARGS()->ws + WS_PROJ)), LDP, ((float*)(KARGS()->ws + WS_SS))};
          pg8::gemm_phase<pg8::EpiScaleBf16<0>, pg8::StaticOrder, true, PG_SP2>(lds, g, S, E); } }
        GSYNC();
        { bf16* projL = ((bf16*)(KARGS()->ws + WS_PROJ)); bf16* mixedL = ((bf16*)(KARGS()->ws + WS_MIX)); float* kvTL = ((float*)(KARGS()->ws + WS_KVT)); float* decayL = ((float*)(KARGS()->ws + WS_DEC)); bf16* StL = ((bf16*)(KARGS()->ws + WS_ST)); LAUNDER(projL); LAUNDER(mixedL); LAUNDER(kvTL); LAUNDER(decayL); LAUNDER(StL);
#pragma nounroll
        for (int rep = 0; rep < REP_B1; ++rep) {
#ifndef REP_CONV
#define REP_CONV 1
#endif
#ifndef REP_KV
#define REP_KV 1
#endif
#ifndef REP_ATT
#define REP_ATT 1
#endif
#ifndef REP_SCAN
#define REP_SCAN 1
#endif
#ifndef REP_OUT
#define REP_OUT 1
#endif
#ifndef NO_CONV
#pragma nounroll
        for (int rc = 0; rc < REP_CONV; ++rc)
        for (int bc = bx; bc < 512; bc += G)
            conv_item(projL, KARGS()->in[6] + l * 31 * 256, KARGS()->in[7] + l * 256, KARGS()->in[8] + l * 256, KARGS()->in[9] + l * 256, mixedL, lds, bc, tid, wave, lane);
#endif
        {
            LAS float* biasT = (LAS float*)(lds + 131072);
            int tidb = threadIdx.x; asm volatile("" : "+v"(tidb));
            for (int i = tidb; i < 6 * 257; i += NWAVES * 64) { const int hh = i / 257, j = i - hh * 257; biasT[hh * 260 + j] = KARGS()->in[10][(size_t)l * 6 * 257 + i] * LOG2E; }
            __syncthreads();
            LAS unsigned char* vimg = lds + wave * 16384;
#ifndef NO_GLAKV
#pragma nounroll
            for (int rc = 0; rc < REP_KV; ++rc)
            for (int it = gw; it < 2048; it += ngw) gla_kv_item(projL, KARGS()->in[4] + l * 192, kvTL, decayL, vimg, it, lane);
#endif
#ifndef NO_ATT
#pragma nounroll
            for (int rc = 0; rc < REP_ATT; ++rc)
#if ATT_BLOCK
            __syncthreads();
#pragma nounroll
            for (int ra = 0; ra < REP_ATT; ++ra)
            for (int u = bx; u < 768; u += G) {
                int uu = u;
                if (G == 256) { const int combo = (u >> 8) * 8 + (bx & 7); uu = ((combo / 3) * 32 + (bx >> 3)) * 3 + combo % 3; }
                ATT_UNIT_FN(projL, mixedL, biasT, lds, uu, wave, lane);
            }
#else
            for (int u = gw; u < 6144; u += ngw) attn_unit(projL, mixedL, biasT, vimg, u, lane);
#endif
#endif
        }
        __syncthreads();
        }
        GSYNC();
#pragma nounroll
        for (int rep = 0; rep < REP_B23; ++rep) {
        LAUNDER(kvTL); LAUNDER(decayL); LAUNDER(StL);
#pragma nounroll
        for (int rc = 0; rc < REP_SCAN; ++rc)
        { int tids = threadIdx.x; asm volatile("" : "+v"(tids)); gla_scan(kvTL, decayL, StL, bx * (NWAVES * 64) + tids, G * NWAVES * 64); }
        GSYNC();
        LAUNDER(projL); LAUNDER(mixedL); LAUNDER(StL);
#ifndef NO_GLAOUT
#pragma nounroll
        for (int rc = 0; rc < REP_OUT; ++rc)
        for (int it = gw; it < 2048; it += ngw) gla_out_item(projL, StL, mixedL, it, lane);
#endif
        GSYNC();
        }
        }
#ifndef REP_GC
#define REP_GC 1
#endif
#ifndef REP_GE
#define REP_GE 1
#endif
#pragma nounroll
        for (int rgc = 0; rgc < REP_GC; ++rgc)
        { const bf16* gA = ((bf16*)(KARGS()->ws + WS_MIX)); const bf16* gB = (const bf16*)(wl + W_OUT); LAUNDER(gA); LAUNDER(gB);
          STAGGER_WORK(l == 0 ? 2048 : 8192, l == 0 ? 4096 : 10240);
          pg8::Gemm g{gA, gB, MTOK, DM, DM}; pg8::StaticOrder S; S.init(MTOK, DM, G, bx);
          pg8::EpiResid E{((bf16*)(KARGS()->ws + WS_HB)), rgc + 1 < REP_GC ? (bf16*)(KARGS()->ws + 371 * MiB) : ((bf16*)(KARGS()->ws + WS_HB)), ((float*)(KARGS()->ws + WS_SS))};
          pg8::gemm_phase<pg8::EpiResid, pg8::StaticOrder, true, PG_SP2>(lds, g, S, E); }
        GSYNC();
#pragma nounroll
        for (int rg = 0; rg < REP_GD; ++rg) { const bf16* gA = ((bf16*)(KARGS()->ws + WS_HB)); const bf16* gB = (const bf16*)(wl + W_UP); LAUNDER(gA); LAUNDER(gB);
          STAGGER_IDLE(STAG_D);
          pg8::Gemm g{gA, gB, MTOK, FF, DM}; pg8::StaticOrder S; S.init(MTOK, FF, G, bx);
          pg8::EpiScaleBf16<1> E{((bf16*)(KARGS()->ws + WS_FF)), FF, ((float*)(KARGS()->ws + WS_SS))};
          pg8::gemm_phase<pg8::EpiScaleBf16<1>, pg8::StaticOrder, true, PG_SP2>(lds, g, S, E); }
        GSYNC();
#pragma nounroll
        for (int rge = 0; rge < REP_GE; ++rge)
        { const bf16* gA = ((bf16*)(KARGS()->ws + WS_FF)); const bf16* gB = (const bf16*)(wl + W_DN); LAUNDER(gA); LAUNDER(gB);
          STAGGER_WORK(l == 0 ? 6144 : 0, l == 0 ? 8192 : 0);
          pg8::Gemm g{gA, gB, MTOK, DM, FF}; pg8::StaticOrder S; S.init(MTOK, DM, G, bx);
          pg8::EpiResid E{((bf16*)(KARGS()->ws + WS_HB)), rge + 1 < REP_GE ? (bf16*)(KARGS()->ws + 371 * MiB) : ((bf16*)(KARGS()->ws + WS_HB)), ((float*)(KARGS()->ws + WS_SS))};
          pg8::gemm_phase<pg8::EpiResid, pg8::StaticOrder, true, PG_SP2>(lds, g, S, E); }
        GSYNC();
    }
    { int lane2 = tid & 63; asm volatile("" : "+v"(lane2)); final_rows((KARGS()->out), ((bf16*)(KARGS()->ws + WS_HB)), ((float*)(KARGS()->ws + WS_SS)), KARGS()->in[15], gw, ngw, lane2); }
}

extern "C" void kernel_launch(void* const* d_in, const int* in_sizes, int n_in, void* d_out, int out_size, void* d_ws, size_t ws_size, hipStream_t stream) {
    static int grid = 0;
    if (grid == 0) {
        if (n_in != 16 || in_sizes[0] != MTOK * DM || out_size != MTOK * DM || ws_size < WS_END) { fprintf(stderr, "kernel_launch: unexpected shapes (n_in %d, ws %zu)\n", n_in, ws_size); grid = -1; return; }
        int dev = 0, cus = 0, per_cu = 0;
        if (hipGetDevice(&dev) != hipSuccess || hipDeviceGetAttribute(&cus, hipDeviceAttributeMultiprocessorCount, dev) != hipSuccess) { grid = -1; return; }
        if (hipFuncSetAttribute((const void*)mega_fwd, hipFuncAttributeMaxDynamicSharedMemorySize, LDS_BYTES) != hipSuccess) { fprintf(stderr, "kernel_launch: hipFuncSetAttribute failed\n"); grid = -1; return; }
        if (hipOccupancyMaxActiveBlocksPerMultiprocessor(&per_cu, (const void*)mega_fwd, NWAVES * 64, LDS_BYTES) != hipSuccess || per_cu < 1) { fprintf(stderr, "kernel_launch: occupancy query says %d blocks per CU\n", per_cu); (void)hipGetLastError(); grid = -1; return; }
        grid = cus;
    }
    if (grid < 0) return;
#if USE_XCD
    if (hipMemsetAsync((char*)d_ws + WS_CTL, 0, 65536, stream) != hipSuccess) { fprintf(stderr, "kernel_launch: memset failed\n"); return; }
#endif
    Args a{};
    for (int i = 0; i < 16; ++i) a.in[i] = (const float*)d_in[i];
    a.out = (float*)d_out; a.ws = (unsigned char*)d_ws;
    void* args[] = {&a};
    const hipError_t e = hipLaunchCooperativeKernel((const void*)mega_fwd, dim3(grid), dim3(NWAVES * 64), args, LDS_BYTES, stream);
    if (e != hipSuccess) fprintf(stderr, "kernel_launch: cooperative launch failed: %s (grid %d)\n", hipGetErrorString(e), grid);
}
```

```cpp
#include <hip/hip_runtime.h>
#include <hip/hip_cooperative_groups.h>
#include <cstdio>
#include <cstdint>
namespace cg = cooperative_groups;
#ifndef USE_XCD
#define USE_XCD 1
#endif
#ifndef PROBE_DRY
#define PROBE_DRY 0
#endif
#define STAG_A 0
#define STAG_D 0
#ifndef PG_SP2
#define PG_SP2 true
#endif
#ifndef ATT_IGLP
#define ATT_IGLP -1
#endif
#ifndef STREAM_NT
#define STREAM_NT 1
#endif
#ifndef WSTAG
#define WSTAG 1
#endif
#ifndef ATT_BLOCK
#define ATT_BLOCK 1
#endif
#ifndef ATT_PAIR
#define ATT_PAIR 1
#endif
#if ATT_PAIR
#define ATT_UNIT_FN attn_pair_unit
#else
#define ATT_UNIT_FN attn_block_unit
#endif
namespace pg8 {
#define PG8_LAS __attribute__((address_space(3)))
typedef unsigned short bf16_t;
typedef short bf16x8 __attribute__((ext_vector_type(8)));
typedef float f32x4 __attribute__((ext_vector_type(4)));
typedef unsigned u32x4 __attribute__((ext_vector_type(4)));
constexpr int BM = 256, BK = 64, HALF = 128, HTB = HALF * BK * 2  , STAGE_BYTES = 8 * HTB, NXCD = 8, WGM = 8;

__host__ __device__ __forceinline__ int lds_byte(int r, int c) { const int st = (r >> 4) * 2 + (c >> 5), rr = r & 15, cc = c & 31, ob = rr * 64 + cc * 2; return st * 1024 + (ob ^ (((ob >> 9) & 1) << 5)); }
__host__ __device__ __forceinline__ void stage_rc(int b, int& R, int& C) { const int st = b / 1024, sb = b % 1024, swz = sb ^ (((sb >> 9) & 1) << 5); R = (st >> 1) * 16 + swz / 64; C = (st & 1) * 32 + (swz % 64) / 2; }
__host__ __device__ __forceinline__ int perm32(int rho) { const int n = rho >> 4, i = rho & 15; return 8 * (i >> 2) + 4 * n + (i & 3); }

struct Unit { int pm, pn; };
struct Gemm { const bf16_t* A; const bf16_t* Bt; int M, N, K; };

struct StaticOrder {
    int nM, nN, nwg, G, c;
    __host__ __device__ void init(int M, int N, int G_, int c_) { nM = M / BM; nN = N / BM; nwg = nM * nN; G = G_; c = c_; }
    __host__ __device__ bool next(int i, Unit& u) const {
        const long L = (long)i * G + c; if (L >= nwg) return false;
        int wgid = (int)L; { const int q = nwg / NXCD, r = nwg % NXCD, xcd = wgid % NXCD, off = wgid / NXCD; wgid = (xcd < r ? xcd * (q + 1) : r * (q + 1) + (xcd - r) * q) + off; }
        const int nig = WGM * nN, gid = wgid / nig, fm = gid * WGM, gsz = (nM - fm) < WGM ? (nM - fm) : WGM;
        u.pm = fm + ((wgid % nig) % gsz); u.pn = (wgid % nig) / gsz; return true;
    }
    __device__ __forceinline__ void a_ready(const Unit&) const {}
    __device__ __forceinline__ void done(const Unit&) const {}
};

__device__ __forceinline__ unsigned cvt_pk_bf16(float lo, float hi) { unsigned r; asm volatile("v_cvt_pk_bf16_f32 %0, %1, %2" : "=v"(r) : "v"(lo), "v"(hi)); return r; }

__device__ __forceinline__ unsigned cvtpk2(float lo, float hi) { typedef float f2_t __attribute__((ext_vector_type(2))); typedef __bf16 b2_t __attribute__((ext_vector_type(2))); f2_t v = {lo, hi}; b2_t b = __builtin_convertvector(v, b2_t); return __builtin_bit_cast(unsigned, b); }
#ifndef FF_NT
#define FF_NT 0
#endif
#ifndef EPI_WT
#define EPI_WT 0
#endif
#ifndef EPI_WT8
#define EPI_WT8 0
#endif
__device__ __forceinline__ void st16_wt(void* p, u32x4 v) {
#if EPI_WT
    asm volatile("global_store_dwordx4 %0, %1, off sc1\n\ts_nop 1" :: "v"(p), "v"(v) : "memory");
#else
    *(u32x4*)p = v;
#endif
}
typedef unsigned u32x2w __attribute__((ext_vector_type(2)));
__device__ __forceinline__ void st8_wt(void* p, u32x2w v) {
#if EPI_WT8
    asm volatile("global_store_dwordx2 %0, %1, off sc1" :: "v"(p), "v"(v) : "memory");
#else
    *(u32x2w*)p = v;
#endif
}
__device__ __forceinline__ float row_rstd16(const float* sspart, int row, int fq) {
    const f32x4 p = *(const f32x4*)(sspart + (size_t)row * 16 + 4 * fq);
    float s = (p[0] + p[1]) + (p[2] + p[3]);
    s += __shfl_xor(s, 16); s += __shfl_xor(s, 32);
    return __builtin_amdgcn_rsqf(s * (1.0f / 1024.0f) + 1e-6f);
}
template <int ACT, bool DRY = false, bool SCALE = true> struct EpiScaleBf16 {
    static constexpr bool PERM = true, AFTER_DRAIN = false; static constexpr int A_AUX = 0;
    bf16_t* O; int ldc; const float* sspart;
    __device__ __forceinline__ void operator()(const f32x4 (&acc)[2][2][4][2], const Unit& u, int wr, int wc, int fr, int fq) const {
        const int row0 = u.pm * BM + wr * 64 + fr; const int col0 = u.pn * BM + wc * 32 + 8 * fq;
        float rs[2][4];
        if constexpr (SCALE) { f32x4 pp[2][4];
#pragma unroll
        for (int ai = 0; ai < 2; ++ai)
#pragma unroll
            for (int m = 0; m < 4; ++m) pp[ai][m] = *(const f32x4*)(sspart + (size_t)(row0 + ai * HALF + m * 16) * 16 + 4 * fq);
        asm volatile("" : "+v"(pp[0][0]), "+v"(pp[0][1]), "+v"(pp[0][2]), "+v"(pp[0][3]), "+v"(pp[1][0]), "+v"(pp[1][1]), "+v"(pp[1][2]), "+v"(pp[1][3]));
#pragma unroll
        for (int ai = 0; ai < 2; ++ai)
#pragma unroll
            for (int m = 0; m < 4; ++m) { const f32x4 p = pp[ai][m]; rs[ai][m] = (p[0] + p[1]) + (p[2] + p[3]); }
#pragma unroll
        for (int ai = 0; ai < 2; ++ai)
#pragma unroll
            for (int m = 0; m < 4; ++m) { float s = rs[ai][m]; s += __shfl_xor(s, 16); s += __shfl_xor(s, 32); rs[ai][m] = __builtin_amdgcn_rsqf(s * (1.0f / 1024.0f) + 1e-6f); }
        } else {
#pragma unroll
            for (int ai = 0; ai < 2; ++ai)
#pragma unroll
                for (int m = 0; m < 4; ++m) rs[ai][m] = 1.0f;
        }
#pragma unroll
        for (int ai = 0; ai < 2; ++ai)
#pragma unroll
            for (int m = 0; m < 4; ++m) { const int row = row0 + ai * HALF + m * 16; const float r = rs[ai][m];
                bf16_t* rowp = O + (size_t)row * ldc + col0;
#pragma unroll
                for (int bj = 0; bj < 2; ++bj) { f32x4 v0 = acc[ai][bj][m][0] * r, v1 = acc[ai][bj][m][1] * r;
                    if (ACT == 1) {
#pragma unroll
                        for (int e = 0; e < 4; ++e) { const float a = fmaxf(v0[e], 0.f), b = fmaxf(v1[e], 0.f); v0[e] = a * a; v1[e] = b * b; } }
                    u32x4 w; w.x = cvtpk2(v0[0], v0[1]); w.y = cvtpk2(v0[2], v0[3]); w.z = cvtpk2(v1[0], v1[1]); w.w = cvtpk2(v1[2], v1[3]);
                    if (!DRY || w.x == 0x7fc17fc1u) { if (ACT == 1 && FF_NT) __builtin_nontemporal_store(w, (u32x4*)(rowp + bj * HALF)); else st16_wt(rowp + bj * HALF, w); } } }
    }
};
#ifndef RESID_A_AUX
#define RESID_A_AUX 0
#endif
struct EpiResid {
    static constexpr bool PERM = false, AFTER_DRAIN = false; static constexpr int A_AUX = RESID_A_AUX;
    const bf16_t* hin; bf16_t* hb; float* sspart; const float* ss_scale;
    __device__ __forceinline__ void operator()(const f32x4 (&acc)[2][2][4][2], const Unit& u, int wr, int wc, int fr, int fq) const {
        typedef unsigned u32x2v __attribute__((ext_vector_type(2)));
        const int col0 = u.pn * BM + wc * 32 + 4 * fq;
#pragma unroll
        for (int ai = 0; ai < 2; ++ai) {
            u32x2v bs[4][2][2];
#pragma unroll
            for (int m = 0; m < 4; ++m) { const size_t off = (size_t)(u.pm * BM + ai * HALF + wr * 64 + m * 16 + fr) * 1024 + col0;
#pragma unroll
                for (int bj = 0; bj < 2; ++bj)
#pragma unroll
                    for (int n = 0; n < 2; ++n) bs[m][bj][n] = *(const u32x2v*)(hin + off + bj * HALF + n * 16); }
            f32x4 pp[4]; float r2[4];
            if (ss_scale) {
#pragma unroll
                for (int m = 0; m < 4; ++m) pp[m] = *(const f32x4*)(ss_scale + (size_t)(u.pm * BM + ai * HALF + wr * 64 + m * 16 + fr) * 16 + 4 * fq);
                asm volatile("" : "+v"(pp[0]), "+v"(pp[1]), "+v"(pp[2]), "+v"(pp[3]));
#pragma unroll
                for (int m = 0; m < 4; ++m) { const f32x4 p = pp[m]; float s = (p[0] + p[1]) + (p[2] + p[3]); s += __shfl_xor(s, 16); s += __shfl_xor(s, 32); r2[m] = __builtin_amdgcn_rcpf(s * (1.0f / 1024.0f) + 1e-6f); }
            } else {
#pragma unroll
                for (int m = 0; m < 4; ++m) r2[m] = 1.0f;
            }
            asm volatile("" : "+v"(bs[0][0][0]), "+v"(bs[0][0][1]), "+v"(bs[0][1][0]), "+v"(bs[0][1][1]), "+v"(bs[1][0][0]), "+v"(bs[1][0][1]), "+v"(bs[1][1][0]), "+v"(bs[1][1][1]),
                             "+v"(bs[2][0][0]), "+v"(bs[2][0][1]), "+v"(bs[2][1][0]), "+v"(bs[2][1][1]), "+v"(bs[3][0][0]), "+v"(bs[3][0][1]), "+v"(bs[3][1][0]), "+v"(bs[3][1][1]) :: "memory");
#pragma unroll
            for (int m = 0; m < 4; ++m) { const int r = u.pm * BM + ai * HALF + wr * 64 + m * 16 + fr; const size_t off = (size_t)r * 1024 + col0; float ss = 0.f;
#pragma unroll
                for (int bj = 0; bj < 2; ++bj)
#pragma unroll
                    for (int n = 0; n < 2; ++n) { const u32x2v b = bs[m][bj][n]; f32x4 o = acc[ai][bj][m][n] * r2[m];
                        o[0] += __uint_as_float(b.x << 16); o[1] += __uint_as_float(b.x & 0xffff0000u); o[2] += __uint_as_float(b.y << 16); o[3] += __uint_as_float(b.y & 0xffff0000u);
                        u32x2v w; w.x = cvtpk2(o[0], o[1]); w.y = cvtpk2(o[2], o[3]); st8_wt(hb + off + bj * HALF + n * 16, w);
                        ss += (o[0] * o[0] + o[1] * o[1]) + (o[2] * o[2] + o[3] * o[3]); }
                ss += __shfl_xor(ss, 16); ss += __shfl_xor(ss, 32);
                if (fq == 0) sspart[(size_t)r * 16 + u.pn * 4 + wc] = ss; }
            asm volatile("" ::: "memory");
        }
    }
};
template <class Epi, class Sched, bool ALIGN_EPI = false, bool SP2 = false>
__device__ __forceinline__ void gemm_phase(PG8_LAS unsigned char* lds, const Gemm g, const Sched& S, const Epi& E) {
    int tid_ = threadIdx.x; asm volatile("" : "+v"(tid_));
    const int tid = tid_, wid = __builtin_amdgcn_readfirstlane(tid >> 6), lane = tid & 63, wr = wid >> 2, wc = wid & 3, fr = lane & 15, fq = lane >> 4;
    const int K = g.K, nt = K / BK;
    unsigned voffA[2], voffB[2];
#pragma unroll
    for (int i = 0; i < 2; ++i) { int R, C; stage_rc(tid * 16 + i * 8192, R, C); const int Rb = Epi::PERM ? ((R & ~31) + perm32(R & 31)) : R;
        voffA[i] = (unsigned)(R * K + C) * 2u; voffB[i] = (unsigned)(Rb * K + C) * 2u; }
    const size_t kstep = (size_t)(BK * 2);
    const size_t hstep = (size_t)HALF * K * 2;
    const size_t tstep = 2 * hstep;
    const unsigned ldsw = (unsigned)wid * 1024u;
    const int aoff = lds_byte(wr * 64 + fr, fq * 8), boff = lds_byte(wc * 32 + fr, fq * 8);
#define PG8_SA(b, h) (((b) * 2 + (h)) * HTB)
#define PG8_SB(b, h) ((4 + (b) * 2 + (h)) * HTB)
#define PG8_STAGE(bufoff, gbase, voff) do { _Pragma("unroll") for (int _i = 0; _i < 2; ++_i) \
        __builtin_amdgcn_global_load_lds((const unsigned*)((const char*)(gbase) + (voff)[_i]), (PG8_LAS unsigned*)(lds + (bufoff) + ldsw + _i * 8192), 16, 0, 0); } while (0)
#define PG8_STAGE_A(bufoff, gbase, voff) do { _Pragma("unroll") for (int _i = 0; _i < 2; ++_i) \
        __builtin_amdgcn_global_load_lds((const unsigned*)((const char*)(gbase) + (voff)[_i]), (PG8_LAS unsigned*)(lds + (bufoff) + ldsw + _i * 8192), 16, 0, Epi::A_AUX); } while (0)
#define PG8_LDA(dst, b, h) do { _Pragma("unroll") for (int m = 0; m < 4; ++m) _Pragma("unroll") for (int k = 0; k < 2; ++k) dst[m][k] = *(const PG8_LAS bf16x8*)(lds + PG8_SA(b, h) + aoff + m * 2048 + k * 1024); } while (0)
#define PG8_LDB(dst, b, h) do { _Pragma("unroll") for (int n = 0; n < 2; ++n) _Pragma("unroll") for (int k = 0; k < 2; ++k) dst[n][k] = *(const PG8_LAS bf16x8*)(lds + PG8_SB(b, h) + boff + n * 2048 + k * 1024); } while (0)
#define PG8_MMA(ai, bj, At, Bt) do { __builtin_amdgcn_s_setprio(1); _Pragma("unroll") for (int m = 0; m < 4; ++m) _Pragma("unroll") for (int n = 0; n < 2; ++n) _Pragma("unroll") for (int k = 0; k < 2; ++k) \
        acc[ai][bj][m][n] = __builtin_amdgcn_mfma_f32_16x16x32_bf16(Bt[n][k], At[m][k], acc[ai][bj][m][n], 0, 0, 0); __builtin_amdgcn_s_setprio(0); } while (0)
#define PG8_WAIT_V(n) asm volatile("s_waitcnt vmcnt(" #n ")" ::: "memory")
#define PG8_WAIT_L(n) asm volatile("s_waitcnt lgkmcnt(" #n ")" ::: "memory")
#define PG8_BAR __builtin_amdgcn_s_barrier()
#define PG8_SCHED __builtin_amdgcn_sched_barrier(0)
    Unit cur, nxt; int ui = 0;
    if (!S.next(0, cur)) return;
    f32x4 acc[2][2][4][2];
#pragma unroll
    for (int a = 0; a < 2; ++a)
#pragma unroll
        for (int b = 0; b < 2; ++b)
#pragma unroll
            for (int m = 0; m < 4; ++m)
#pragma unroll
                for (int n = 0; n < 2; ++n) acc[a][b][m][n] = (f32x4){0.f, 0.f, 0.f, 0.f};
    bf16x8 At[4][2], B0[2][2], B1[2][2];
    const char* cA = (const char*)g.A + (size_t)cur.pm * tstep; const char* cB = (const char*)g.Bt + (size_t)cur.pn * tstep;
    S.a_ready(cur);
    if constexpr (SP2) {
        PG8_STAGE(PG8_SB(0, 0), cB, voffB); PG8_STAGE(PG8_SB(0, 1), cB + hstep, voffB); PG8_STAGE_A(PG8_SA(0, 0), cA, voffA); PG8_STAGE_A(PG8_SA(0, 1), cA + hstep, voffA);
        if (wr == 1) PG8_BAR;
        PG8_WAIT_V(2); PG8_BAR;
        PG8_STAGE(PG8_SB(1, 0), cB + kstep, voffB); PG8_STAGE_A(PG8_SA(1, 0), cA + kstep, voffA); PG8_STAGE(PG8_SB(1, 1), cB + hstep + kstep, voffB);
        PG8_WAIT_V(6); PG8_BAR;
    } else {
        PG8_STAGE(PG8_SB(0, 0), cB, voffB); PG8_STAGE_A(PG8_SA(0, 0), cA, voffA); PG8_STAGE(PG8_SB(0, 1), cB + hstep, voffB); PG8_STAGE_A(PG8_SA(0, 1), cA + hstep, voffA);
        if (wr == 1) PG8_BAR;
        PG8_WAIT_V(4); PG8_BAR;
        PG8_STAGE(PG8_SB(1, 0), cB + kstep, voffB); PG8_STAGE_A(PG8_SA(1, 0), cA + kstep, voffA); PG8_STAGE(PG8_SB(1, 1), cB + hstep + kstep, voffB);
        PG8_WAIT_V(6); PG8_BAR;
    }
    for (;;) {
        const bool has_next = S.next(ui + 1, nxt);
        const char* nA = has_next ? (const char*)g.A + (size_t)nxt.pm * tstep : cA; const char* nB = has_next ? (const char*)g.Bt + (size_t)nxt.pn * tstep : cB;
        for (int t = 0; t < nt; t += 2) {
            const bool last = (t == nt - 2);
            const char* a1 = cA + (size_t)(t + 1) * kstep;
            const char* a2 = last ? nA : cA + (size_t)(t + 2) * kstep; const char* b2 = last ? nB : cB + (size_t)(t + 2) * kstep;
            const char* a3 = a2 + kstep; const char* b3 = b2 + kstep;
            if (last && has_next) S.a_ready(nxt);
            if constexpr (SP2) {
            PG8_LDB(B0, 0, 0); PG8_LDB(B1, 0, 1); PG8_SCHED; PG8_LDA(At, 0, 0); PG8_STAGE_A(PG8_SA(1, 1), a1 + hstep, voffA);
            PG8_WAIT_V(8); PG8_WAIT_L(0); PG8_BAR; PG8_MMA(0, 0, At, B0); PG8_MMA(0, 1, At, B1); PG8_BAR; PG8_SCHED;
            PG8_LDA(At, 0, 1); PG8_STAGE(PG8_SB(0, 0), b2, voffB); PG8_STAGE(PG8_SB(0, 1), b2 + hstep, voffB); PG8_STAGE_A(PG8_SA(0, 0), a2, voffA);
            PG8_WAIT_V(8); PG8_WAIT_L(0); PG8_BAR; PG8_MMA(1, 0, At, B0); PG8_MMA(1, 1, At, B1); PG8_BAR; PG8_SCHED;
            PG8_LDB(B0, 1, 0); PG8_LDB(B1, 1, 1); PG8_SCHED; PG8_LDA(At, 1, 0); PG8_STAGE_A(PG8_SA(0, 1), a2 + hstep, voffA);
            PG8_WAIT_V(8); PG8_WAIT_L(0); PG8_BAR; PG8_MMA(0, 0, At, B0); PG8_MMA(0, 1, At, B1); PG8_BAR; PG8_SCHED;
            PG8_LDA(At, 1, 1); PG8_STAGE(PG8_SB(1, 0), b3, voffB); PG8_STAGE(PG8_SB(1, 1), b3 + hstep, voffB); PG8_STAGE_A(PG8_SA(1, 0), a3, voffA);
            PG8_WAIT_V(8); PG8_WAIT_L(0); PG8_BAR; PG8_MMA(1, 0, At, B0); PG8_MMA(1, 1, At, B1); PG8_BAR; PG8_SCHED;
            } else {
            PG8_LDB(B0, 0, 0); PG8_SCHED; PG8_LDA(At, 0, 0); PG8_STAGE_A(PG8_SA(1, 1), a1 + hstep, voffA);
            PG8_WAIT_L(8); PG8_BAR; PG8_WAIT_L(0); PG8_MMA(0, 0, At, B0); PG8_BAR; PG8_SCHED;
            PG8_LDB(B1, 0, 1); PG8_STAGE(PG8_SB(0, 0), b2, voffB);
            PG8_BAR; PG8_WAIT_L(0); PG8_MMA(0, 1, At, B1); PG8_BAR;
            PG8_LDA(At, 0, 1); PG8_STAGE_A(PG8_SA(0, 0), a2, voffA);
            PG8_BAR; PG8_WAIT_L(0); PG8_MMA(1, 0, At, B0); PG8_BAR; PG8_SCHED;
            PG8_STAGE(PG8_SB(0, 1), b2 + hstep, voffB);
            PG8_WAIT_V(6); PG8_BAR; PG8_MMA(1, 1, At, B1); PG8_BAR;
            PG8_LDB(B0, 1, 0); PG8_SCHED; PG8_LDA(At, 1, 0); PG8_STAGE_A(PG8_SA(0, 1), a2 + hstep, voffA);
            PG8_WAIT_L(8); PG8_BAR; PG8_WAIT_L(0); PG8_MMA(0, 0, At, B0); PG8_BAR; PG8_SCHED;
            PG8_LDB(B1, 1, 1); PG8_STAGE(PG8_SB(1, 0), b3, voffB);
            PG8_BAR; PG8_WAIT_L(0); PG8_MMA(0, 1, At, B1); PG8_BAR;
            PG8_LDA(At, 1, 1); PG8_STAGE_A(PG8_SA(1, 0), a3, voffA);
            PG8_BAR; PG8_WAIT_L(0); PG8_MMA(1, 0, At, B0); PG8_BAR; PG8_SCHED;
            PG8_STAGE(PG8_SB(1, 1), b3 + hstep, voffB);
            PG8_WAIT_V(6); PG8_BAR; PG8_MMA(1, 1, At, B1); PG8_BAR;
            }
        }
        if constexpr (ALIGN_EPI) { if (wr == 0) PG8_BAR; }
        if constexpr (!Epi::AFTER_DRAIN) { E(acc, cur, wr, wc, fr, fq); S.done(cur); }
        if (!has_next) break;
#pragma unroll
        for (int a = 0; a < 2; ++a)
#pragma unroll
            for (int b = 0; b < 2; ++b)
#pragma unroll
                for (int m = 0; m < 4; ++m)
#pragma unroll
                    for (int n = 0; n < 2; ++n) acc[a][b][m][n] = (f32x4){0.f, 0.f, 0.f, 0.f};
        cur = nxt; cA = nA; cB = nB; ++ui;
        if constexpr (ALIGN_EPI) { if (wr == 1) PG8_BAR; }
    }
    PG8_WAIT_V(0);
    if constexpr (!ALIGN_EPI) { if (wr == 0) PG8_BAR; }
    PG8_BAR;
    if constexpr (Epi::AFTER_DRAIN) { E.fused(acc, cur, wr, wc, fr, fq, lds, wid, lane); S.done(cur); }
#undef PG8_SA
#undef PG8_SB
#undef PG8_STAGE
#undef PG8_STAGE_A
#undef PG8_LDA
#undef PG8_LDB
#undef PG8_MMA
#undef PG8_WAIT_V
#undef PG8_WAIT_L
#undef PG8_BAR
#undef PG8_SCHED
}
}

#define LAS __attribute__((address_space(3)))
typedef unsigned short bf16;
typedef short bf16x8 __attribute__((ext_vector_type(8)));
typedef float f32x4 __attribute__((ext_vector_type(4)));
typedef float f32x16 __attribute__((ext_vector_type(16)));
typedef unsigned u32x4 __attribute__((ext_vector_type(4)));
typedef unsigned u32x2 __attribute__((ext_vector_type(2)));
typedef short v4i16_t __attribute__((ext_vector_type(4)));

constexpr int NWAVES = 8;
constexpr int MTOK = 32768, DM = 1024, SEQ = 4096, NCH = 64, FF = 4096;
constexpr int DIN_SRC = 2832;
constexpr int LDP = 3072;
constexpr int GQ = 0, GK = 192, GV = 384, GG = 768, GZ = 1152, CU = 1344, AQ = 1856, AK = 2240, AV = 2624, PEND = 3008;
constexpr int MIX_GLA = 0, MIX_CONV = 384, MIX_ATT = 640;
constexpr float EPS = 1e-6f;
constexpr float LOG2E = 1.4426950408889634f;

constexpr size_t MiB = 1u << 20;
constexpr size_t WS_CTL = 0;
constexpr size_t WS_W = 1 * MiB, W_LAYER = 24 * MiB, W_IN = 0, W_OUT = 6 * MiB, W_UP = 8 * MiB, W_DN = 16 * MiB;
constexpr size_t WS_HB = 49 * MiB;
constexpr size_t WS_PROJ = 113 * MiB;
constexpr size_t WS_MIX = 305 * MiB;
constexpr size_t WS_FF = 113 * MiB;
constexpr size_t WS_SS = 369 * MiB;
constexpr size_t WS_KVT = 371 * MiB;
constexpr size_t WS_DEC = 407 * MiB;
constexpr size_t WS_ST = 408 * MiB;
constexpr size_t WS_SSA = 428 * MiB;
constexpr size_t WS_END = 430 * MiB;

constexpr int LDS_BYTES = 147456;

__device__ __forceinline__ unsigned cvtpk(float lo, float hi) { typedef float f2_t __attribute__((ext_vector_type(2))); typedef __bf16 b2_t __attribute__((ext_vector_type(2))); f2_t v = {lo, hi}; b2_t b = __builtin_convertvector(v, b2_t); return __builtin_bit_cast(unsigned, b); }
__device__ __forceinline__ float bflo(unsigned u) { return __uint_as_float(u << 16); }
__device__ __forceinline__ float bfhi(unsigned u) { return __uint_as_float(u & 0xffff0000u); }
__device__ __forceinline__ float bf2f(bf16 u) { return __uint_as_float((unsigned)u << 16); }
__device__ __forceinline__ float dpp_add(float v, int dummy) { return v; }
#define DPP_ADD(v, ctrl) ((v) + __builtin_bit_cast(float, __builtin_amdgcn_update_dpp(0, __builtin_bit_cast(int, (v)), (ctrl), 0xf, 0xf, true)))
__device__ __forceinline__ float wave_sum(float v) {
    v = DPP_ADD(v, 0xB1); v = DPP_ADD(v, 0x4E); v = DPP_ADD(v, 0x141); v = DPP_ADD(v, 0x140);
    const int iv = __builtin_bit_cast(int, v);
    const float r0 = __builtin_bit_cast(float, __builtin_amdgcn_readlane(iv, 0)), r1 = __builtin_bit_cast(float, __builtin_amdgcn_readlane(iv, 16));
    const float r2 = __builtin_bit_cast(float, __builtin_amdgcn_readlane(iv, 32)), r3 = __builtin_bit_cast(float, __builtin_amdgcn_readlane(iv, 48));
    return (r0 + r1) + (r2 + r3);
}
__device__ __forceinline__ float fast_sigmoid(float x) { return __builtin_amdgcn_rcpf(1.f + __expf(-x)); }
__device__ __forceinline__ int crow(int r, int hi) { return (r & 3) + 8 * (r >> 2) + 4 * hi; }
__device__ __forceinline__ v4i16_t trrd(LAS const unsigned char* p) { return __builtin_amdgcn_ds_read_tr16_b64_v4i16((LAS v4i16_t*)p); }
__device__ __forceinline__ bf16x8 cat8(v4i16_t a, v4i16_t b) { return (bf16x8){a[0], a[1], a[2], a[3], b[0], b[1], b[2], b[3]}; }
#define MFMA32(a, b, c) __builtin_amdgcn_mfma_f32_32x32x16_bf16((a), (b), (c), 0, 0, 0)
#define LDS_FENCE() asm volatile("s_waitcnt lgkmcnt(0)" ::: "memory")

struct Args { const float* in[16]; float* out; unsigned char* ws; };
typedef const Args __attribute__((address_space(4))) CArgs;
__device__ __forceinline__ void p0_store_tile(LAS float* scr, bf16* WT, int K, int dst_row0, int k0, const float* gain, int lane) {
    const int c = lane & 7;
    f32x4 g0 = (f32x4){1.f, 1.f, 1.f, 1.f}, g1 = g0;
    if (gain) { g0 = *(const f32x4*)(gain + k0 + 8 * c); g1 = *(const f32x4*)(gain + k0 + 8 * c + 4); }
    LDS_FENCE();
#pragma unroll
    for (int j = 0; j < 4; ++j) { const int n = (lane >> 3) + 8 * j; const LAS float* s = scr + (8 * c) * 33 + n;
        u32x4 o; o.x = cvtpk(s[0 * 33] * g0[0], s[1 * 33] * g0[1]); o.y = cvtpk(s[2 * 33] * g0[2], s[3 * 33] * g0[3]); o.z = cvtpk(s[4 * 33] * g1[0], s[5 * 33] * g1[1]); o.w = cvtpk(s[6 * 33] * g1[2], s[7 * 33] * g1[3]);
        *(u32x4*)(WT + (size_t)(dst_row0 + n) * K + k0 + 8 * c) = o; }
    LDS_FENCE();
}
__device__ __forceinline__ void p0_copy_item(const float* W, int ldw, int src0, LAS float* scr, int k0, int lane) {
    float wv[32];
#pragma unroll
    for (int i = 0; i < 32; ++i) { const float* wp = W + (size_t)(k0 + 2 * i + (lane >> 5)) * ldw + src0 + (lane & 31); wv[i] = STREAM_NT ? __builtin_nontemporal_load(wp) : *wp; }
    asm volatile("" : "+v"(wv[0]), "+v"(wv[1]), "+v"(wv[2]), "+v"(wv[3]), "+v"(wv[4]), "+v"(wv[5]), "+v"(wv[6]), "+v"(wv[7]), "+v"(wv[8]), "+v"(wv[9]), "+v"(wv[10]), "+v"(wv[11]), "+v"(wv[12]), "+v"(wv[13]), "+v"(wv[14]), "+v"(wv[15]),
                     "+v"(wv[16]), "+v"(wv[17]), "+v"(wv[18]), "+v"(wv[19]), "+v"(wv[20]), "+v"(wv[21]), "+v"(wv[22]), "+v"(wv[23]), "+v"(wv[24]), "+v"(wv[25]), "+v"(wv[26]), "+v"(wv[27]), "+v"(wv[28]), "+v"(wv[29]));
#pragma unroll
    for (int i = 0; i < 32; ++i) scr[(2 * i + (lane >> 5)) * 33 + (lane & 31)] = wv[i];
}
__device__ __forceinline__ void p0_weights(CArgs* ka, LAS float* scr, int lo, int hi, int gw, int ngw, int lane) {
    constexpr int I_IN = 16 * 96, I_OUT = 16 * 32, I_UP = 16 * 128, I_DN = 64 * 32, I_L = I_IN + I_OUT + I_UP + I_DN;
    unsigned char* ws = ka->ws;
    for (int it = lo + gw; it < hi; it += ngw) {
        const int l = it / I_L; int r = it - l * I_L;
        unsigned char* wl = ws + WS_W + (size_t)l * W_LAYER;
        if (r < I_IN) {
            const int kb = r / 96, nb = r % 96, k0 = 64 * kb, n0 = 32 * nb;
            const float* W = ka->in[2] + (size_t)l * DM * DIN_SRC; const float* gain = ka->in[1] + l * DM;
            if (n0 < GZ) p0_copy_item(W, DIN_SRC, n0, scr, k0, lane);
            else if (n0 < CU) {
                const float* wg = ka->in[3] + (size_t)l * 16 * 192; const int j = n0 - GZ + (lane & 31);
                float wgc[16];
#pragma unroll
                for (int q = 0; q < 16; ++q) wgc[q] = wg[q * 192 + j];
#pragma unroll 4
                for (int i = 0; i < 32; ++i) { const int kk = 2 * i + (lane >> 5); const f32x4* wr = (const f32x4*)(W + (size_t)(k0 + kk) * DIN_SRC + 1152); float s = 0.f;
#pragma unroll
                    for (int q = 0; q < 4; ++q) { const f32x4 wv = wr[q]; s += (wv[0] * wgc[4 * q] + wv[1] * wgc[4 * q + 1]) + (wv[2] * wgc[4 * q + 2] + wv[3] * wgc[4 * q + 3]); }
                    scr[kk * 33 + (lane & 31)] = s; }
            }
            else if (n0 < PEND) p0_copy_item(W, DIN_SRC, n0 - CU + 1168, scr, k0, lane);
            else {
#pragma unroll 8
                for (int i = 0; i < 32; ++i) scr[(2 * i + (lane >> 5)) * 33 + (lane & 31)] = 0.f;
            }
            p0_store_tile(scr, (bf16*)(wl + W_IN), DM, n0, k0, gain, lane);
            continue;
        }
        r -= I_IN;
        if (r < I_OUT) { const int kb = r / 32, nb = r % 32; p0_copy_item(ka->in[11] + (size_t)l * DM * DM, DM, 32 * nb, scr, 64 * kb, lane);
            p0_store_tile(scr, (bf16*)(wl + W_OUT), DM, 32 * nb, 64 * kb, kb < 6 ? ka->in[5] + l * 384 : nullptr, lane); continue; }
        r -= I_OUT;
        if (r < I_UP) { const int kb = r / 128, nb = r % 128; p0_copy_item(ka->in[13] + (size_t)l * DM * FF, FF, 32 * nb, scr, 64 * kb, lane); p0_store_tile(scr, (bf16*)(wl + W_UP), DM, 32 * nb, 64 * kb, ka->in[12] + l * DM, lane); continue; }
        r -= I_UP;
        { const int kb = r / 32, nb = r % 32; p0_copy_item(ka->in[14] + (size_t)l * FF * DM, DM, 32 * nb, scr, 64 * kb, lane); p0_store_tile(scr, (bf16*)(wl + W_DN), FF, 32 * nb, 64 * kb, nullptr, lane); }
    }
}
__device__ __forceinline__ void p0_rows(const float* x, bf16* hb, float* sspart, int gw, int ngw, int lane) {
    for (int m0 = gw; m0 < MTOK; m0 += 4 * ngw) {
        f32x4 v[4][4];
#pragma unroll
        for (int q = 0; q < 4; ++q) { int m = m0 + q * ngw; m = m < MTOK ? m : m0; const f32x4* xr = (const f32x4*)(x + (size_t)m * DM) + lane;
#pragma unroll
            for (int j = 0; j < 4; ++j) v[q][j] = STREAM_NT ? __builtin_nontemporal_load(xr + 64 * j) : xr[64 * j]; }
        asm volatile("" : "+v"(v[0][0]), "+v"(v[0][1]), "+v"(v[0][2]), "+v"(v[0][3]), "+v"(v[1][0]), "+v"(v[1][1]), "+v"(v[1][2]), "+v"(v[1][3]),
                         "+v"(v[2][0]), "+v"(v[2][1]), "+v"(v[2][2]), "+v"(v[2][3]), "+v"(v[3][0]), "+v"(v[3][1]), "+v"(v[3][2]), "+v"(v[3][3]));
#pragma unroll
        for (int q = 0; q < 4; ++q) { const int m = m0 + q * ngw; if (m < MTOK) {
            float s = 0.f;
#pragma unroll
            for (int j = 0; j < 4; ++j) s += (v[q][j][0] * v[q][j][0] + v[q][j][1] * v[q][j][1]) + (v[q][j][2] * v[q][j][2] + v[q][j][3] * v[q][j][3]);
            s = wave_sum(s);
            u32x2* o = (u32x2*)(hb + (size_t)m * DM) + lane;
#pragma unroll
            for (int j = 0; j < 4; ++j) { u32x2 w; w.x = cvtpk(v[q][j][0], v[q][j][1]); w.y = cvtpk(v[q][j][2], v[q][j][3]); o[64 * j] = w; }
            if (lane < 16) sspart[(size_t)m * 16 + lane] = s * (1.0f / 16.0f); } }
    }
}
__device__ __forceinline__ void final_rows(float* out, const bf16* hb, const float* sspart, const float* g, int gw, int ngw, int lane) {
    f32x4 gv[4];
#pragma unroll
    for (int j = 0; j < 4; ++j) gv[j] = ((const f32x4*)g)[lane + 64 * j];
    for (int m0 = gw; m0 < MTOK; m0 += 4 * ngw) {
        u32x2 v[4][4]; float ps[4];
#pragma unroll
        for (int q = 0; q < 4; ++q) { int m = m0 + q * ngw; m = m < MTOK ? m : m0; const u32x2* xr = (const u32x2*)(hb + (size_t)m * DM) + lane;
            ps[q] = lane < 16 ? sspart[(size_t)m * 16 + lane] : 0.f;
#pragma unroll
            for (int j = 0; j < 4; ++j) v[q][j] = STREAM_NT ? __builtin_nontemporal_load(xr + 64 * j) : xr[64 * j]; }
        asm volatile("" : "+v"(v[0][0]), "+v"(v[0][1]), "+v"(v[0][2]), "+v"(v[0][3]), "+v"(v[1][0]), "+v"(v[1][1]), "+v"(v[1][2]), "+v"(v[1][3]),
                         "+v"(v[2][0]), "+v"(v[2][1]), "+v"(v[2][2]), "+v"(v[2][3]), "+v"(v[3][0]), "+v"(v[3][1]), "+v"(v[3][2]), "+v"(v[3][3]), "+v"(ps[0]), "+v"(ps[1]), "+v"(ps[2]), "+v"(ps[3]));
#pragma unroll
        for (int q = 0; q < 4; ++q) { const int m = m0 + q * ngw; if (m < MTOK) {
            const float rs = __builtin_amdgcn_rsqf(wave_sum(ps[q]) * (1.0f / 1024.0f) + EPS);
            f32x4* xr = (f32x4*)(out + (size_t)m * DM) + lane;
#pragma unroll
            for (int j = 0; j < 4; ++j) { f32x4 o; o[0] = bflo(v[q][j].x); o[1] = bfhi(v[q][j].x); o[2] = bflo(v[q][j].y); o[3] = bfhi(v[q][j].y); { const f32x4 ov = o * rs * gv[j]; if (STREAM_NT) __builtin_nontemporal_store(ov, xr + 64 * j); else xr[64 * j] = ov; } } } }
    }
}

__device__ __forceinline__ void conv_item(const bf16* proj, const float* wdw, const float* bdw, const float* lng, const float* lnb, bf16* mixed, LAS unsigned char* lds, int bc, int tid, int wave, int lane) {
    asm volatile("" : "+v"(lane), "+v"(tid));
    const int c = bc & 63; const size_t tokb = (size_t)(bc >> 6) * SEQ; const int t0 = c * 64;
    LAS float* gl = (LAS float*)lds;
    const int c4 = lane * 4;
    f32x4 wr[31];
#pragma unroll
    for (int j = 0; j < 31; ++j) wr[j] = *(const f32x4*)(wdw + j * 256 + c4);
    const f32x4 bias = *(const f32x4*)(bdw + c4);
    const f32x4 g = *(const f32x4*)(lng + c4), be = *(const f32x4*)(lnb + c4);
    {
        u32x2 av[12], gv[12];
#pragma unroll
        for (int ii = 0; ii < 12; ++ii) { const int idx = tid + ii * 512, row = idx >> 6, c4 = (idx & 63) * 4; int t = t0 - 30 + row; t = t < 0 ? 0 : (row > 93 ? t0 : t);
            const bf16* p = proj + (tokb + t) * LDP + CU + c4; av[ii] = *(const u32x2*)p; gv[ii] = *(const u32x2*)(p + 256); }
        asm volatile("" : "+v"(av[0]), "+v"(av[1]), "+v"(av[2]), "+v"(av[3]), "+v"(av[4]), "+v"(av[5]), "+v"(av[6]), "+v"(av[7]), "+v"(av[8]), "+v"(av[9]), "+v"(av[10]), "+v"(av[11]),
                         "+v"(gv[0]), "+v"(gv[1]), "+v"(gv[2]), "+v"(gv[3]), "+v"(gv[4]), "+v"(gv[5]), "+v"(gv[6]), "+v"(gv[7]), "+v"(gv[8]), "+v"(gv[9]), "+v"(gv[10]), "+v"(gv[11]));
#pragma unroll
        for (int ii = 0; ii < 12; ++ii) { const int idx = tid + ii * 512, row = idx >> 6, c4 = (idx & 63) * 4, t = t0 - 30 + row;
            const u32x2 a = av[ii], g = gv[ii];
            const float a0 = bflo(a.x), a1 = bfhi(a.x), a2 = bflo(a.y), a3 = bfhi(a.y), g0 = bflo(g.x), g1 = bfhi(g.x), g2 = bflo(g.y), g3 = bfhi(g.y);
            f32x4 v; v[0] = a0 * fast_sigmoid(g0); v[1] = a1 * fast_sigmoid(g1); v[2] = a2 * fast_sigmoid(g2); v[3] = a3 * fast_sigmoid(g3);
            if (t < 0) v = (f32x4){0.f, 0.f, 0.f, 0.f};
            if (row < 94) *(LAS f32x4*)(gl + row * 256 + c4) = v; }
    }
    __syncthreads();
#pragma nounroll
    for (int tq = 0; tq < 2; ++tq) {
        f32x4 acc[4];
#pragma unroll
        for (int to = 0; to < 4; ++to) acc[to] = bias;
        const LAS float* gp = gl + (8 * wave + 4 * tq) * 256 + c4;
#pragma unroll
        for (int g0 = 0; g0 < 36; g0 += 12) {
            f32x4 x[12];
#pragma unroll
            for (int q = 0; q < 12; ++q) { const int rin = g0 + q < 34 ? g0 + q : 33; x[q] = *(const LAS f32x4*)(gp + rin * 256); }
            asm volatile("" : "+v"(x[0]), "+v"(x[1]), "+v"(x[2]), "+v"(x[3]), "+v"(x[4]), "+v"(x[5]), "+v"(x[6]), "+v"(x[7]), "+v"(x[8]), "+v"(x[9]), "+v"(x[10]), "+v"(x[11]));
#pragma unroll
            for (int q = 0; q < 12; ++q) { const int rin = g0 + q;
#pragma unroll
                for (int to = 0; to < 4; ++to) { const int j = rin - to; if (rin < 34 && j >= 0 && j <= 30) acc[to] += wr[j] * x[q]; } }
        }
#pragma unroll
        for (int to = 0; to < 4; ++to) {
            const f32x4 a = acc[to]; const float mean = wave_sum((a[0] + a[1]) + (a[2] + a[3])) * (1.0f / 256.0f);
            const f32x4 d = a - mean; const float var = wave_sum((d[0] * d[0] + d[1] * d[1]) + (d[2] * d[2] + d[3] * d[3])) * (1.0f / 256.0f);
            const float rs = __builtin_amdgcn_rsqf(var + EPS);
            f32x4 y = d * rs * g + be;
#pragma unroll
            for (int e = 0; e < 4; ++e) y[e] = y[e] * fast_sigmoid(y[e]);
            u32x2 w; w.x = cvtpk(y[0], y[1]); w.y = cvtpk(y[2], y[3]);
            *(u32x2*)(mixed + (tokb + t0 + 8 * wave + 4 * tq + to) * DM + MIX_CONV + c4) = w;
        }
    }
    __syncthreads();
}

#define GLDS16(gp, lp) __builtin_amdgcn_global_load_lds((const unsigned*)(gp), (LAS unsigned*)(lp), 16, 0, 0)
__device__ __forceinline__ void glds16_asm(const void* gsrc, unsigned lds_dst) { unsigned keep;
    asm volatile("s_mov_b32 %0, m0\n\ts_mov_b32 m0, %2\n\ts_nop 0\n\tglobal_load_lds_dwordx4 %1, off\n\ts_mov_b32 m0, %0" : "=&s"(keep) : "v"(gsrc), "s"(lds_dst) : "memory"); }
__device__ __forceinline__ void attn_unit(const bf16* proj, bf16* mixed, const LAS float* biasT, LAS unsigned char* vimg, int u, int lane) {
    asm volatile("" : "+v"(lane));
    const int half = u & 1; int t = u >> 1; const int h = t % 6; t /= 6; const int c = t & 63;
    const int r32 = lane & 31, hi = lane >> 5;
    const size_t tok0 = (size_t)t * 64;
    const int iq = 32 * half + r32;
    const bf16* qp = proj + (tok0 + iq) * LDP + AQ + h * 64 + 8 * hi;
    bf16x8 qf[4];
#pragma unroll
    for (int ks = 0; ks < 4; ++ks) qf[ks] = *(const bf16x8*)(qp + 16 * ks);
    float mrun = -1e30f, lrun = 0.f; f32x16 o0, o1;
#pragma unroll
    for (int r = 0; r < 16; ++r) { o0[r] = 0.f; o1[r] = 0.f; }
    const LAS float* bh = biasT + h * 260;
    const unsigned trb = ((lane >> 4) & 1) * 32 + (lane & 3) * 8 + (4 * hi + ((lane & 15) >> 2)) * 64;
    const float C2 = 0.125f * LOG2E;
    const int w0 = (c < 8 ? 8 - c : 0);
    const unsigned koff = (unsigned)r32 * LDP + 8u * hi;
    const unsigned vdoff = (unsigned)(8 * (lane >> 5) + ((lane & 31) >> 2)) * LDP + 8u * (lane & 3);
    bf16x8 kf[2][4];
    { const bf16* kt = proj + (tok0 - (size_t)(8 - w0) * 64) * LDP + AK + h * 64; const bf16* vt = kt + (AV - AK);
#pragma unroll
      for (int kb = 0; kb < 2; ++kb)
#pragma unroll
          for (int ks = 0; ks < 4; ++ks) kf[kb][ks] = *(const bf16x8*)(kt + (koff + (unsigned)(kb * 32 * LDP + 16 * ks)));
#pragma unroll
      for (int p = 0; p < 8; ++p) GLDS16(vt + (vdoff + (unsigned)((16 * (p & 3)) * LDP + 32 * (p >> 2))), vimg + p * 1024);
      asm volatile("" ::: "memory"); }
    int buf = 0;
    for (int w = w0; w <= 8; ++w) {
        bf16x8 kn[2][4];
        { const int wn = w < 8 ? w + 1 : 8;
          const bf16* kt = proj + (tok0 - (size_t)(8 - wn) * 64) * LDP + AK + h * 64; const bf16* vt = kt + (AV - AK);
          LAS unsigned char* vb = vimg + (buf ^ 1) * 8192;
          LDS_FENCE();
#pragma unroll
          for (int kb = 0; kb < 2; ++kb)
#pragma unroll
              for (int ks = 0; ks < 4; ++ks) kn[kb][ks] = *(const bf16x8*)(kt + (koff + (unsigned)(kb * 32 * LDP + 16 * ks)));
#pragma unroll
          for (int p = 0; p < 8; ++p) GLDS16(vt + (vdoff + (unsigned)((16 * (p & 3)) * LDP + 32 * (p >> 2))), vb + p * 1024);
          asm volatile("" ::: "memory"); }
        f32x16 s0, s1;
#pragma unroll
        for (int r = 0; r < 16; ++r) { s0[r] = 0.f; s1[r] = 0.f; }
#pragma unroll
        for (int ks = 0; ks < 4; ++ks) { s0 = MFMA32(kf[0][ks], qf[ks], s0); s1 = MFMA32(kf[1][ks], qf[ks], s1); }
        const int relb = (8 - w) * 64 + iq;
        float tm = -1e30f;
        if (w <= 5) {
            const float bc = bh[256];
#pragma unroll
            for (int r = 0; r < 16; ++r) { s0[r] = s0[r] * C2 + bc; s1[r] = s1[r] * C2 + bc; tm = fmaxf(tm, fmaxf(s0[r], s1[r])); }
        } else {
            float bv0[16], bv1[16];
#pragma unroll
            for (int r = 0; r < 16; ++r) { const int j0 = crow(r, hi); int i0 = relb - j0, i1 = relb - j0 - 32; i0 = (i0 > 128 ? 128 : i0) + 128; i1 = (i1 > 128 ? 128 : i1) + 128;
                bv0[r] = bh[i0]; bv1[r] = bh[i1]; }
            LDS_FENCE();
#pragma unroll
            for (int r = 0; r < 16; ++r) { s0[r] = s0[r] * C2 + bv0[r]; s1[r] = s1[r] * C2 + bv1[r]; tm = fmaxf(tm, fmaxf(s0[r], s1[r])); }
        }
        tm = fmaxf(tm, __shfl_xor(tm, 32));
        const float mn = fmaxf(mrun, tm); const float sc = __builtin_amdgcn_exp2f(mrun - mn); mrun = mn;
        float ps = 0.f;
#pragma unroll
        for (int r = 0; r < 16; ++r) { s0[r] = __builtin_amdgcn_exp2f(s0[r] - mn); s1[r] = __builtin_amdgcn_exp2f(s1[r] - mn); ps += s0[r] + s1[r]; o0[r] *= sc; o1[r] *= sc; }
        lrun = lrun * sc + ps;
        bf16x8 pf[2][2];
#pragma unroll
        for (int s2 = 0; s2 < 2; ++s2) {
            u32x4 a, b;
            a.x = cvtpk(s0[8 * s2 + 0], s0[8 * s2 + 1]); a.y = cvtpk(s0[8 * s2 + 2], s0[8 * s2 + 3]); a.z = cvtpk(s0[8 * s2 + 4], s0[8 * s2 + 5]); a.w = cvtpk(s0[8 * s2 + 6], s0[8 * s2 + 7]);
            b.x = cvtpk(s1[8 * s2 + 0], s1[8 * s2 + 1]); b.y = cvtpk(s1[8 * s2 + 2], s1[8 * s2 + 3]); b.z = cvtpk(s1[8 * s2 + 4], s1[8 * s2 + 5]); b.w = cvtpk(s1[8 * s2 + 6], s1[8 * s2 + 7]);
            pf[0][s2] = __builtin_bit_cast(bf16x8, a); pf[1][s2] = __builtin_bit_cast(bf16x8, b);
        }
        asm volatile("s_waitcnt vmcnt(16)" ::: "memory");
        const LAS unsigned char* vc = vimg + buf * 8192;
#pragma unroll
        for (int kb = 0; kb < 2; ++kb)
#pragma unroll
            for (int s2 = 0; s2 < 2; ++s2) {
                const unsigned off = (4 * kb + 2 * s2) * 512 + trb;
                const bf16x8 v0 = cat8(trrd(vc + off), trrd(vc + off + 512));
                const bf16x8 v1 = cat8(trrd(vc + 4096 + off), trrd(vc + 4096 + off + 512));
                o0 = MFMA32(v0, pf[kb][s2], o0); o1 = MFMA32(v1, pf[kb][s2], o1);
            }
#pragma unroll
        for (int kb = 0; kb < 2; ++kb)
#pragma unroll
            for (int ks = 0; ks < 4; ++ks) kf[kb][ks] = kn[kb][ks];
        buf ^= 1;
    }
    lrun += __shfl_xor(lrun, 32);
    const float inv = 1.0f / lrun;
    bf16* op = mixed + (tok0 + iq) * DM + MIX_ATT + h * 64 + 4 * hi;
#pragma unroll
    for (int rg = 0; rg < 4; ++rg) {
        u32x2 w0v, w1v;
        w0v.x = cvtpk(o0[4 * rg] * inv, o0[4 * rg + 1] * inv); w0v.y = cvtpk(o0[4 * rg + 2] * inv, o0[4 * rg + 3] * inv);
        w1v.x = cvtpk(o1[4 * rg] * inv, o1[4 * rg + 1] * inv); w1v.y = cvtpk(o1[4 * rg + 2] * inv, o1[4 * rg + 3] * inv);
        *(u32x2*)(op + 8 * rg) = w0v; *(u32x2*)(op + 32 + 8 * rg) = w1v;
    }
    asm volatile("s_waitcnt vmcnt(0) lgkmcnt(0)" ::: "memory");
}

__device__ __forceinline__ void attn_block_unit(const bf16* proj, bf16* mixed, const LAS float* biasT, LAS unsigned char* ring, int u, int wave, int lane) {
    asm volatile("" : "+v"(lane));
    const int h = u % 6; const int bg = u / 6; const int g = bg & 15, b = bg >> 4;
    const int qc = wave >> 1, half = wave & 1;
    const int r32 = lane & 31, hi = lane >> 5;
    const size_t tokg = (size_t)b * SEQ + (size_t)g * 256;
    const int tlo = (g < 2) ? 8 - 4 * g : 0;
    const int ntile = 12 - tlo;
    const unsigned kdo = (unsigned)(32 * (wave >> 2) + r32) * LDP + 16u * (wave & 3) + 8u * hi;
    const unsigned vdo = (unsigned)(16 * (wave & 3) + 8 * hi + (r32 >> 2)) * LDP + 32u * (wave >> 2) + 8u * (lane & 3) + (unsigned)(AV - AK);
#define ATT_ISSUE(t_, st_) do { const bf16* kt_ = proj + (tokg + (size_t)(t_) * 64 - 512) * LDP + AK + h * 64; \
        glds16_asm(kt_ + kdo, (unsigned)__builtin_amdgcn_readfirstlane((int)(ring0 + (unsigned)((st_) * 16384 + wave * 1024)))); \
        glds16_asm(kt_ + vdo, (unsigned)__builtin_amdgcn_readfirstlane((int)(ring0 + (unsigned)((st_) * 16384 + 8192 + wave * 1024)))); } while (0)
    const unsigned ring0 = (unsigned)(uintptr_t)ring;
    const int iq = 32 * half + r32;
    const bf16* qp = proj + (tokg + qc * 64 + iq) * LDP + AQ + h * 64 + 8 * hi;
    bf16x8 qf[4];
#pragma unroll
    for (int ks = 0; ks < 4; ++ks) qf[ks] = *(const bf16x8*)(qp + 16 * ks);
    asm volatile("" ::: "memory");
    { const float C2q = 0.125f * LOG2E;
#pragma unroll
      for (int ks = 0; ks < 4; ++ks) { u32x4 q4 = __builtin_bit_cast(u32x4, qf[ks]);
#pragma unroll
          for (int e = 0; e < 4; ++e) q4[e] = cvtpk(bflo(q4[e]) * C2q, bfhi(q4[e]) * C2q);
          qf[ks] = __builtin_bit_cast(bf16x8, q4); } }
    ATT_ISSUE(tlo, 0); ATT_ISSUE(tlo + 1, 1); ATT_ISSUE(tlo + 2, 2);
    asm volatile("" ::: "memory");
    float mrun = -1e30f, lrun = 0.f; f32x16 o0, o1;
#pragma unroll
    for (int r = 0; r < 16; ++r) { o0[r] = 0.f; o1[r] = 0.f; }
    const LAS float* bh = biasT + h * 260;
    const unsigned trb = ((lane >> 4) & 1) * 32 + (lane & 3) * 8 + (4 * hi + ((lane & 15) >> 2)) * 64;
    for (int j = 0; j < ntile; ++j) {
        const int left = ntile - 1 - j;
        if (left >= 2) asm volatile("s_waitcnt vmcnt(4) lgkmcnt(0)\n\ts_barrier" ::: "memory");
        else if (left == 1) asm volatile("s_waitcnt vmcnt(2) lgkmcnt(0)\n\ts_barrier" ::: "memory");
        else asm volatile("s_waitcnt vmcnt(0) lgkmcnt(0)\n\ts_barrier" ::: "memory");
        if (j + 3 < ntile) { ATT_ISSUE(tlo + j + 3, (j + 3) & 3); }
        asm volatile("" ::: "memory");
        const int w = tlo + j - qc;
        if (w >= 0 && w <= 8) {
            const LAS unsigned char* kc = ring + (j & 3) * 16384; const LAS unsigned char* vc = kc + 8192;
            bf16x8 kf[2][4];
#pragma unroll
            for (int kb = 0; kb < 2; ++kb)
#pragma unroll
                for (int ks = 0; ks < 4; ++ks) kf[kb][ks] = *(const LAS bf16x8*)(kc + (kb * 4 + ks) * 1024 + 16 * lane);
            f32x16 s0, s1;
#pragma unroll
            for (int r = 0; r < 16; ++r) { s0[r] = 0.f; s1[r] = 0.f; }
#pragma unroll
            for (int ks = 0; ks < 4; ++ks) { s0 = MFMA32(kf[0][ks], qf[ks], s0); s1 = MFMA32(kf[1][ks], qf[ks], s1); }
            const int relb = (8 - w) * 64 + iq;
            float tm = -1e30f, boff = 0.f;
            if (w <= 5) {
                boff = bh[256];
#pragma unroll
                for (int r = 0; r < 16; ++r) tm = fmaxf(tm, fmaxf(s0[r], s1[r]));
                tm += boff;
            } else {
                float bv0[16], bv1[16];
#pragma unroll
                for (int r = 0; r < 16; ++r) { const int j0 = crow(r, hi); int i0 = relb - j0, i1 = relb - j0 - 32; i0 = (i0 > 128 ? 128 : i0) + 128; i1 = (i1 > 128 ? 128 : i1) + 128;
                    bv0[r] = bh[i0]; bv1[r] = bh[i1]; }
#pragma unroll
                for (int r = 0; r < 16; ++r) { s0[r] += bv0[r]; s1[r] += bv1[r]; tm = fmaxf(tm, fmaxf(s0[r], s1[r])); }
            }
            tm = fmaxf(tm, __shfl_xor(tm, 32));
            if (__any(tm > mrun + 8.0f)) {
                const float mn = fmaxf(mrun, tm); const float sc = __builtin_amdgcn_exp2f(mrun - mn); mrun = mn; lrun *= sc;
#pragma unroll
                for (int r = 0; r < 16; ++r) { o0[r] *= sc; o1[r] *= sc; }
            }
            const float sub = mrun - boff;
            float ps = 0.f;
#pragma unroll
            for (int r = 0; r < 16; ++r) { s0[r] = __builtin_amdgcn_exp2f(s0[r] - sub); s1[r] = __builtin_amdgcn_exp2f(s1[r] - sub); ps += s0[r] + s1[r]; }
            lrun += ps;
            bf16x8 pf[2][2];
#pragma unroll
            for (int s2 = 0; s2 < 2; ++s2) {
                u32x4 a, bb;
                a.x = cvtpk(s0[8 * s2 + 0], s0[8 * s2 + 1]); a.y = cvtpk(s0[8 * s2 + 2], s0[8 * s2 + 3]); a.z = cvtpk(s0[8 * s2 + 4], s0[8 * s2 + 5]); a.w = cvtpk(s0[8 * s2 + 6], s0[8 * s2 + 7]);
                bb.x = cvtpk(s1[8 * s2 + 0], s1[8 * s2 + 1]); bb.y = cvtpk(s1[8 * s2 + 2], s1[8 * s2 + 3]); bb.z = cvtpk(s1[8 * s2 + 4], s1[8 * s2 + 5]); bb.w = cvtpk(s1[8 * s2 + 6], s1[8 * s2 + 7]);
                pf[0][s2] = __builtin_bit_cast(bf16x8, a); pf[1][s2] = __builtin_bit_cast(bf16x8, bb);
            }
#pragma unroll
            for (int kb = 0; kb < 2; ++kb)
#pragma unroll
                for (int s2 = 0; s2 < 2; ++s2) {
                    const unsigned off = (4 * kb + 2 * s2) * 512 + trb;
                    const bf16x8 v0 = cat8(trrd(vc + off), trrd(vc + off + 512));
                    const bf16x8 v1 = cat8(trrd(vc + 4096 + off), trrd(vc + 4096 + off + 512));
                    o0 = MFMA32(v0, pf[kb][s2], o0); o1 = MFMA32(v1, pf[kb][s2], o1);
                }
        }
    }
#undef ATT_ISSUE
    lrun += __shfl_xor(lrun, 32);
    const float inv = 1.0f / lrun;
    bf16* op = mixed + (tokg + qc * 64 + iq) * DM + MIX_ATT + h * 64 + 4 * hi;
#pragma unroll
    for (int rg = 0; rg < 4; ++rg) {
        u32x2 w0v, w1v;
        w0v.x = cvtpk(o0[4 * rg] * inv, o0[4 * rg + 1] * inv); w0v.y = cvtpk(o0[4 * rg + 2] * inv, o0[4 * rg + 3] * inv);
        w1v.x = cvtpk(o1[4 * rg] * inv, o1[4 * rg + 1] * inv); w1v.y = cvtpk(o1[4 * rg + 2] * inv, o1[4 * rg + 3] * inv);
        *(u32x2*)(op + 8 * rg) = w0v; *(u32x2*)(op + 32 + 8 * rg) = w1v;
    }
    asm volatile("s_waitcnt lgkmcnt(0)\n\ts_barrier" ::: "memory");
}

__device__ __forceinline__ void attn_pair_unit(const bf16* proj, bf16* mixed, const LAS float* biasT, LAS unsigned char* ring, int u, int wave, int lane) {
    asm volatile("" : "+v"(lane));
    const int hp = u % 3; const int bg = u / 3; const int g2 = bg & 31, b = bg >> 5;
    const int sub = wave >> 2, w4 = wave & 3; const int h = 2 * hp + sub;
    const int qc = w4 >> 1, half = w4 & 1;
    const int r32 = lane & 31, hi = lane >> 5;
    const size_t tokg = (size_t)b * SEQ + (size_t)g2 * 128;
    const int tlo = (g2 < 4) ? 8 - 2 * g2 : 0;
    const int ntile = 10 - tlo;
    LAS unsigned char* ringS = ring + sub * 65536;
    unsigned kdo[2], vdo[2];
#pragma unroll
    for (int q = 0; q < 2; ++q) { const int p = 2 * w4 + q;
        kdo[q] = (unsigned)(32 * (p >> 2) + r32) * LDP + 16u * (p & 3) + 8u * hi;
        vdo[q] = (unsigned)(16 * (p & 3) + 8 * hi + (r32 >> 2)) * LDP + 32u * (p >> 2) + 8u * (lane & 3) + (unsigned)(AV - AK); }
#define ATT_ISSUE(t_, st_) do { const bf16* kt_ = proj + (tokg + (size_t)(t_) * 64 - 512) * LDP + AK + h * 64; \
        _Pragma("unroll") for (int q_ = 0; q_ < 2; ++q_) { \
        glds16_asm(kt_ + kdo[q_], (unsigned)__builtin_amdgcn_readfirstlane((int)(ring0 + (unsigned)((st_) * 16384 + (2 * w4 + q_) * 1024)))); \
        glds16_asm(kt_ + vdo[q_], (unsigned)__builtin_amdgcn_readfirstlane((int)(ring0 + (unsigned)((st_) * 16384 + 8192 + (2 * w4 + q_) * 1024)))); } } while (0)
    const unsigned ring0 = (unsigned)(uintptr_t)ringS;
    const int iq = 32 * half + r32;
    const bf16* qp = proj + (tokg + qc * 64 + iq) * LDP + AQ + h * 64 + 8 * hi;
    bf16x8 qf[4];
#pragma unroll
    for (int ks = 0; ks < 4; ++ks) qf[ks] = *(const bf16x8*)(qp + 16 * ks);
    asm volatile("" ::: "memory");
    { const float C2q = 0.125f * LOG2E;
#pragma unroll
      for (int ks = 0; ks < 4; ++ks) { u32x4 q4 = __builtin_bit_cast(u32x4, qf[ks]);
#pragma unroll
          for (int e = 0; e < 4; ++e) q4[e] = cvtpk(bflo(q4[e]) * C2q, bfhi(q4[e]) * C2q);
          qf[ks] = __builtin_bit_cast(bf16x8, q4); } }
    ATT_ISSUE(tlo, 0); ATT_ISSUE(tlo + 1, 1); if (ntile > 2) { ATT_ISSUE(tlo + 2, 2); }
    asm volatile("" ::: "memory");
    float mrun = -1e30f, lrun = 0.f; f32x16 o0, o1;
#pragma unroll
    for (int r = 0; r < 16; ++r) { o0[r] = 0.f; o1[r] = 0.f; }
    const LAS float* bh = biasT + h * 260;
    const unsigned trb = ((lane >> 4) & 1) * 32 + (lane & 3) * 8 + (4 * hi + ((lane & 15) >> 2)) * 64;
    for (int j = 0; j < ntile; ++j) {
        const int left = ntile - 1 - j;
        if (left >= 2) asm volatile("s_waitcnt vmcnt(8) lgkmcnt(0)\n\ts_barrier" ::: "memory");
        else if (left == 1) asm volatile("s_waitcnt vmcnt(4) lgkmcnt(0)\n\ts_barrier" ::: "memory");
        else asm volatile("s_waitcnt vmcnt(0) lgkmcnt(0)\n\ts_barrier" ::: "memory");
        if (j + 3 < ntile) { ATT_ISSUE(tlo + j + 3, (j + 3) & 3); }
        asm volatile("" ::: "memory");
        const int w = tlo + j - qc;
        if (w >= 0 && w <= 8) {
#if ATT_IGLP >= 0
            __builtin_amdgcn_iglp_opt(ATT_IGLP);
#endif
            const LAS unsigned char* kc = ringS + (j & 3) * 16384; const LAS unsigned char* vc = kc + 8192;
            bf16x8 kf[2][4];
#pragma unroll
            for (int kb = 0; kb < 2; ++kb)
#pragma unroll
                for (int ks = 0; ks < 4; ++ks) kf[kb][ks] = *(const LAS bf16x8*)(kc + (kb * 4 + ks) * 1024 + 16 * lane);
            f32x16 s0, s1;
#pragma unroll
            for (int r = 0; r < 16; ++r) { s0[r] = 0.f; s1[r] = 0.f; }
            __builtin_amdgcn_s_setprio(1);
#pragma unroll
            for (int ks = 0; ks < 4; ++ks) { s0 = MFMA32(kf[0][ks], qf[ks], s0); s1 = MFMA32(kf[1][ks], qf[ks], s1); }
            __builtin_amdgcn_s_setprio(0);
            bf16x8 vf[2][2][2];
#pragma unroll
            for (int kb = 0; kb < 2; ++kb)
#pragma unroll
                for (int s2 = 0; s2 < 2; ++s2) { const unsigned off = (4 * kb + 2 * s2) * 512 + trb;
                    vf[kb][s2][0] = cat8(trrd(vc + off), trrd(vc + off + 512)); vf[kb][s2][1] = cat8(trrd(vc + 4096 + off), trrd(vc + 4096 + off + 512)); }
            asm volatile("" ::: "memory");
            const int relb = (8 - w) * 64 + iq;
            float tm = -1e30f, boff = 0.f;
            if (w <= 5) {
                boff = bh[256];
#pragma unroll
                for (int r = 0; r < 16; ++r) tm = fmaxf(tm, fmaxf(s0[r], s1[r]));
                tm += boff;
            } else {
                float bv0[16], bv1[16];
#pragma unroll
                for (int r = 0; r < 16; ++r) { const int j0 = crow(r, hi); int i0 = relb - j0, i1 = relb - j0 - 32; i0 = (i0 > 128 ? 128 : i0) + 128; i1 = (i1 > 128 ? 128 : i1) + 128;
                    bv0[r] = bh[i0]; bv1[r] = bh[i1]; }
#pragma unroll
                for (int r = 0; r < 16; ++r) { s0[r] += bv0[r]; s1[r] += bv1[r]; tm = fmaxf(tm, fmaxf(s0[r], s1[r])); }
            }
            { auto rr = __builtin_amdgcn_permlane32_swap(__float_as_uint(tm), __float_as_uint(tm), false, false); tm = fmaxf(__uint_as_float(rr[0]), __uint_as_float(rr[1])); }
            if (__any(tm > mrun + 8.0f)) {
                const float mn = fmaxf(mrun, tm); const float sc = __builtin_amdgcn_exp2f(mrun - mn); mrun = mn; lrun *= sc;
#pragma unroll
                for (int r = 0; r < 16; ++r) { o0[r] *= sc; o1[r] *= sc; }
            }
            const float sub = mrun - boff;
            float ps = 0.f;
#pragma unroll
            for (int r = 0; r < 16; ++r) { s0[r] = __builtin_amdgcn_exp2f(s0[r] - sub); s1[r] = __builtin_amdgcn_exp2f(s1[r] - sub); ps += s0[r] + s1[r]; }
            lrun += ps;
            bf16x8 pf[2][2];
#pragma unroll
            for (int s2 = 0; s2 < 2; ++s2) {
                u32x4 a, bb;
                a.x = cvtpk(s0[8 * s2 + 0], s0[8 * s2 + 1]); a.y = cvtpk(s0[8 * s2 + 2], s0[8 * s2 + 3]); a.z = cvtpk(s0[8 * s2 + 4], s0[8 * s2 + 5]); a.w = cvtpk(s0[8 * s2 + 6], s0[8 * s2 + 7]);
                bb.x = cvtpk(s1[8 * s2 + 0], s1[8 * s2 + 1]); bb.y = cvtpk(s1[8 * s2 + 2], s1[8 * s2 + 3]); bb.z = cvtpk(s1[8 * s2 + 4], s1[8 * s2 + 5]); bb.w = cvtpk(s1[8 * s2 + 6], s1[8 * s2 + 7]);
                pf[0][s2] = __builtin_bit_cast(bf16x8, a); pf[1][s2] = __builtin_bit_cast(bf16x8, bb);
            }
#pragma unroll
            for (int kb = 0; kb < 2; ++kb)
#pragma unroll
                for (int s2 = 0; s2 < 2; ++s2) {
                    o0 = MFMA32(vf[kb][s2][0], pf[kb][s2], o0); o1 = MFMA32(vf[kb][s2][1], pf[kb][s2], o1);
                }
        }
    }
#undef ATT_ISSUE
    lrun += __shfl_xor(lrun, 32);
    const float inv = 1.0f / lrun;
    bf16* op = mixed + (tokg + qc * 64 + iq) * DM + MIX_ATT + h * 64 + 4 * hi;
#pragma unroll
    for (int rg = 0; rg < 4; ++rg) {
        u32x2 w0v, w1v;
        w0v.x = cvtpk(o0[4 * rg] * inv, o0[4 * rg + 1] * inv); w0v.y = cvtpk(o0[4 * rg + 2] * inv, o0[4 * rg + 3] * inv);
        w1v.x = cvtpk(o1[4 * rg] * inv, o1[4 * rg + 1] * inv); w1v.y = cvtpk(o1[4 * rg + 2] * inv, o1[4 * rg + 3] * inv);
        *(u32x2*)(op + 8 * rg) = w0v; *(u32x2*)(op + 32 + 8 * rg) = w1v;
    }
    asm volatile("s_waitcnt lgkmcnt(0)\n\ts_barrier" ::: "memory");
}

__device__ __forceinline__ void gla_kv_item(const bf16* proj, const float* bgate, float* kvT, float* decay, LAS unsigned char* vimg, int it, int lane) {
    asm volatile("" : "+v"(lane));
    const int h = it & 3; const size_t tok0 = (size_t)(it >> 2) * 64;
    const int r32 = lane & 31, hi = lane >> 5;
    LDS_FENCE();
    {
        const int kc = lane < 48 ? lane : 47;
        const bf16* zp = proj + tok0 * LDP + GZ + h * 48 + kc; const bf16* kp = proj + tok0 * LDP + GK + h * 48 + kc;
        const float bz = bgate[h * 48 + kc];
        float suf = 0.f;
#pragma unroll
        for (int hb2 = 1; hb2 >= 0; --hb2) {
            bf16 zr[32], kr[32];
#pragma unroll
            for (int i = 0; i < 32; ++i) { zr[i] = zp[(size_t)(32 * hb2 + i) * LDP]; kr[i] = kp[(size_t)(32 * hb2 + i) * LDP]; }
            asm volatile("" ::: "memory");
#pragma unroll
            for (int i = 31; i >= 0; --i) { const int t = 32 * hb2 + i;
                const float z = bf2f(zr[i]) + bz, kk = bf2f(kr[i]);
                const float la = (fminf(z, 0.f) - __logf(1.f + __expf(-fabsf(z)))) * (1.0f / 16.0f);
                const float kd = kk * __expf(suf); suf += la;
                *(LAS bf16*)(vimg + lane * 144 + t * 2) = (bf16)(cvtpk(kd, 0.f) & 0xffffu); }
        }
        if (lane < 48) decay[(size_t)it * 48 + kc] = __expf(suf);
    }
    LDS_FENCE();
    bf16x8 kfr[2][4];
#pragma unroll
    for (int kb = 0; kb < 2; ++kb)
#pragma unroll
        for (int s = 0; s < 4; ++s) { const int kc = 32 * kb + r32; const int kcc = kc < 48 ? kc : 47;
            u32x4 a = *(const LAS u32x4*)(vimg + kcc * 144 + (16 * s + 8 * hi) * 2);
            if (kc >= 48) a = (u32x4){0u, 0u, 0u, 0u};
            kfr[kb][s] = __builtin_bit_cast(bf16x8, a); }
    LDS_FENCE();
    { u32x4 val[12];
#pragma unroll
      for (int i = 0; i < 12; ++i) { const int id = i * 64 + lane, t = id / 12, ch = id - 12 * t; val[i] = *(const u32x4*)(proj + (tok0 + t) * LDP + GV + h * 96 + 8 * ch); }
      asm volatile("" : "+v"(val[0]), "+v"(val[1]), "+v"(val[2]), "+v"(val[3]), "+v"(val[4]), "+v"(val[5]), "+v"(val[6]), "+v"(val[7]), "+v"(val[8]), "+v"(val[9]), "+v"(val[10]), "+v"(val[11]));
#pragma unroll
      for (int i = 0; i < 12; ++i) { const int id = i * 64 + lane, t = id / 12, ch = id - 12 * t; *(LAS u32x4*)(vimg + (ch >> 2) * 4096 + (t >> 3) * 512 + (t & 7) * 64 + (ch & 3) * 16) = val[i]; } }
    f32x16 acc[3][2];
#pragma unroll
    for (int vb = 0; vb < 3; ++vb)
#pragma unroll
        for (int kb = 0; kb < 2; ++kb)
#pragma unroll
            for (int r = 0; r < 16; ++r) acc[vb][kb][r] = 0.f;
    LDS_FENCE();
    const unsigned trb = ((lane >> 4) & 1) * 32 + (lane & 3) * 8 + ((lane & 15) >> 2) * 64 + hi * 512;
#pragma unroll
    for (int s = 0; s < 4; ++s)
#pragma unroll
        for (int vb = 0; vb < 3; ++vb) { const unsigned off = vb * 4096 + (2 * s) * 512 + trb;
            const bf16x8 vf = cat8(trrd(vimg + off), trrd(vimg + off + 256));
            acc[vb][0] = MFMA32(vf, kfr[0][s], acc[vb][0]); acc[vb][1] = MFMA32(vf, kfr[1][s], acc[vb][1]); }
    float* dst = kvT + (size_t)it * 4608;
#pragma unroll
    for (int vb = 0; vb < 3; ++vb)
#pragma unroll
        for (int r = 0; r < 16; ++r) { const int v = 32 * vb + crow(r, hi);
            dst[v * 48 + r32] = acc[vb][0][r];
            if (r32 < 16) dst[v * 48 + 32 + r32] = acc[vb][1][r]; }
    LDS_FENCE();
}
__device__ __forceinline__ void gla_scan(const float* kvT, const float* decay, bf16* St, int gtid, int nthr) {
    for (int e = gtid; e < 32 * 4608; e += nthr) {
        const int bh = e / 4608, rem = e - bh * 4608, k = rem % 48, b = bh >> 2, h = bh & 3;
        float st = 0.f;
#pragma nounroll
        for (int c0 = 0; c0 < 64; c0 += 16) {
            float kv[16], dc[16];
#pragma unroll
            for (int j = 0; j < 16; ++j) { const size_t it = (size_t)(((b * 64 + c0 + j) << 2) + h); kv[j] = STREAM_NT ? __builtin_nontemporal_load(kvT + it * 4608 + rem) : kvT[it * 4608 + rem]; dc[j] = decay[it * 48 + k]; }
            asm volatile("" : "+v"(kv[0]), "+v"(kv[1]), "+v"(kv[2]), "+v"(kv[3]), "+v"(kv[4]), "+v"(kv[5]), "+v"(kv[6]), "+v"(kv[7]), "+v"(kv[8]), "+v"(kv[9]), "+v"(kv[10]), "+v"(kv[11]), "+v"(kv[12]), "+v"(kv[13]), "+v"(kv[14]), "+v"(kv[15]),
                             "+v"(dc[0]), "+v"(dc[1]), "+v"(dc[2]), "+v"(dc[3]), "+v"(dc[4]), "+v"(dc[5]), "+v"(dc[6]), "+v"(dc[7]), "+v"(dc[8]), "+v"(dc[9]), "+v"(dc[10]), "+v"(dc[11]), "+v"(dc[12]), "+v"(dc[13]));
#pragma unroll
            for (int j = 0; j < 16; ++j) { const size_t it = (size_t)(((b * 64 + c0 + j) << 2) + h); st = dc[j] * st + kv[j]; St[it * 4608 + rem] = (bf16)(cvtpk(st, 0.f) & 0xffffu); }
        }
    }
}
__device__ __forceinline__ void gla_out_item(const bf16* proj, const bf16* St, bf16* mixed, int it, int lane) {
    asm volatile("" : "+v"(lane));
    const int h = it & 3; const size_t tok0 = (size_t)(it >> 2) * 64;
    const int r32 = lane & 31, hi = lane >> 5;
    bf16x8 af[3][3], bq[2][3]; u32x2 gg[2][3][4];
#pragma unroll
    for (int vb = 0; vb < 3; ++vb)
#pragma unroll
        for (int ks = 0; ks < 3; ++ks) af[vb][ks] = *(const bf16x8*)(St + (size_t)it * 4608 + (32 * vb + r32) * 48 + 16 * ks + 8 * hi);
#pragma unroll
    for (int tb = 0; tb < 2; ++tb)
#pragma unroll
        for (int ks = 0; ks < 3; ++ks) bq[tb][ks] = *(const bf16x8*)(proj + (tok0 + 32 * tb + r32) * LDP + GQ + h * 48 + 16 * ks + 8 * hi);
#pragma unroll
    for (int tb = 0; tb < 2; ++tb)
#pragma unroll
        for (int vb = 0; vb < 3; ++vb)
#pragma unroll
            for (int rg = 0; rg < 4; ++rg) gg[tb][vb][rg] = *(const u32x2*)(proj + (tok0 + 32 * tb + r32) * LDP + GG + h * 96 + 32 * vb + 8 * rg + 4 * hi);
    asm volatile("" : "+v"(af[0][0]), "+v"(af[0][1]), "+v"(af[0][2]), "+v"(af[1][0]), "+v"(af[1][1]), "+v"(af[1][2]), "+v"(af[2][0]), "+v"(af[2][1]), "+v"(af[2][2]),
                     "+v"(bq[0][0]), "+v"(bq[0][1]), "+v"(bq[0][2]), "+v"(bq[1][0]), "+v"(bq[1][1]), "+v"(bq[1][2]));
    f32x16 acc[3][2];
#pragma unroll
    for (int vb = 0; vb < 3; ++vb)
#pragma unroll
        for (int tb = 0; tb < 2; ++tb)
#pragma unroll
            for (int r = 0; r < 16; ++r) acc[vb][tb][r] = 0.f;
#pragma unroll
    for (int ks = 0; ks < 3; ++ks)
#pragma unroll
        for (int vb = 0; vb < 3; ++vb)
#pragma unroll
            for (int tb = 0; tb < 2; ++tb) acc[vb][tb] = MFMA32(af[vb][ks], bq[tb][ks], acc[vb][tb]);
    const float QS = 0.14433756729740643f;
#pragma unroll
    for (int tb = 0; tb < 2; ++tb) {
        float ss = 0.f;
#pragma unroll
        for (int vb = 0; vb < 3; ++vb)
#pragma unroll
            for (int r = 0; r < 16; ++r) { const float x = acc[vb][tb][r] * QS; acc[vb][tb][r] = x; ss += x * x; }
        ss += __shfl_xor(ss, 32);
        const float rn = __builtin_amdgcn_rsqf(ss * (1.0f / 96.0f) + EPS);
        const size_t tok = tok0 + 32 * tb + r32;
#pragma unroll
        for (int vb = 0; vb < 3; ++vb)
#pragma unroll
            for (int rg = 0; rg < 4; ++rg) { const int v0 = 32 * vb + 8 * rg + 4 * hi; const u32x2 g = gg[tb][vb][rg];
                const float g0 = bflo(g.x), g1 = bfhi(g.x), g2 = bflo(g.y), g3 = bfhi(g.y);
                const float y0 = acc[vb][tb][4 * rg + 0] * rn * (g0 * fast_sigmoid(g0));
                const float y1 = acc[vb][tb][4 * rg + 1] * rn * (g1 * fast_sigmoid(g1));
                const float y2 = acc[vb][tb][4 * rg + 2] * rn * (g2 * fast_sigmoid(g2));
                const float y3 = acc[vb][tb][4 * rg + 3] * rn * (g3 * fast_sigmoid(g3));
                u32x2 w; w.x = cvtpk(y0, y1); w.y = cvtpk(y2, y3);
                *(u32x2*)(mixed + tok * DM + MIX_GLA + h * 96 + v0) = w; }
    }
}
#define XB_TMO      128
#define XB_XCNT(j)  (256  + 64 * (j))
#define XB_XSUB(j)  (1280 + 64 * (j))
#define XB_XGEN(j)  (2304 + 64 * (j))
#define XB_TOP      3328
#define XB_TOPGEN   3392
#define XCD_BAR_WORDS 3456
#define XB_SPIN_CAP (1u << 18)

__device__ __forceinline__ unsigned xb_ld(unsigned* p)              { return __hip_atomic_load(p, __ATOMIC_RELAXED, __HIP_MEMORY_SCOPE_AGENT); }
__device__ __forceinline__ unsigned xb_add(unsigned* p, unsigned v) { return __hip_atomic_fetch_add(p, v, __ATOMIC_RELAXED, __HIP_MEMORY_SCOPE_AGENT); }
__device__ __forceinline__ unsigned xb_xcc_id() { return (unsigned)__builtin_amdgcn_s_getreg((3 << 11) | 20) & 0xFu; }
#define XB_SPIN(cond, bar) do { unsigned _sp = 0; while (cond) { __builtin_amdgcn_s_sleep(1); \
    if ((++_sp & 255u) == 0u) { if (xb_ld(&(bar)[XB_TMO])) break; if (_sp > XB_SPIN_CAP) { atomicAdd(&(bar)[XB_TMO], 1u); break; } } } } while (0)

struct XcdBarrier {
    unsigned* bar; unsigned x;
    volatile LAS unsigned* st;
};

__device__ __forceinline__ XcdBarrier xcd_barrier_post(unsigned* bar, volatile LAS unsigned* st) {
    XcdBarrier b; b.bar = bar; b.x = xb_xcc_id(); b.st = st;
    if (threadIdx.x == 0) (void)xb_add(&bar[XB_XCNT(b.x)], 1u);
    return b;
}
__device__ __forceinline__ void xcd_barrier_complete(unsigned* bar, unsigned x, unsigned& nloc, unsigned& nx) {
    const unsigned G = gridDim.x * gridDim.y * gridDim.z;
    unsigned sum, cnt, mine, sp = 0u;
    for (;;) {
        sum = 0u; cnt = 0u; mine = 0u;
#pragma unroll
        for (unsigned j = 0; j < 16; ++j) { const unsigned c = xb_ld(&bar[XB_XCNT(j)]); sum += c; cnt += (c > 0u) ? 1u : 0u; mine = (j == x) ? c : mine; }
        if (sum == G) break;
        __builtin_amdgcn_s_sleep(1);
        if ((++sp & 255u) == 0u) { if (xb_ld(&bar[XB_TMO])) break; if (sp > XB_SPIN_CAP) { atomicAdd(&bar[XB_TMO], 1u); break; } }
    }
    nloc = mine > 0u ? mine : 1u; nx = cnt > 0u ? cnt : 1u;
}

__device__ __forceinline__ void xcd_barrier(const XcdBarrier& b) {
    asm volatile("s_waitcnt vmcnt(0)" ::: "memory");
    __syncthreads();
    if (threadIdx.x == 0) {
        unsigned* bar = b.bar;
        __builtin_amdgcn_s_waitcnt(0);
        unsigned nloc = b.st[0], nx = b.st[1];
        if (nloc == 0u) { xcd_barrier_complete(bar, b.x, nloc, nx); b.st[0] = nloc; b.st[1] = nx; }
        const unsigned old = xb_add(&bar[XB_XSUB(b.x)], 1u);
        const unsigned gen = old / nloc;
        if (old + 1u == (gen + 1u) * nloc) {
            __builtin_amdgcn_fence(__ATOMIC_RELEASE, "agent");
            asm volatile("s_waitcnt vmcnt(0)" ::: "memory");
            const unsigned og = xb_add(&bar[XB_TOP], 1u);
            const unsigned tg = og / nx;
            if (og + 1u == (tg + 1u) * nx) xb_add(&bar[XB_TOPGEN], 1u);
            else XB_SPIN(xb_ld(&bar[XB_TOPGEN]) == tg, bar);
            __builtin_amdgcn_fence(__ATOMIC_ACQUIRE, "agent");
            xb_add(&bar[XB_XGEN(b.x)], 1u);
            asm volatile("s_waitcnt vmcnt(0)" ::: "memory");
        } else {
            XB_SPIN(xb_ld(&bar[XB_XGEN(b.x)]) == gen, bar);
            __builtin_amdgcn_fence(__ATOMIC_ACQUIRE, "agent");
            asm volatile("s_waitcnt vmcnt(0)" ::: "memory");
        }
    }
    __syncthreads();
}

#define KARGS() ({ CArgs* p_ = (CArgs*)__builtin_amdgcn_kernarg_segment_ptr(); size_t z_ = 0; asm volatile("" : "+s"(z_)); p_ + z_; })

__global__ void __launch_bounds__(NWAVES * 64, 2) mega_fwd(Args a) {
    extern __shared__ __attribute__((aligned(16))) unsigned char lds_raw[];
    cg::grid_group grid = cg::this_grid();
    LAS unsigned char* lds = (LAS unsigned char*)lds_raw;
    const int tid = threadIdx.x, lane = tid & 63, wave = __builtin_amdgcn_readfirstlane(tid >> 6);
    const int G = gridDim.x, bx = blockIdx.x;
    const int gw = bx * NWAVES + wave, ngw = G * NWAVES;
    unsigned char* ws = a.ws;
    bf16* hb = (bf16*)(ws + WS_HB); bf16* proj = (bf16*)(ws + WS_PROJ); bf16* mixed = (bf16*)(ws + WS_MIX); bf16* ffb = (bf16*)(ws + WS_FF);
    float* sspart = (float*)(ws + WS_SS); float* kvT = (float*)(ws + WS_KVT); float* decay = (float*)(ws + WS_DEC); bf16* St = (bf16*)(ws + WS_ST);
    float* out = a.out;
#if USE_XCD
    volatile LAS unsigned* MISC = (volatile LAS unsigned*)(lds + 143360);
    if (tid < 32) MISC[tid] = 0u;
    __syncthreads();
    XcdBarrier bar = xcd_barrier_post((unsigned*)(ws + WS_CTL) + 4096, MISC + 8);
#define GSYNC() xcd_barrier(bar)
#else
#define GSYNC() do { __threadfence(); grid.sync(); } while (0)
#endif

#ifndef REP_P0
#define REP_P0 1
#endif
#ifndef REP_B1
#define REP_B1 1
#endif
#ifndef REP_B23
#define REP_B23 1
#endif
#pragma nounroll
    for (int rep = 0; rep < REP_P0; ++rep) {
#if WSTAG
    p0_weights(KARGS(), (LAS float*)(lds + wave * 16384), 0, 2048, gw, ngw, lane);
    p0_weights(KARGS(), (LAS float*)(lds + wave * 16384), 4096, 6144, gw, ngw, lane);
    p0_weights(KARGS(), (LAS float*)(lds + wave * 16384), 10240, 12288, gw, ngw, lane);
#else
    p0_weights(KARGS(), (LAS float*)(lds + wave * 16384), 0, 12288, gw, ngw, lane);
#endif
    p0_rows(a.in[0], hb, sspart, gw, ngw, lane);
    }
#if USE_XCD
    if (G == 0x7fffffff) grid.sync();
    GSYNC();
#else
    __threadfence(); grid.sync();
#endif

#ifndef STAG_A
#define STAG_A 0
#endif
#ifndef STAG_D
#define STAG_D 0
#endif
#define STAGGER_WORK(lo_, hi_) do { if (WSTAG) { if (bx & 1) { int lane_s = threadIdx.x & 63; asm volatile("" : "+v"(lane_s)); \
        p0_weights(KARGS(), (LAS float*)(lds + wave * 16384), (lo_), (hi_), (bx >> 1) * NWAVES + wave, (G >> 1) * NWAVES, lane_s); } __syncthreads(); } } while (0)
#ifndef STAG_A
#define STAG_A 0
#endif
#ifndef STAG_D
#define STAG_D 0
#endif
#define STAGGER_IDLE(ticks) do { if ((ticks) > 0 && (bx & 1)) { const unsigned long long t0_ = __builtin_amdgcn_s_memrealtime(); while (__builtin_amdgcn_s_memrealtime() - t0_ < (unsigned long long)(ticks)) __builtin_amdgcn_s_sleep(8); } } while (0)
#define LAUNDER(p) do { size_t z_ = 0; asm volatile("" : "+s"(z_)); (p) = (p) + z_; } while (0)
#pragma nounroll
    for (int l = 0; l < 2; ++l) {
        const unsigned char* wl = KARGS()->ws + WS_W + (size_t)l * W_LAYER;
#ifndef REP_GA
#define REP_GA 1
#endif
#ifndef REP_GD
#define REP_GD 1
#endif
#pragma nounroll
        for (int rg = 0; rg < REP_GA; ++rg) { const bf16* gA = ((bf16*)(KARGS()->ws + WS_HB)); const bf16* gB = (const bf16*)(wl + W_IN); LAUNDER(gA); LAUNDER(gB);
          STAGGER_IDLE(STAG_A);
          pg8::Gemm g{gA, gB, MTOK, LDP, DM}; pg8::StaticOrder S; S.init(MTOK, LDP, G, bx);
#if PROBE_DRY
          if (rg + 1 < REP_GA) { pg8::EpiScaleBf16<0, true> E{((bf16*)(KARGS()->ws + WS_PROJ)), LDP, ((float*)(KARGS()->ws + WS_SS))};
          pg8::gemm_phase<pg8::EpiScaleBf16<0, true>, pg8::StaticOrder, true, PG_SP2>(lds, g, S, E); } else
#endif
          { pg8::EpiScaleBf16<0> E{((bf16*)(KARGS()->ws + WS_PROJ)), LDP, ((float*)(KARGS()->ws + WS_SS))};
          pg8::gemm_phase<pg8::EpiScaleBf16<0>, pg8::StaticOrder, true, PG_SP2>(lds, g, S, E); } }
        GSYNC();
        { bf16* projL = ((bf16*)(KARGS()->ws + WS_PROJ)); bf16* mixedL = ((bf16*)(KARGS()->ws + WS_MIX)); float* kvTL = ((float*)(KARGS()->ws + WS_KVT)); float* decayL = ((float*)(KARGS()->ws + WS_DEC)); bf16* StL = ((bf16*)(KARGS()->ws + WS_ST)); LAUNDER(projL); LAUNDER(mixedL); LAUNDER(kvTL); LAUNDER(decayL); LAUNDER(StL);
#pragma nounroll
        for (int rep = 0; rep < REP_B1; ++rep) {
#ifndef REP_CONV
#define REP_CONV 1
#endif
#ifndef REP_KV
#define REP_KV 1
#endif
#ifndef REP_ATT
#define REP_ATT 1
#endif
#ifndef REP_SCAN
#define REP_SCAN 1
#endif
#ifndef REP_OUT
#define REP_OUT 1
#endif
#ifndef NO_CONV
#pragma nounroll
        for (int rc = 0; rc < REP_CONV; ++rc)
        for (int bc = bx; bc < 512; bc += G)
            conv_item(projL, KARGS()->in[6] + l * 31 * 256, KARGS()->in[7] + l * 256, KARGS()->in[8] + l * 256, KARGS()->in[9] + l * 256, mixedL, lds, bc, tid, wave, lane);
#endif
        {
            LAS float* biasT = (LAS float*)(lds + 131072);
            int tidb = threadIdx.x; asm volatile("" : "+v"(tidb));
            for (int i = tidb; i < 6 * 257; i += NWAVES * 64) { const int hh = i / 257, j = i - hh * 257; biasT[hh * 260 + j] = KARGS()->in[10][(size_t)l * 6 * 257 + i] * LOG2E; }
            __syncthreads();
            LAS unsigned char* vimg = lds + wave * 16384;
#ifndef NO_GLAKV
#pragma nounroll
            for (int rc = 0; rc < REP_KV; ++rc)
            for (int it = gw; it < 2048; it += ngw) gla_kv_item(projL, KARGS()->in[4] + l * 192, kvTL, decayL, vimg, it, lane);
#endif
#ifndef NO_ATT
#pragma nounroll
            for (int rc = 0; rc < REP_ATT; ++rc)
#if ATT_BLOCK
            __syncthreads();
#pragma nounroll
            for (int ra = 0; ra < REP_ATT; ++ra)
            for (int u = bx; u < 768; u += G) {
                int uu = u;
                if (G == 256) { const int combo = (u >> 8) * 8 + (bx & 7); uu = ((combo / 3) * 32 + (bx >> 3)) * 3 + combo % 3; }
                ATT_UNIT_FN(projL, mixedL, biasT, lds, uu, wave, lane);
            }
#else
            for (int u = gw; u < 6144; u += ngw) attn_unit(projL, mixedL, biasT, vimg, u, lane);
#endif
#endif
        }
        __syncthreads();
        }
        GSYNC();
#pragma nounroll
        for (int rep = 0; rep < REP_B23; ++rep) {
        LAUNDER(kvTL); LAUNDER(decayL); LAUNDER(StL);
#pragma nounroll
        for (int rc = 0; rc < REP_SCAN; ++rc)
        { int tids = threadIdx.x; asm volatile("" : "+v"(tids)); gla_scan(kvTL, decayL, StL, bx * (NWAVES * 64) + tids, G * NWAVES * 64); }
        GSYNC();
        LAUNDER(projL); LAUNDER(mixedL); LAUNDER(StL);
#ifndef NO_GLAOUT
#pragma nounroll
        for (int rc = 0; rc < REP_OUT; ++rc)
        for (int it = gw; it < 2048; it += ngw) gla_out_item(projL, StL, mixedL, it, lane);
#endif
        GSYNC();
        }
        }
#ifndef REP_GC
#define REP_GC 1
#endif
#ifndef REP_GE
#define REP_GE 1
#endif
#pragma nounroll
        for (int rgc = 0; rgc < REP_GC; ++rgc)
        { const bf16* gA = ((bf16*)(KARGS()->ws + WS_MIX)); const bf16* gB = (const bf16*)(wl + W_OUT); LAUNDER(gA); LAUNDER(gB);
          STAGGER_WORK(l == 0 ? 2048 : 8192, l == 0 ? 4096 : 10240);
          pg8::Gemm g{gA, gB, MTOK, DM, DM}; pg8::StaticOrder S; S.init(MTOK, DM, G, bx);
          pg8::EpiResid E{((bf16*)(KARGS()->ws + WS_HB)), rgc + 1 < REP_GC ? (bf16*)(KARGS()->ws + 371 * MiB) : ((bf16*)(KARGS()->ws + WS_HB)), ((float*)(KARGS()->ws + WS_SSA)), nullptr};
          pg8::gemm_phase<pg8::EpiResid, pg8::StaticOrder, true, PG_SP2>(lds, g, S, E); }
        GSYNC();
#pragma nounroll
        for (int rg = 0; rg < REP_GD; ++rg) { const bf16* gA = ((bf16*)(KARGS()->ws + WS_HB)); const bf16* gB = (const bf16*)(wl + W_UP); LAUNDER(gA); LAUNDER(gB);
          STAGGER_IDLE(STAG_D);
          pg8::Gemm g{gA, gB, MTOK, FF, DM}; pg8::StaticOrder S; S.init(MTOK, FF, G, bx);
          pg8::EpiScaleBf16<1, false, false> E{((bf16*)(KARGS()->ws + WS_FF)), FF, nullptr};
          pg8::gemm_phase<pg8::EpiScaleBf16<1, false, false>, pg8::StaticOrder, true, PG_SP2>(lds, g, S, E); }
        GSYNC();
#pragma nounroll
        for (int rge = 0; rge < REP_GE; ++rge)
        { const bf16* gA = ((bf16*)(KARGS()->ws + WS_FF)); const bf16* gB = (const bf16*)(wl + W_DN); LAUNDER(gA); LAUNDER(gB);
          STAGGER_WORK(l == 0 ? 6144 : 0, l == 0 ? 8192 : 0);
          pg8::Gemm g{gA, gB, MTOK, DM, FF}; pg8::StaticOrder S; S.init(MTOK, DM, G, bx);
          pg8::EpiResid E{((bf16*)(KARGS()->ws + WS_HB)), rge + 1 < REP_GE ? (bf16*)(KARGS()->ws + 371 * MiB) : ((bf16*)(KARGS()->ws + WS_HB)), ((float*)(KARGS()->ws + WS_SS)), ((const float*)(KARGS()->ws + WS_SSA))};
          pg8::gemm_phase<pg8::EpiResid, pg8::StaticOrder, true, PG_SP2>(lds, g, S, E); }
        GSYNC();
    }
    { int lane2 = tid & 63; asm volatile("" : "+v"(lane2)); final_rows((KARGS()->out), ((bf16*)(KARGS()->ws + WS_HB)), ((float*)(KARGS()->ws + WS_SS)), KARGS()->in[15], gw, ngw, lane2); }
}

extern "C" void kernel_launch(void* const* d_in, const int* in_sizes, int n_in, void* d_out, int out_size, void* d_ws, size_t ws_size, hipStream_t stream) {
    static int grid = 0;
    if (grid == 0) {
        if (n_in != 16 || in_sizes[0] != MTOK * DM || out_size != MTOK * DM || ws_size < WS_END) { fprintf(stderr, "kernel_launch: unexpected shapes (n_in %d, ws %zu)\n", n_in, ws_size); grid = -1; return; }
        int dev = 0, cus = 0, per_cu = 0;
        if (hipGetDevice(&dev) != hipSuccess || hipDeviceGetAttribute(&cus, hipDeviceAttributeMultiprocessorCount, dev) != hipSuccess) { grid = -1; return; }
        if (hipFuncSetAttribute((const void*)mega_fwd, hipFuncAttributeMaxDynamicSharedMemorySize, LDS_BYTES) != hipSuccess) { fprintf(stderr, "kernel_launch: hipFuncSetAttribute failed\n"); grid = -1; return; }
        if (hipOccupancyMaxActiveBlocksPerMultiprocessor(&per_cu, (const void*)mega_fwd, NWAVES * 64, LDS_BYTES) != hipSuccess || per_cu < 1) { fprintf(stderr, "kernel_launch: occupancy query says %d blocks per CU\n", per_cu); (void)hipGetLastError(); grid = -1; return; }
        grid = cus;
    }
    if (grid < 0) return;
#if USE_XCD
    if (hipMemsetAsync((char*)d_ws + WS_CTL, 0, 65536, stream) != hipSuccess) { fprintf(stderr, "kernel_launch: memset failed\n"); return; }
#endif
    Args a{};
    for (int i = 0; i < 16; ++i) a.in[i] = (const float*)d_in[i];
    a.out = (float*)d_out; a.ws = (unsigned char*)d_ws;
    void* args[] = {&a};
    const hipError_t e = hipLaunchCooperativeKernel((const void*)mega_fwd, dim3(grid), dim3(NWAVES * 64), args, LDS_BYTES, stream);
    if (e != hipSuccess) fprintf(stderr, "kernel_launch: cooperative launch failed: %s (grid %d)\n", hipGetErrorString(e), grid);
}
```

```cpp
#include <hip/hip_runtime.h>
#include <hip/hip_cooperative_groups.h>
#include <cstdio>
#include <cstdint>
namespace cg = cooperative_groups;
#ifndef USE_XCD
#define USE_XCD 1
#endif
#ifndef PROBE_DRY
#define PROBE_DRY 0
#endif
#define STAG_A 0
#define STAG_D 0
#ifndef PG_SP2
#define PG_SP2 true
#endif
#ifndef ATT_IGLP
#define ATT_IGLP -1
#endif
#ifndef STREAM_NT
#define STREAM_NT 1
#endif
#ifndef WSTAG
#define WSTAG 1
#endif
#ifndef ATT_BLOCK
#define ATT_BLOCK 1
#endif
#ifndef ATT_PAIR
#define ATT_PAIR 1
#endif
#if ATT_PAIR
#define ATT_UNIT_FN attn_pair_unit
#else
#define ATT_UNIT_FN attn_block_unit
#endif
namespace pg8 {
#define PG8_LAS __attribute__((address_space(3)))
typedef unsigned short bf16_t;
typedef short bf16x8 __attribute__((ext_vector_type(8)));
typedef float f32x4 __attribute__((ext_vector_type(4)));
typedef unsigned u32x4 __attribute__((ext_vector_type(4)));
constexpr int BM = 256, BK = 64, HALF = 128, HTB = HALF * BK * 2  , STAGE_BYTES = 8 * HTB, NXCD = 8, WGM = 4;

__host__ __device__ __forceinline__ int lds_byte(int r, int c) { const int st = (r >> 4) * 2 + (c >> 5), rr = r & 15, cc = c & 31, ob = rr * 64 + cc * 2; return st * 1024 + (ob ^ (((ob >> 9) & 1) << 5)); }
__host__ __device__ __forceinline__ void stage_rc(int b, int& R, int& C) { const int st = b / 1024, sb = b % 1024, swz = sb ^ (((sb >> 9) & 1) << 5); R = (st >> 1) * 16 + swz / 64; C = (st & 1) * 32 + (swz % 64) / 2; }
__host__ __device__ __forceinline__ int perm32(int rho) { const int n = rho >> 4, i = rho & 15; return 8 * (i >> 2) + 4 * n + (i & 3); }

struct Unit { int pm, pn; };
struct Gemm { const bf16_t* A; const bf16_t* Bt; int M, N, K; };

struct StaticOrder {
    int nM, nN, nwg, G, c;
    __host__ __device__ void init(int M, int N, int G_, int c_) { nM = M / BM; nN = N / BM; nwg = nM * nN; G = G_; c = c_; }
    __host__ __device__ bool next(int i, Unit& u) const {
        const long L = (long)i * G + c; if (L >= nwg) return false;
        int wgid = (int)L; { const int q = nwg / NXCD, r = nwg % NXCD, xcd = wgid % NXCD, off = wgid / NXCD; wgid = (xcd < r ? xcd * (q + 1) : r * (q + 1) + (xcd - r) * q) + off; }
        const int nig = WGM * nN, gid = wgid / nig, fm = gid * WGM, gsz = (nM - fm) < WGM ? (nM - fm) : WGM;
        u.pm = fm + ((wgid % nig) % gsz); u.pn = (wgid % nig) / gsz; return true;
    }
    __device__ __forceinline__ void a_ready(const Unit&) const {}
    __device__ __forceinline__ void done(const Unit&) const {}
};

__device__ __forceinline__ unsigned cvt_pk_bf16(float lo, float hi) { unsigned r; asm volatile("v_cvt_pk_bf16_f32 %0, %1, %2" : "=v"(r) : "v"(lo), "v"(hi)); return r; }

__device__ __forceinline__ unsigned cvtpk2(float lo, float hi) { typedef float f2_t __attribute__((ext_vector_type(2))); typedef __bf16 b2_t __attribute__((ext_vector_type(2))); f2_t v = {lo, hi}; b2_t b = __builtin_convertvector(v, b2_t); return __builtin_bit_cast(unsigned, b); }
#ifndef FF_NT
#define FF_NT 0
#endif
#ifndef EPI_WT
#define EPI_WT 0
#endif
#ifndef EPI_WT8
#define EPI_WT8 0
#endif
__device__ __forceinline__ void st16_wt(void* p, u32x4 v) {
#if EPI_WT
    asm volatile("global_store_dwordx4 %0, %1, off sc1\n\ts_nop 1" :: "v"(p), "v"(v) : "memory");
#else
    *(u32x4*)p = v;
#endif
}
typedef unsigned u32x2w __attribute__((ext_vector_type(2)));
__device__ __forceinline__ void st8_wt(void* p, u32x2w v) {
#if EPI_WT8
    asm volatile("global_store_dwordx2 %0, %1, off sc1" :: "v"(p), "v"(v) : "memory");
#else
    *(u32x2w*)p = v;
#endif
}
__device__ __forceinline__ float row_rstd16(const float* sspart, int row, int fq) {
    const f32x4 p = *(const f32x4*)(sspart + (size_t)row * 16 + 4 * fq);
    float s = (p[0] + p[1]) + (p[2] + p[3]);
    s += __shfl_xor(s, 16); s += __shfl_xor(s, 32);
    return __builtin_amdgcn_rsqf(s * (1.0f / 1024.0f) + 1e-6f);
}
template <int ACT, bool DRY = false, bool SCALE = true> struct EpiScaleBf16 {
    static constexpr bool PERM = true, AFTER_DRAIN = false; static constexpr int A_AUX = 0;
    bf16_t* O; int ldc; const float* sspart;
    __device__ __forceinline__ void operator()(const f32x4 (&acc)[2][2][4][2], const Unit& u, int wr, int wc, int fr, int fq) const {
        const int row0 = u.pm * BM + wr * 64 + fr; const int col0 = u.pn * BM + wc * 32 + 8 * fq;
        float rs[2][4];
        if constexpr (SCALE) { f32x4 pp[2][4];
#pragma unroll
        for (int ai = 0; ai < 2; ++ai)
#pragma unroll
            for (int m = 0; m < 4; ++m) pp[ai][m] = *(const f32x4*)(sspart + (size_t)(row0 + ai * HALF + m * 16) * 16 + 4 * fq);
        asm volatile("" : "+v"(pp[0][0]), "+v"(pp[0][1]), "+v"(pp[0][2]), "+v"(pp[0][3]), "+v"(pp[1][0]), "+v"(pp[1][1]), "+v"(pp[1][2]), "+v"(pp[1][3]));
#pragma unroll
        for (int ai = 0; ai < 2; ++ai)
#pragma unroll
            for (int m = 0; m < 4; ++m) { const f32x4 p = pp[ai][m]; rs[ai][m] = (p[0] + p[1]) + (p[2] + p[3]); }
#pragma unroll
        for (int ai = 0; ai < 2; ++ai)
#pragma unroll
            for (int m = 0; m < 4; ++m) { float s = rs[ai][m]; s += __shfl_xor(s, 16); s += __shfl_xor(s, 32); rs[ai][m] = __builtin_amdgcn_rsqf(s * (1.0f / 1024.0f) + 1e-6f); }
        } else {
#pragma unroll
            for (int ai = 0; ai < 2; ++ai)
#pragma unroll
                for (int m = 0; m < 4; ++m) rs[ai][m] = 1.0f;
        }
#pragma unroll
        for (int ai = 0; ai < 2; ++ai)
#pragma unroll
            for (int m = 0; m < 4; ++m) { const int row = row0 + ai * HALF + m * 16; const float r = rs[ai][m];
                bf16_t* rowp = O + (size_t)row * ldc + col0;
#pragma unroll
                for (int bj = 0; bj < 2; ++bj) { f32x4 v0 = acc[ai][bj][m][0] * r, v1 = acc[ai][bj][m][1] * r;
                    if (ACT == 1) {
#pragma unroll
                        for (int e = 0; e < 4; ++e) { const float a = fmaxf(v0[e], 0.f), b = fmaxf(v1[e], 0.f); v0[e] = a * a; v1[e] = b * b; } }
                    u32x4 w; w.x = cvtpk2(v0[0], v0[1]); w.y = cvtpk2(v0[2], v0[3]); w.z = cvtpk2(v1[0], v1[1]); w.w = cvtpk2(v1[2], v1[3]);
                    if (!DRY || w.x == 0x7fc17fc1u) { if (ACT == 1 && FF_NT) __builtin_nontemporal_store(w, (u32x4*)(rowp + bj * HALF)); else st16_wt(rowp + bj * HALF, w); } } }
    }
};
#ifndef RESID_A_AUX
#define RESID_A_AUX 0
#endif
struct EpiResid {
    static constexpr bool PERM = false, AFTER_DRAIN = false; static constexpr int A_AUX = RESID_A_AUX;
    const bf16_t* hin; bf16_t* hb; float* sspart; const float* ss_scale;
    __device__ __forceinline__ void operator()(const f32x4 (&acc)[2][2][4][2], const Unit& u, int wr, int wc, int fr, int fq) const {
        typedef unsigned u32x2v __attribute__((ext_vector_type(2)));
        const int col0 = u.pn * BM + wc * 32 + 4 * fq;
#pragma unroll
        for (int ai = 0; ai < 2; ++ai) {
            u32x2v bs[4][2][2];
#pragma unroll
            for (int m = 0; m < 4; ++m) { const size_t off = (size_t)(u.pm * BM + ai * HALF + wr * 64 + m * 16 + fr) * 1024 + col0;
#pragma unroll
                for (int bj = 0; bj < 2; ++bj)
#pragma unroll
                    for (int n = 0; n < 2; ++n) bs[m][bj][n] = *(const u32x2v*)(hin + off + bj * HALF + n * 16); }
            f32x4 pp[4]; float r2[4];
            if (ss_scale) {
#pragma unroll
                for (int m = 0; m < 4; ++m) pp[m] = *(const f32x4*)(ss_scale + (size_t)(u.pm * BM + ai * HALF + wr * 64 + m * 16 + fr) * 16 + 4 * fq);
                asm volatile("" : "+v"(pp[0]), "+v"(pp[1]), "+v"(pp[2]), "+v"(pp[3]));
#pragma unroll
                for (int m = 0; m < 4; ++m) { const f32x4 p = pp[m]; float s = (p[0] + p[1]) + (p[2] + p[3]); s += __shfl_xor(s, 16); s += __shfl_xor(s, 32); r2[m] = __builtin_amdgcn_rcpf(s * (1.0f / 1024.0f) + 1e-6f); }
            } else {
#pragma unroll
                for (int m = 0; m < 4; ++m) r2[m] = 1.0f;
            }
            asm volatile("" : "+v"(bs[0][0][0]), "+v"(bs[0][0][1]), "+v"(bs[0][1][0]), "+v"(bs[0][1][1]), "+v"(bs[1][0][0]), "+v"(bs[1][0][1]), "+v"(bs[1][1][0]), "+v"(bs[1][1][1]),
                             "+v"(bs[2][0][0]), "+v"(bs[2][0][1]), "+v"(bs[2][1][0]), "+v"(bs[2][1][1]), "+v"(bs[3][0][0]), "+v"(bs[3][0][1]), "+v"(bs[3][1][0]), "+v"(bs[3][1][1]) :: "memory");
#pragma unroll
            for (int m = 0; m < 4; ++m) { const int r = u.pm * BM + ai * HALF + wr * 64 + m * 16 + fr; const size_t off = (size_t)r * 1024 + col0; float ss = 0.f;
#pragma unroll
                for (int bj = 0; bj < 2; ++bj)
#pragma unroll
                    for (int n = 0; n < 2; ++n) { const u32x2v b = bs[m][bj][n]; f32x4 o = acc[ai][bj][m][n] * r2[m];
                        o[0] += __uint_as_float(b.x << 16); o[1] += __uint_as_float(b.x & 0xffff0000u); o[2] += __uint_as_float(b.y << 16); o[3] += __uint_as_float(b.y & 0xffff0000u);
                        u32x2v w; w.x = cvtpk2(o[0], o[1]); w.y = cvtpk2(o[2], o[3]); st8_wt(hb + off + bj * HALF + n * 16, w);
                        ss += (o[0] * o[0] + o[1] * o[1]) + (o[2] * o[2] + o[3] * o[3]); }
                ss += __shfl_xor(ss, 16); ss += __shfl_xor(ss, 32);
                if (fq == 0) sspart[(size_t)r * 16 + u.pn * 4 + wc] = ss; }
            asm volatile("" ::: "memory");
        }
    }
};
template <class Epi, class Sched, bool ALIGN_EPI = false, bool SP2 = false>
__device__ __forceinline__ void gemm_phase(PG8_LAS unsigned char* lds, const Gemm g, const Sched& S, const Epi& E) {
    int tid_ = threadIdx.x; asm volatile("" : "+v"(tid_));
    const int tid = tid_, wid = __builtin_amdgcn_readfirstlane(tid >> 6), lane = tid & 63, wr = wid >> 2, wc = wid & 3, fr = lane & 15, fq = lane >> 4;
    const int K = g.K, nt = K / BK;
    unsigned voffA[2], voffB[2];
#pragma unroll
    for (int i = 0; i < 2; ++i) { int R, C; stage_rc(tid * 16 + i * 8192, R, C); const int Rb = Epi::PERM ? ((R & ~31) + perm32(R & 31)) : R;
        voffA[i] = (unsigned)(R * K + C) * 2u; voffB[i] = (unsigned)(Rb * K + C) * 2u; }
    const size_t kstep = (size_t)(BK * 2);
    const size_t hstep = (size_t)HALF * K * 2;
    const size_t tstep = 2 * hstep;
    const unsigned ldsw = (unsigned)wid * 1024u;
    const int aoff = lds_byte(wr * 64 + fr, fq * 8), boff = lds_byte(wc * 32 + fr, fq * 8);
#define PG8_SA(b, h) (((b) * 2 + (h)) * HTB)
#define PG8_SB(b, h) ((4 + (b) * 2 + (h)) * HTB)
#define PG8_STAGE(bufoff, gbase, voff) do { _Pragma("unroll") for (int _i = 0; _i < 2; ++_i) \
        __builtin_amdgcn_global_load_lds((const unsigned*)((const char*)(gbase) + (voff)[_i]), (PG8_LAS unsigned*)(lds + (bufoff) + ldsw + _i * 8192), 16, 0, 0); } while (0)
#define PG8_STAGE_A(bufoff, gbase, voff) do { _Pragma("unroll") for (int _i = 0; _i < 2; ++_i) \
        __builtin_amdgcn_global_load_lds((const unsigned*)((const char*)(gbase) + (voff)[_i]), (PG8_LAS unsigned*)(lds + (bufoff) + ldsw + _i * 8192), 16, 0, Epi::A_AUX); } while (0)
#define PG8_LDA(dst, b, h) do { _Pragma("unroll") for (int m = 0; m < 4; ++m) _Pragma("unroll") for (int k = 0; k < 2; ++k) dst[m][k] = *(const PG8_LAS bf16x8*)(lds + PG8_SA(b, h) + aoff + m * 2048 + k * 1024); } while (0)
#define PG8_LDB(dst, b, h) do { _Pragma("unroll") for (int n = 0; n < 2; ++n) _Pragma("unroll") for (int k = 0; k < 2; ++k) dst[n][k] = *(const PG8_LAS bf16x8*)(lds + PG8_SB(b, h) + boff + n * 2048 + k * 1024); } while (0)
#define PG8_MMA(ai, bj, At, Bt) do { __builtin_amdgcn_s_setprio(1); _Pragma("unroll") for (int m = 0; m < 4; ++m) _Pragma("unroll") for (int n = 0; n < 2; ++n) _Pragma("unroll") for (int k = 0; k < 2; ++k) \
        acc[ai][bj][m][n] = __builtin_amdgcn_mfma_f32_16x16x32_bf16(Bt[n][k], At[m][k], acc[ai][bj][m][n], 0, 0, 0); __builtin_amdgcn_s_setprio(0); } while (0)
#define PG8_WAIT_V(n) asm volatile("s_waitcnt vmcnt(" #n ")" ::: "memory")
#define PG8_WAIT_L(n) asm volatile("s_waitcnt lgkmcnt(" #n ")" ::: "memory")
#define PG8_BAR __builtin_amdgcn_s_barrier()
#define PG8_SCHED __builtin_amdgcn_sched_barrier(0)
    Unit cur, nxt; int ui = 0;
    if (!S.next(0, cur)) return;
    f32x4 acc[2][2][4][2];
#pragma unroll
    for (int a = 0; a < 2; ++a)
#pragma unroll
        for (int b = 0; b < 2; ++b)
#pragma unroll
            for (int m = 0; m < 4; ++m)
#pragma unroll
                for (int n = 0; n < 2; ++n) acc[a][b][m][n] = (f32x4){0.f, 0.f, 0.f, 0.f};
    bf16x8 At[4][2], B0[2][2], B1[2][2];
    const char* cA = (const char*)g.A + (size_t)cur.pm * tstep; const char* cB = (const char*)g.Bt + (size_t)cur.pn * tstep;
    S.a_ready(cur);
    if constexpr (SP2) {
        PG8_STAGE(PG8_SB(0, 0), cB, voffB); PG8_STAGE(PG8_SB(0, 1), cB + hstep, voffB); PG8_STAGE_A(PG8_SA(0, 0), cA, voffA); PG8_STAGE_A(PG8_SA(0, 1), cA + hstep, voffA);
        if (wr == 1) PG8_BAR;
        PG8_WAIT_V(2); PG8_BAR;
        PG8_STAGE(PG8_SB(1, 0), cB + kstep, voffB); PG8_STAGE_A(PG8_SA(1, 0), cA + kstep, voffA); PG8_STAGE(PG8_SB(1, 1), cB + hstep + kstep, voffB);
        PG8_WAIT_V(6); PG8_BAR;
    } else {
        PG8_STAGE(PG8_SB(0, 0), cB, voffB); PG8_STAGE_A(PG8_SA(0, 0), cA, voffA); PG8_STAGE(PG8_SB(0, 1), cB + hstep, voffB); PG8_STAGE_A(PG8_SA(0, 1), cA + hstep, voffA);
        if (wr == 1) PG8_BAR;
        PG8_WAIT_V(4); PG8_BAR;
        PG8_STAGE(PG8_SB(1, 0), cB + kstep, voffB); PG8_STAGE_A(PG8_SA(1, 0), cA + kstep, voffA); PG8_STAGE(PG8_SB(1, 1), cB + hstep + kstep, voffB);
        PG8_WAIT_V(6); PG8_BAR;
    }
    for (;;) {
        const bool has_next = S.next(ui + 1, nxt);
        const char* nA = has_next ? (const char*)g.A + (size_t)nxt.pm * tstep : cA; const char* nB = has_next ? (const char*)g.Bt + (size_t)nxt.pn * tstep : cB;
        for (int t = 0; t < nt; t += 2) {
            const bool last = (t == nt - 2);
            const char* a1 = cA + (size_t)(t + 1) * kstep;
            const char* a2 = last ? nA : cA + (size_t)(t + 2) * kstep; const char* b2 = last ? nB : cB + (size_t)(t + 2) * kstep;
            const char* a3 = a2 + kstep; const char* b3 = b2 + kstep;
            if (last && has_next) S.a_ready(nxt);
            if constexpr (SP2) {
            PG8_LDB(B0, 0, 0); PG8_LDB(B1, 0, 1); PG8_SCHED; PG8_LDA(At, 0, 0); PG8_STAGE_A(PG8_SA(1, 1), a1 + hstep, voffA);
            PG8_WAIT_V(8); PG8_WAIT_L(0); PG8_BAR; PG8_MMA(0, 0, At, B0); PG8_MMA(0, 1, At, B1); PG8_BAR; PG8_SCHED;
            PG8_LDA(At, 0, 1); PG8_STAGE(PG8_SB(0, 0), b2, voffB); PG8_STAGE(PG8_SB(0, 1), b2 + hstep, voffB); PG8_STAGE_A(PG8_SA(0, 0), a2, voffA);
            PG8_WAIT_V(8); PG8_WAIT_L(0); PG8_BAR; PG8_MMA(1, 0, At, B0); PG8_MMA(1, 1, At, B1); PG8_BAR; PG8_SCHED;
            PG8_LDB(B0, 1, 0); PG8_LDB(B1, 1, 1); PG8_SCHED; PG8_LDA(At, 1, 0); PG8_STAGE_A(PG8_SA(0, 1), a2 + hstep, voffA);
            PG8_WAIT_V(8); PG8_WAIT_L(0); PG8_BAR; PG8_MMA(0, 0, At, B0); PG8_MMA(0, 1, At, B1); PG8_BAR; PG8_SCHED;
            PG8_LDA(At, 1, 1); PG8_STAGE(PG8_SB(1, 0), b3, voffB); PG8_STAGE(PG8_SB(1, 1), b3 + hstep, voffB); PG8_STAGE_A(PG8_SA(1, 0), a3, voffA);
            PG8_WAIT_V(8); PG8_WAIT_L(0); PG8_BAR; PG8_MMA(1, 0, At, B0); PG8_MMA(1, 1, At, B1); PG8_BAR; PG8_SCHED;
            } else {
            PG8_LDB(B0, 0, 0); PG8_SCHED; PG8_LDA(At, 0, 0); PG8_STAGE_A(PG8_SA(1, 1), a1 + hstep, voffA);
            PG8_WAIT_L(8); PG8_BAR; PG8_WAIT_L(0); PG8_MMA(0, 0, At, B0); PG8_BAR; PG8_SCHED;
            PG8_LDB(B1, 0, 1); PG8_STAGE(PG8_SB(0, 0), b2, voffB);
            PG8_BAR; PG8_WAIT_L(0); PG8_MMA(0, 1, At, B1); PG8_BAR;
            PG8_LDA(At, 0, 1); PG8_STAGE_A(PG8_SA(0, 0), a2, voffA);
            PG8_BAR; PG8_WAIT_L(0); PG8_MMA(1, 0, At, B0); PG8_BAR; PG8_SCHED;
            PG8_STAGE(PG8_SB(0, 1), b2 + hstep, voffB);
            PG8_WAIT_V(6); PG8_BAR; PG8_MMA(1, 1, At, B1); PG8_BAR;
            PG8_LDB(B0, 1, 0); PG8_SCHED; PG8_LDA(At, 1, 0); PG8_STAGE_A(PG8_SA(0, 1), a2 + hstep, voffA);
            PG8_WAIT_L(8); PG8_BAR; PG8_WAIT_L(0); PG8_MMA(0, 0, At, B0); PG8_BAR; PG8_SCHED;
            PG8_LDB(B1, 1, 1); PG8_STAGE(PG8_SB(1, 0), b3, voffB);
            PG8_BAR; PG8_WAIT_L(0); PG8_MMA(0, 1, At, B1); PG8_BAR;
            PG8_LDA(At, 1, 1); PG8_STAGE_A(PG8_SA(1, 0), a3, voffA);
            PG8_BAR; PG8_WAIT_L(0); PG8_MMA(1, 0, At, B0); PG8_BAR; PG8_SCHED;
            PG8_STAGE(PG8_SB(1, 1), b3 + hstep, voffB);
            PG8_WAIT_V(6); PG8_BAR; PG8_MMA(1, 1, At, B1); PG8_BAR;
            }
        }
        if constexpr (ALIGN_EPI) { if (wr == 0) PG8_BAR; }
        if constexpr (!Epi::AFTER_DRAIN) { E(acc, cur, wr, wc, fr, fq); S.done(cur); }
        if (!has_next) break;
#pragma unroll
        for (int a = 0; a < 2; ++a)
#pragma unroll
            for (int b = 0; b < 2; ++b)
#pragma unroll
                for (int m = 0; m < 4; ++m)
#pragma unroll
                    for (int n = 0; n < 2; ++n) acc[a][b][m][n] = (f32x4){0.f, 0.f, 0.f, 0.f};
        cur = nxt; cA = nA; cB = nB; ++ui;
        if constexpr (ALIGN_EPI) { if (wr == 1) PG8_BAR; }
    }
    PG8_WAIT_V(0);
    if constexpr (!ALIGN_EPI) { if (wr == 0) PG8_BAR; }
    PG8_BAR;
    if constexpr (Epi::AFTER_DRAIN) { E.fused(acc, cur, wr, wc, fr, fq, lds, wid, lane); S.done(cur); }
#undef PG8_SA
#undef PG8_SB
#undef PG8_STAGE
#undef PG8_STAGE_A
#undef PG8_LDA
#undef PG8_LDB
#undef PG8_MMA
#undef PG8_WAIT_V
#undef PG8_WAIT_L
#undef PG8_BAR
#undef PG8_SCHED
}
}

#define LAS __attribute__((address_space(3)))
typedef unsigned short bf16;
typedef short bf16x8 __attribute__((ext_vector_type(8)));
typedef float f32x4 __attribute__((ext_vector_type(4)));
typedef float f32x16 __attribute__((ext_vector_type(16)));
typedef unsigned u32x4 __attribute__((ext_vector_type(4)));
typedef unsigned u32x2 __attribute__((ext_vector_type(2)));
typedef short v4i16_t __attribute__((ext_vector_type(4)));

constexpr int NWAVES = 8;
constexpr int MTOK = 32768, DM = 1024, SEQ = 4096, NCH = 64, FF = 4096;
constexpr int DIN_SRC = 2832;
constexpr int LDP = 3072;
constexpr int GQ = 0, GK = 192, GV = 384, GG = 768, GZ = 1152, CU = 1344, AQ = 1856, AK = 2240, AV = 2624, PEND = 3008;
constexpr int MIX_GLA = 0, MIX_CONV = 384, MIX_ATT = 640;
constexpr float EPS = 1e-6f;
constexpr float LOG2E = 1.4426950408889634f;

constexpr size_t MiB = 1u << 20;
constexpr size_t WS_CTL = 0;
constexpr size_t WS_W = 1 * MiB, W_LAYER = 24 * MiB, W_IN = 0, W_OUT = 6 * MiB, W_UP = 8 * MiB, W_DN = 16 * MiB;
constexpr size_t WS_HB = 49 * MiB;
constexpr size_t WS_PROJ = 113 * MiB;
constexpr size_t WS_MIX = 305 * MiB;
constexpr size_t WS_FF = 113 * MiB;
constexpr size_t WS_SS = 369 * MiB;
constexpr size_t WS_KVT = 371 * MiB;
constexpr size_t WS_DEC = 407 * MiB;
constexpr size_t WS_ST = 408 * MiB;
constexpr size_t WS_SSA = 428 * MiB;
constexpr size_t WS_END = 430 * MiB;

constexpr int LDS_BYTES = 147456;

__device__ __forceinline__ unsigned cvtpk(float lo, float hi) { typedef float f2_t __attribute__((ext_vector_type(2))); typedef __bf16 b2_t __attribute__((ext_vector_type(2))); f2_t v = {lo, hi}; b2_t b = __builtin_convertvector(v, b2_t); return __builtin_bit_cast(unsigned, b); }
__device__ __forceinline__ float bflo(unsigned u) { return __uint_as_float(u << 16); }
__device__ __forceinline__ float bfhi(unsigned u) { return __uint_as_float(u & 0xffff0000u); }
__device__ __forceinline__ float bf2f(bf16 u) { return __uint_as_float((unsigned)u << 16); }
__device__ __forceinline__ float dpp_add(float v, int dummy) { return v; }
#define DPP_ADD(v, ctrl) ((v) + __builtin_bit_cast(float, __builtin_amdgcn_update_dpp(0, __builtin_bit_cast(int, (v)), (ctrl), 0xf, 0xf, true)))
__device__ __forceinline__ float wave_sum(float v) {
    v = DPP_ADD(v, 0xB1); v = DPP_ADD(v, 0x4E); v = DPP_ADD(v, 0x141); v = DPP_ADD(v, 0x140);
    const int iv = __builtin_bit_cast(int, v);
    const float r0 = __builtin_bit_cast(float, __builtin_amdgcn_readlane(iv, 0)), r1 = __builtin_bit_cast(float, __builtin_amdgcn_readlane(iv, 16));
    const float r2 = __builtin_bit_cast(float, __builtin_amdgcn_readlane(iv, 32)), r3 = __builtin_bit_cast(float, __builtin_amdgcn_readlane(iv, 48));
    return (r0 + r1) + (r2 + r3);
}
__device__ __forceinline__ float fast_sigmoid(float x) { return __builtin_amdgcn_rcpf(1.f + __expf(-x)); }
__device__ __forceinline__ int crow(int r, int hi) { return (r & 3) + 8 * (r >> 2) + 4 * hi; }
__device__ __forceinline__ v4i16_t trrd(LAS const unsigned char* p) { return __builtin_amdgcn_ds_read_tr16_b64_v4i16((LAS v4i16_t*)p); }
__device__ __forceinline__ bf16x8 cat8(v4i16_t a, v4i16_t b) { return (bf16x8){a[0], a[1], a[2], a[3], b[0], b[1], b[2], b[3]}; }
#define MFMA32(a, b, c) __builtin_amdgcn_mfma_f32_32x32x16_bf16((a), (b), (c), 0, 0, 0)
#define LDS_FENCE() asm volatile("s_waitcnt lgkmcnt(0)" ::: "memory")

struct Args { const float* in[16]; float* out; unsigned char* ws; };
typedef const Args __attribute__((address_space(4))) CArgs;
__device__ __forceinline__ void p0_store_tile(LAS float* scr, bf16* WT, int K, int dst_row0, int k0, const float* gain, int lane) {
    const int c = lane & 7;
    f32x4 g0 = (f32x4){1.f, 1.f, 1.f, 1.f}, g1 = g0;
    if (gain) { g0 = *(const f32x4*)(gain + k0 + 8 * c); g1 = *(const f32x4*)(gain + k0 + 8 * c + 4); }
    LDS_FENCE();
#pragma unroll
    for (int j = 0; j < 4; ++j) { const int n = (lane >> 3) + 8 * j; const LAS float* s = scr + (8 * c) * 33 + n;
        u32x4 o; o.x = cvtpk(s[0 * 33] * g0[0], s[1 * 33] * g0[1]); o.y = cvtpk(s[2 * 33] * g0[2], s[3 * 33] * g0[3]); o.z = cvtpk(s[4 * 33] * g1[0], s[5 * 33] * g1[1]); o.w = cvtpk(s[6 * 33] * g1[2], s[7 * 33] * g1[3]);
        *(u32x4*)(WT + (size_t)(dst_row0 + n) * K + k0 + 8 * c) = o; }
    LDS_FENCE();
}
__device__ __forceinline__ void p0_copy_item(const float* W, int ldw, int src0, LAS float* scr, int k0, int lane) {
    float wv[32];
#pragma unroll
    for (int i = 0; i < 32; ++i) { const float* wp = W + (size_t)(k0 + 2 * i + (lane >> 5)) * ldw + src0 + (lane & 31); wv[i] = STREAM_NT ? __builtin_nontemporal_load(wp) : *wp; }
    asm volatile("" : "+v"(wv[0]), "+v"(wv[1]), "+v"(wv[2]), "+v"(wv[3]), "+v"(wv[4]), "+v"(wv[5]), "+v"(wv[6]), "+v"(wv[7]), "+v"(wv[8]), "+v"(wv[9]), "+v"(wv[10]), "+v"(wv[11]), "+v"(wv[12]), "+v"(wv[13]), "+v"(wv[14]), "+v"(wv[15]),
                     "+v"(wv[16]), "+v"(wv[17]), "+v"(wv[18]), "+v"(wv[19]), "+v"(wv[20]), "+v"(wv[21]), "+v"(wv[22]), "+v"(wv[23]), "+v"(wv[24]), "+v"(wv[25]), "+v"(wv[26]), "+v"(wv[27]), "+v"(wv[28]), "+v"(wv[29]));
#pragma unroll
    for (int i = 0; i < 32; ++i) scr[(2 * i + (lane >> 5)) * 33 + (lane & 31)] = wv[i];
}
__device__ __forceinline__ void p0_weights(CArgs* ka, LAS float* scr, int lo, int hi, int gw, int ngw, int lane) {
    constexpr int I_IN = 16 * 96, I_OUT = 16 * 32, I_UP = 16 * 128, I_DN = 64 * 32, I_L = I_IN + I_OUT + I_UP + I_DN;
    unsigned char* ws = ka->ws;
    for (int it = lo + gw; it < hi; it += ngw) {
        const int l = it / I_L; int r = it - l * I_L;
        unsigned char* wl = ws + WS_W + (size_t)l * W_LAYER;
        if (r < I_IN) {
            const int kb = r / 96, nb = r % 96, k0 = 64 * kb, n0 = 32 * nb;
            const float* W = ka->in[2] + (size_t)l * DM * DIN_SRC; const float* gain = ka->in[1] + l * DM;
            if (n0 < GZ) p0_copy_item(W, DIN_SRC, n0, scr, k0, lane);
            else if (n0 < CU) {
                const float* wg = ka->in[3] + (size_t)l * 16 * 192; const int j = n0 - GZ + (lane & 31);
                float wgc[16];
#pragma unroll
                for (int q = 0; q < 16; ++q) wgc[q] = wg[q * 192 + j];
#pragma unroll 4
                for (int i = 0; i < 32; ++i) { const int kk = 2 * i + (lane >> 5); const f32x4* wr = (const f32x4*)(W + (size_t)(k0 + kk) * DIN_SRC + 1152); float s = 0.f;
#pragma unroll
                    for (int q = 0; q < 4; ++q) { const f32x4 wv = wr[q]; s += (wv[0] * wgc[4 * q] + wv[1] * wgc[4 * q + 1]) + (wv[2] * wgc[4 * q + 2] + wv[3] * wgc[4 * q + 3]); }
                    scr[kk * 33 + (lane & 31)] = s; }
            }
            else if (n0 < PEND) p0_copy_item(W, DIN_SRC, n0 - CU + 1168, scr, k0, lane);
            else {
#pragma unroll 8
                for (int i = 0; i < 32; ++i) scr[(2 * i + (lane >> 5)) * 33 + (lane & 31)] = 0.f;
            }
            p0_store_tile(scr, (bf16*)(wl + W_IN), DM, n0, k0, gain, lane);
            continue;
        }
        r -= I_IN;
        if (r < I_OUT) { const int kb = r / 32, nb = r % 32; p0_copy_item(ka->in[11] + (size_t)l * DM * DM, DM, 32 * nb, scr, 64 * kb, lane);
            p0_store_tile(scr, (bf16*)(wl + W_OUT), DM, 32 * nb, 64 * kb, kb < 6 ? ka->in[5] + l * 384 : nullptr, lane); continue; }
        r -= I_OUT;
        if (r < I_UP) { const int kb = r / 128, nb = r % 128; p0_copy_item(ka->in[13] + (size_t)l * DM * FF, FF, 32 * nb, scr, 64 * kb, lane); p0_store_tile(scr, (bf16*)(wl + W_UP), DM, 32 * nb, 64 * kb, ka->in[12] + l * DM, lane); continue; }
        r -= I_UP;
        { const int kb = r / 32, nb = r % 32; p0_copy_item(ka->in[14] + (size_t)l * FF * DM, DM, 32 * nb, scr, 64 * kb, lane); p0_store_tile(scr, (bf16*)(wl + W_DN), FF, 32 * nb, 64 * kb, nullptr, lane); }
    }
}
__device__ __forceinline__ void p0_rows(const float* x, bf16* hb, float* sspart, int gw, int ngw, int lane) {
    for (int m0 = gw; m0 < MTOK; m0 += 4 * ngw) {
        f32x4 v[4][4];
#pragma unroll
        for (int q = 0; q < 4; ++q) { int m = m0 + q * ngw; m = m < MTOK ? m : m0; const f32x4* xr = (const f32x4*)(x + (size_t)m * DM) + lane;
#pragma unroll
            for (int j = 0; j < 4; ++j) v[q][j] = STREAM_NT ? __builtin_nontemporal_load(xr + 64 * j) : xr[64 * j]; }
        asm volatile("" : "+v"(v[0][0]), "+v"(v[0][1]), "+v"(v[0][2]), "+v"(v[0][3]), "+v"(v[1][0]), "+v"(v[1][1]), "+v"(v[1][2]), "+v"(v[1][3]),
                         "+v"(v[2][0]), "+v"(v[2][1]), "+v"(v[2][2]), "+v"(v[2][3]), "+v"(v[3][0]), "+v"(v[3][1]), "+v"(v[3][2]), "+v"(v[3][3]));
#pragma unroll
        for (int q = 0; q < 4; ++q) { const int m = m0 + q * ngw; if (m < MTOK) {
            float s = 0.f;
#pragma unroll
            for (int j = 0; j < 4; ++j) s += (v[q][j][0] * v[q][j][0] + v[q][j][1] * v[q][j][1]) + (v[q][j][2] * v[q][j][2] + v[q][j][3] * v[q][j][3]);
            s = wave_sum(s);
            u32x2* o = (u32x2*)(hb + (size_t)m * DM) + lane;
#pragma unroll
            for (int j = 0; j < 4; ++j) { u32x2 w; w.x = cvtpk(v[q][j][0], v[q][j][1]); w.y = cvtpk(v[q][j][2], v[q][j][3]); o[64 * j] = w; }
            if (lane < 16) sspart[(size_t)m * 16 + lane] = s * (1.0f / 16.0f); } }
    }
}
__device__ __forceinline__ void final_rows(float* out, const bf16* hb, const float* sspart, const float* g, int gw, int ngw, int lane) {
    f32x4 gv[4];
#pragma unroll
    for (int j = 0; j < 4; ++j) gv[j] = ((const f32x4*)g)[lane + 64 * j];
    for (int m0 = gw; m0 < MTOK; m0 += 4 * ngw) {
        u32x2 v[4][4]; float ps[4];
#pragma unroll
        for (int q = 0; q < 4; ++q) { int m = m0 + q * ngw; m = m < MTOK ? m : m0; const u32x2* xr = (const u32x2*)(hb + (size_t)m * DM) + lane;
            ps[q] = lane < 16 ? sspart[(size_t)m * 16 + lane] : 0.f;
#pragma unroll
            for (int j = 0; j < 4; ++j) v[q][j] = STREAM_NT ? __builtin_nontemporal_load(xr + 64 * j) : xr[64 * j]; }
        asm volatile("" : "+v"(v[0][0]), "+v"(v[0][1]), "+v"(v[0][2]), "+v"(v[0][3]), "+v"(v[1][0]), "+v"(v[1][1]), "+v"(v[1][2]), "+v"(v[1][3]),
                         "+v"(v[2][0]), "+v"(v[2][1]), "+v"(v[2][2]), "+v"(v[2][3]), "+v"(v[3][0]), "+v"(v[3][1]), "+v"(v[3][2]), "+v"(v[3][3]), "+v"(ps[0]), "+v"(ps[1]), "+v"(ps[2]), "+v"(ps[3]));
#pragma unroll
        for (int q = 0; q < 4; ++q) { const int m = m0 + q * ngw; if (m < MTOK) {
            const float rs = __builtin_amdgcn_rsqf(wave_sum(ps[q]) * (1.0f / 1024.0f) + EPS);
            f32x4* xr = (f32x4*)(out + (size_t)m * DM) + lane;
#pragma unroll
            for (int j = 0; j < 4; ++j) { f32x4 o; o[0] = bflo(v[q][j].x); o[1] = bfhi(v[q][j].x); o[2] = bflo(v[q][j].y); o[3] = bfhi(v[q][j].y); { const f32x4 ov = o * rs * gv[j]; if (STREAM_NT) __builtin_nontemporal_store(ov, xr + 64 * j); else xr[64 * j] = ov; } } } }
    }
}

__device__ __forceinline__ void conv_item(const bf16* proj, const float* wdw, const float* bdw, const float* lng, const float* lnb, bf16* mixed, LAS unsigned char* lds, int bc, int tid, int wave, int lane) {
    asm volatile("" : "+v"(lane), "+v"(tid));
    const int c = bc & 63; const size_t tokb = (size_t)(bc >> 6) * SEQ; const int t0 = c * 64;
    LAS float* gl = (LAS float*)lds;
    const int c4 = lane * 4;
    f32x4 wr[31];
#pragma unroll
    for (int j = 0; j < 31; ++j) wr[j] = *(const f32x4*)(wdw + j * 256 + c4);
    const f32x4 bias = *(const f32x4*)(bdw + c4);
    const f32x4 g = *(const f32x4*)(lng + c4), be = *(const f32x4*)(lnb + c4);
    {
        u32x2 av[12], gv[12];
#pragma unroll
        for (int ii = 0; ii < 12; ++ii) { const int idx = tid + ii * 512, row = idx >> 6, c4 = (idx & 63) * 4; int t = t0 - 30 + row; t = t < 0 ? 0 : (row > 93 ? t0 : t);
            const bf16* p = proj + (tokb + t) * LDP + CU + c4; av[ii] = *(const u32x2*)p; gv[ii] = *(const u32x2*)(p + 256); }
        asm volatile("" : "+v"(av[0]), "+v"(av[1]), "+v"(av[2]), "+v"(av[3]), "+v"(av[4]), "+v"(av[5]), "+v"(av[6]), "+v"(av[7]), "+v"(av[8]), "+v"(av[9]), "+v"(av[10]), "+v"(av[11]),
                         "+v"(gv[0]), "+v"(gv[1]), "+v"(gv[2]), "+v"(gv[3]), "+v"(gv[4]), "+v"(gv[5]), "+v"(gv[6]), "+v"(gv[7]), "+v"(gv[8]), "+v"(gv[9]), "+v"(gv[10]), "+v"(gv[11]));
#pragma unroll
        for (int ii = 0; ii < 12; ++ii) { const int idx = tid + ii * 512, row = idx >> 6, c4 = (idx & 63) * 4, t = t0 - 30 + row;
            const u32x2 a = av[ii], g = gv[ii];
            const float a0 = bflo(a.x), a1 = bfhi(a.x), a2 = bflo(a.y), a3 = bfhi(a.y), g0 = bflo(g.x), g1 = bfhi(g.x), g2 = bflo(g.y), g3 = bfhi(g.y);
            f32x4 v; v[0] = a0 * fast_sigmoid(g0); v[1] = a1 * fast_sigmoid(g1); v[2] = a2 * fast_sigmoid(g2); v[3] = a3 * fast_sigmoid(g3);
            if (t < 0) v = (f32x4){0.f, 0.f, 0.f, 0.f};
            if (row < 94) *(LAS f32x4*)(gl + row * 256 + c4) = v; }
    }
    __syncthreads();
#pragma nounroll
    for (int tq = 0; tq < 2; ++tq) {
        f32x4 acc[4];
#pragma unroll
        for (int to = 0; to < 4; ++to) acc[to] = bias;
        const LAS float* gp = gl + (8 * wave + 4 * tq) * 256 + c4;
#pragma unroll
        for (int g0 = 0; g0 < 36; g0 += 12) {
            f32x4 x[12];
#pragma unroll
            for (int q = 0; q < 12; ++q) { const int rin = g0 + q < 34 ? g0 + q : 33; x[q] = *(const LAS f32x4*)(gp + rin * 256); }
            asm volatile("" : "+v"(x[0]), "+v"(x[1]), "+v"(x[2]), "+v"(x[3]), "+v"(x[4]), "+v"(x[5]), "+v"(x[6]), "+v"(x[7]), "+v"(x[8]), "+v"(x[9]), "+v"(x[10]), "+v"(x[11]));
#pragma unroll
            for (int q = 0; q < 12; ++q) { const int rin = g0 + q;
#pragma unroll
                for (int to = 0; to < 4; ++to) { const int j = rin - to; if (rin < 34 && j >= 0 && j <= 30) acc[to] += wr[j] * x[q]; } }
        }
#pragma unroll
        for (int to = 0; to < 4; ++to) {
            const f32x4 a = acc[to]; const float mean = wave_sum((a[0] + a[1]) + (a[2] + a[3])) * (1.0f / 256.0f);
            const f32x4 d = a - mean; const float var = wave_sum((d[0] * d[0] + d[1] * d[1]) + (d[2] * d[2] + d[3] * d[3])) * (1.0f / 256.0f);
            const float rs = __builtin_amdgcn_rsqf(var + EPS);
            f32x4 y = d * rs * g + be;
#pragma unroll
            for (int e = 0; e < 4; ++e) y[e] = y[e] * fast_sigmoid(y[e]);
            u32x2 w; w.x = cvtpk(y[0], y[1]); w.y = cvtpk(y[2], y[3]);
            *(u32x2*)(mixed + (tokb + t0 + 8 * wave + 4 * tq + to) * DM + MIX_CONV + c4) = w;
        }
    }
    __syncthreads();
}

#define GLDS16(gp, lp) __builtin_amdgcn_global_load_lds((const unsigned*)(gp), (LAS unsigned*)(lp), 16, 0, 0)
__device__ __forceinline__ void glds16_asm(const void* gsrc, unsigned lds_dst) { unsigned keep;
    asm volatile("s_mov_b32 %0, m0\n\ts_mov_b32 m0, %2\n\ts_nop 0\n\tglobal_load_lds_dwordx4 %1, off\n\ts_mov_b32 m0, %0" : "=&s"(keep) : "v"(gsrc), "s"(lds_dst) : "memory"); }
__device__ __forceinline__ void attn_unit(const bf16* proj, bf16* mixed, const LAS float* biasT, LAS unsigned char* vimg, int u, int lane) {
    asm volatile("" : "+v"(lane));
    const int half = u & 1; int t = u >> 1; const int h = t % 6; t /= 6; const int c = t & 63;
    const int r32 = lane & 31, hi = lane >> 5;
    const size_t tok0 = (size_t)t * 64;
    const int iq = 32 * half + r32;
    const bf16* qp = proj + (tok0 + iq) * LDP + AQ + h * 64 + 8 * hi;
    bf16x8 qf[4];
#pragma unroll
    for (int ks = 0; ks < 4; ++ks) qf[ks] = *(const bf16x8*)(qp + 16 * ks);
    float mrun = -1e30f, lrun = 0.f; f32x16 o0, o1;
#pragma unroll
    for (int r = 0; r < 16; ++r) { o0[r] = 0.f; o1[r] = 0.f; }
    const LAS float* bh = biasT + h * 260;
    const unsigned trb = ((lane >> 4) & 1) * 32 + (lane & 3) * 8 + (4 * hi + ((lane & 15) >> 2)) * 64;
    const float C2 = 0.125f * LOG2E;
    const int w0 = (c < 8 ? 8 - c : 0);
    const unsigned koff = (unsigned)r32 * LDP + 8u * hi;
    const unsigned vdoff = (unsigned)(8 * (lane >> 5) + ((lane & 31) >> 2)) * LDP + 8u * (lane & 3);
    bf16x8 kf[2][4];
    { const bf16* kt = proj + (tok0 - (size_t)(8 - w0) * 64) * LDP + AK + h * 64; const bf16* vt = kt + (AV - AK);
#pragma unroll
      for (int kb = 0; kb < 2; ++kb)
#pragma unroll
          for (int ks = 0; ks < 4; ++ks) kf[kb][ks] = *(const bf16x8*)(kt + (koff + (unsigned)(kb * 32 * LDP + 16 * ks)));
#pragma unroll
      for (int p = 0; p < 8; ++p) GLDS16(vt + (vdoff + (unsigned)((16 * (p & 3)) * LDP + 32 * (p >> 2))), vimg + p * 1024);
      asm volatile("" ::: "memory"); }
    int buf = 0;
    for (int w = w0; w <= 8; ++w) {
        bf16x8 kn[2][4];
        { const int wn = w < 8 ? w + 1 : 8;
          const bf16* kt = proj + (tok0 - (size_t)(8 - wn) * 64) * LDP + AK + h * 64; const bf16* vt = kt + (AV - AK);
          LAS unsigned char* vb = vimg + (buf ^ 1) * 8192;
          LDS_FENCE();
#pragma unroll
          for (int kb = 0; kb < 2; ++kb)
#pragma unroll
              for (int ks = 0; ks < 4; ++ks) kn[kb][ks] = *(const bf16x8*)(kt + (koff + (unsigned)(kb * 32 * LDP + 16 * ks)));
#pragma unroll
          for (int p = 0; p < 8; ++p) GLDS16(vt + (vdoff + (unsigned)((16 * (p & 3)) * LDP + 32 * (p >> 2))), vb + p * 1024);
          asm volatile("" ::: "memory"); }
        f32x16 s0, s1;
#pragma unroll
        for (int r = 0; r < 16; ++r) { s0[r] = 0.f; s1[r] = 0.f; }
#pragma unroll
        for (int ks = 0; ks < 4; ++ks) { s0 = MFMA32(kf[0][ks], qf[ks], s0); s1 = MFMA32(kf[1][ks], qf[ks], s1); }
        const int relb = (8 - w) * 64 + iq;
        float tm = -1e30f;
        if (w <= 5) {
            const float bc = bh[256];
#pragma unroll
            for (int r = 0; r < 16; ++r) { s0[r] = s0[r] * C2 + bc; s1[r] = s1[r] * C2 + bc; tm = fmaxf(tm, fmaxf(s0[r], s1[r])); }
        } else {
            float bv0[16], bv1[16];
#pragma unroll
            for (int r = 0; r < 16; ++r) { const int j0 = crow(r, hi); int i0 = relb - j0, i1 = relb - j0 - 32; i0 = (i0 > 128 ? 128 : i0) + 128; i1 = (i1 > 128 ? 128 : i1) + 128;
                bv0[r] = bh[i0]; bv1[r] = bh[i1]; }
            LDS_FENCE();
#pragma unroll
            for (int r = 0; r < 16; ++r) { s0[r] = s0[r] * C2 + bv0[r]; s1[r] = s1[r] * C2 + bv1[r]; tm = fmaxf(tm, fmaxf(s0[r], s1[r])); }
        }
        tm = fmaxf(tm, __shfl_xor(tm, 32));
        const float mn = fmaxf(mrun, tm); const float sc = __builtin_amdgcn_exp2f(mrun - mn); mrun = mn;
        float ps = 0.f;
#pragma unroll
        for (int r = 0; r < 16; ++r) { s0[r] = __builtin_amdgcn_exp2f(s0[r] - mn); s1[r] = __builtin_amdgcn_exp2f(s1[r] - mn); ps += s0[r] + s1[r]; o0[r] *= sc; o1[r] *= sc; }
        lrun = lrun * sc + ps;
        bf16x8 pf[2][2];
#pragma unroll
        for (int s2 = 0; s2 < 2; ++s2) {
            u32x4 a, b;
            a.x = cvtpk(s0[8 * s2 + 0], s0[8 * s2 + 1]); a.y = cvtpk(s0[8 * s2 + 2], s0[8 * s2 + 3]); a.z = cvtpk(s0[8 * s2 + 4], s0[8 * s2 + 5]); a.w = cvtpk(s0[8 * s2 + 6], s0[8 * s2 + 7]);
            b.x = cvtpk(s1[8 * s2 + 0], s1[8 * s2 + 1]); b.y = cvtpk(s1[8 * s2 + 2], s1[8 * s2 + 3]); b.z = cvtpk(s1[8 * s2 + 4], s1[8 * s2 + 5]); b.w = cvtpk(s1[8 * s2 + 6], s1[8 * s2 + 7]);
            pf[0][s2] = __builtin_bit_cast(bf16x8, a); pf[1][s2] = __builtin_bit_cast(bf16x8, b);
        }
        asm volatile("s_waitcnt vmcnt(16)" ::: "memory");
        const LAS unsigned char* vc = vimg + buf * 8192;
#pragma unroll
        for (int kb = 0; kb < 2; ++kb)
#pragma unroll
            for (int s2 = 0; s2 < 2; ++s2) {
                const unsigned off = (4 * kb + 2 * s2) * 512 + trb;
                const bf16x8 v0 = cat8(trrd(vc + off), trrd(vc + off + 512));
                const bf16x8 v1 = cat8(trrd(vc + 4096 + off), trrd(vc + 4096 + off + 512));
                o0 = MFMA32(v0, pf[kb][s2], o0); o1 = MFMA32(v1, pf[kb][s2], o1);
            }
#pragma unroll
        for (int kb = 0; kb < 2; ++kb)
#pragma unroll
            for (int ks = 0; ks < 4; ++ks) kf[kb][ks] = kn[kb][ks];
        buf ^= 1;
    }
    lrun += __shfl_xor(lrun, 32);
    const float inv = 1.0f / lrun;
    bf16* op = mixed + (tok0 + iq) * DM + MIX_ATT + h * 64 + 4 * hi;
#pragma unroll
    for (int rg = 0; rg < 4; ++rg) {
        u32x2 w0v, w1v;
        w0v.x = cvtpk(o0[4 * rg] * inv, o0[4 * rg + 1] * inv); w0v.y = cvtpk(o0[4 * rg + 2] * inv, o0[4 * rg + 3] * inv);
        w1v.x = cvtpk(o1[4 * rg] * inv, o1[4 * rg + 1] * inv); w1v.y = cvtpk(o1[4 * rg + 2] * inv, o1[4 * rg + 3] * inv);
        *(u32x2*)(op + 8 * rg) = w0v; *(u32x2*)(op + 32 + 8 * rg) = w1v;
    }
    asm volatile("s_waitcnt vmcnt(0) lgkmcnt(0)" ::: "memory");
}

__device__ __forceinline__ void attn_block_unit(const bf16* proj, bf16* mixed, const LAS float* biasT, LAS unsigned char* ring, int u, int wave, int lane) {
    asm volatile("" : "+v"(lane));
    const int h = u % 6; const int bg = u / 6; const int g = bg & 15, b = bg >> 4;
    const int qc = wave >> 1, half = wave & 1;
    const int r32 = lane & 31, hi = lane >> 5;
    const size_t tokg = (size_t)b * SEQ + (size_t)g * 256;
    const int tlo = (g < 2) ? 8 - 4 * g : 0;
    const int ntile = 12 - tlo;
    const unsigned kdo = (unsigned)(32 * (wave >> 2) + r32) * LDP + 16u * (wave & 3) + 8u * hi;
    const unsigned vdo = (unsigned)(16 * (wave & 3) + 8 * hi + (r32 >> 2)) * LDP + 32u * (wave >> 2) + 8u * (lane & 3) + (unsigned)(AV - AK);
#define ATT_ISSUE(t_, st_) do { const bf16* kt_ = proj + (tokg + (size_t)(t_) * 64 - 512) * LDP + AK + h * 64; \
        glds16_asm(kt_ + kdo, (unsigned)__builtin_amdgcn_readfirstlane((int)(ring0 + (unsigned)((st_) * 16384 + wave * 1024)))); \
        glds16_asm(kt_ + vdo, (unsigned)__builtin_amdgcn_readfirstlane((int)(ring0 + (unsigned)((st_) * 16384 + 8192 + wave * 1024)))); } while (0)
    const unsigned ring0 = (unsigned)(uintptr_t)ring;
    const int iq = 32 * half + r32;
    const bf16* qp = proj + (tokg + qc * 64 + iq) * LDP + AQ + h * 64 + 8 * hi;
    bf16x8 qf[4];
#pragma unroll
    for (int ks = 0; ks < 4; ++ks) qf[ks] = *(const bf16x8*)(qp + 16 * ks);
    asm volatile("" ::: "memory");
    { const float C2q = 0.125f * LOG2E;
#pragma unroll
      for (int ks = 0; ks < 4; ++ks) { u32x4 q4 = __builtin_bit_cast(u32x4, qf[ks]);
#pragma unroll
          for (int e = 0; e < 4; ++e) q4[e] = cvtpk(bflo(q4[e]) * C2q, bfhi(q4[e]) * C2q);
          qf[ks] = __builtin_bit_cast(bf16x8, q4); } }
    ATT_ISSUE(tlo, 0); ATT_ISSUE(tlo + 1, 1); ATT_ISSUE(tlo + 2, 2);
    asm volatile("" ::: "memory");
    float mrun = -1e30f, lrun = 0.f; f32x16 o0, o1;
#pragma unroll
    for (int r = 0; r < 16; ++r) { o0[r] = 0.f; o1[r] = 0.f; }
    const LAS float* bh = biasT + h * 260;
    const unsigned trb = ((lane >> 4) & 1) * 32 + (lane & 3) * 8 + (4 * hi + ((lane & 15) >> 2)) * 64;
    for (int j = 0; j < ntile; ++j) {
        const int left = ntile - 1 - j;
        if (left >= 2) asm volatile("s_waitcnt vmcnt(4) lgkmcnt(0)\n\ts_barrier" ::: "memory");
        else if (left == 1) asm volatile("s_waitcnt vmcnt(2) lgkmcnt(0)\n\ts_barrier" ::: "memory");
        else asm volatile("s_waitcnt vmcnt(0) lgkmcnt(0)\n\ts_barrier" ::: "memory");
        if (j + 3 < ntile) { ATT_ISSUE(tlo + j + 3, (j + 3) & 3); }
        asm volatile("" ::: "memory");
        const int w = tlo + j - qc;
        if (w >= 0 && w <= 8) {
            const LAS unsigned char* kc = ring + (j & 3) * 16384; const LAS unsigned char* vc = kc + 8192;
            bf16x8 kf[2][4];
#pragma unroll
            for (int kb = 0; kb < 2; ++kb)
#pragma unroll
                for (int ks = 0; ks < 4; ++ks) kf[kb][ks] = *(const LAS bf16x8*)(kc + (kb * 4 + ks) * 1024 + 16 * lane);
            f32x16 s0, s1;
#pragma unroll
            for (int r = 0; r < 16; ++r) { s0[r] = 0.f; s1[r] = 0.f; }
#pragma unroll
            for (int ks = 0; ks < 4; ++ks) { s0 = MFMA32(kf[0][ks], qf[ks], s0); s1 = MFMA32(kf[1][ks], qf[ks], s1); }
            const int relb = (8 - w) * 64 + iq;
            float tm = -1e30f, boff = 0.f;
            if (w <= 5) {
                boff = bh[256];
#pragma unroll
                for (int r = 0; r < 16; ++r) tm = fmaxf(tm, fmaxf(s0[r], s1[r]));
                tm += boff;
            } else {
                float bv0[16], bv1[16];
#pragma unroll
                for (int r = 0; r < 16; ++r) { const int j0 = crow(r, hi); int i0 = relb - j0, i1 = relb - j0 - 32; i0 = (i0 > 128 ? 128 : i0) + 128; i1 = (i1 > 128 ? 128 : i1) + 128;
                    bv0[r] = bh[i0]; bv1[r] = bh[i1]; }
#pragma unroll
                for (int r = 0; r < 16; ++r) { s0[r] += bv0[r]; s1[r] += bv1[r]; tm = fmaxf(tm, fmaxf(s0[r], s1[r])); }
            }
            tm = fmaxf(tm, __shfl_xor(tm, 32));
            if (__any(tm > mrun + 8.0f)) {
                const float mn = fmaxf(mrun, tm); const float sc = __builtin_amdgcn_exp2f(mrun - mn); mrun = mn; lrun *= sc;
#pragma unroll
                for (int r = 0; r < 16; ++r) { o0[r] *= sc; o1[r] *= sc; }
            }
            const float sub = mrun - boff;
            float ps = 0.f;
#pragma unroll
            for (int r = 0; r < 16; ++r) { s0[r] = __builtin_amdgcn_exp2f(s0[r] - sub); s1[r] = __builtin_amdgcn_exp2f(s1[r] - sub); ps += s0[r] + s1[r]; }
            lrun += ps;
            bf16x8 pf[2][2];
#pragma unroll
            for (int s2 = 0; s2 < 2; ++s2) {
                u32x4 a, bb;
                a.x = cvtpk(s0[8 * s2 + 0], s0[8 * s2 + 1]); a.y = cvtpk(s0[8 * s2 + 2], s0[8 * s2 + 3]); a.z = cvtpk(s0[8 * s2 + 4], s0[8 * s2 + 5]); a.w = cvtpk(s0[8 * s2 + 6], s0[8 * s2 + 7]);
                bb.x = cvtpk(s1[8 * s2 + 0], s1[8 * s2 + 1]); bb.y = cvtpk(s1[8 * s2 + 2], s1[8 * s2 + 3]); bb.z = cvtpk(s1[8 * s2 + 4], s1[8 * s2 + 5]); bb.w = cvtpk(s1[8 * s2 + 6], s1[8 * s2 + 7]);
                pf[0][s2] = __builtin_bit_cast(bf16x8, a); pf[1][s2] = __builtin_bit_cast(bf16x8, bb);
            }
#pragma unroll
            for (int kb = 0; kb < 2; ++kb)
#pragma unroll
                for (int s2 = 0; s2 < 2; ++s2) {
                    const unsigned off = (4 * kb + 2 * s2) * 512 + trb;
                    const bf16x8 v0 = cat8(trrd(vc + off), trrd(vc + off + 512));
                    const bf16x8 v1 = cat8(trrd(vc + 4096 + off), trrd(vc + 4096 + off + 512));
                    o0 = MFMA32(v0, pf[kb][s2], o0); o1 = MFMA32(v1, pf[kb][s2], o1);
                }
        }
    }
#undef ATT_ISSUE
    lrun += __shfl_xor(lrun, 32);
    const float inv = 1.0f / lrun;
    bf16* op = mixed + (tokg + qc * 64 + iq) * DM + MIX_ATT + h * 64 + 4 * hi;
#pragma unroll
    for (int rg = 0; rg < 4; ++rg) {
        u32x2 w0v, w1v;
        w0v.x = cvtpk(o0[4 * rg] * inv, o0[4 * rg + 1] * inv); w0v.y = cvtpk(o0[4 * rg + 2] * inv, o0[4 * rg + 3] * inv);
        w1v.x = cvtpk(o1[4 * rg] * inv, o1[4 * rg + 1] * inv); w1v.y = cvtpk(o1[4 * rg + 2] * inv, o1[4 * rg + 3] * inv);
        *(u32x2*)(op + 8 * rg) = w0v; *(u32x2*)(op + 32 + 8 * rg) = w1v;
    }
    asm volatile("s_waitcnt lgkmcnt(0)\n\ts_barrier" ::: "memory");
}

__device__ __forceinline__ void attn_pair_unit(const bf16* proj, bf16* mixed, const LAS float* biasT, LAS unsigned char* ring, int u, int wave, int lane) {
    asm volatile("" : "+v"(lane));
    const int hp = u % 3; const int bg = u / 3; const int g2 = bg & 31, b = bg >> 5;
    const int sub = wave >> 2, w4 = wave & 3; const int h = 2 * hp + sub;
    const int qc = w4 >> 1, half = w4 & 1;
    const int r32 = lane & 31, hi = lane >> 5;
    const size_t tokg = (size_t)b * SEQ + (size_t)g2 * 128;
    const int tlo = (g2 < 4) ? 8 - 2 * g2 : 0;
    const int ntile = 10 - tlo;
    LAS unsigned char* ringS = ring + sub * 65536;
    unsigned kdo[2], vdo[2];
#pragma unroll
    for (int q = 0; q < 2; ++q) { const int p = 2 * w4 + q;
        kdo[q] = (unsigned)(32 * (p >> 2) + r32) * LDP + 16u * (p & 3) + 8u * hi;
        vdo[q] = (unsigned)(16 * (p & 3) + 8 * hi + (r32 >> 2)) * LDP + 32u * (p >> 2) + 8u * (lane & 3) + (unsigned)(AV - AK); }
#define ATT_ISSUE(t_, st_) do { const bf16* kt_ = proj + (tokg + (size_t)(t_) * 64 - 512) * LDP + AK + h * 64; \
        _Pragma("unroll") for (int q_ = 0; q_ < 2; ++q_) { \
        glds16_asm(kt_ + kdo[q_], (unsigned)__builtin_amdgcn_readfirstlane((int)(ring0 + (unsigned)((st_) * 16384 + (2 * w4 + q_) * 1024)))); \
        glds16_asm(kt_ + vdo[q_], (unsigned)__builtin_amdgcn_readfirstlane((int)(ring0 + (unsigned)((st_) * 16384 + 8192 + (2 * w4 + q_) * 1024)))); } } while (0)
    const unsigned ring0 = (unsigned)(uintptr_t)ringS;
    const int iq = 32 * half + r32;
    const bf16* qp = proj + (tokg + qc * 64 + iq) * LDP + AQ + h * 64 + 8 * hi;
    bf16x8 qf[4];
#pragma unroll
    for (int ks = 0; ks < 4; ++ks) qf[ks] = *(const bf16x8*)(qp + 16 * ks);
    asm volatile("" ::: "memory");
    { const float C2q = 0.125f * LOG2E;
#pragma unroll
      for (int ks = 0; ks < 4; ++ks) { u32x4 q4 = __builtin_bit_cast(u32x4, qf[ks]);
#pragma unroll
          for (int e = 0; e < 4; ++e) q4[e] = cvtpk(bflo(q4[e]) * C2q, bfhi(q4[e]) * C2q);
          qf[ks] = __builtin_bit_cast(bf16x8, q4); } }
    ATT_ISSUE(tlo, 0); ATT_ISSUE(tlo + 1, 1); if (ntile > 2) { ATT_ISSUE(tlo + 2, 2); }
    asm volatile("" ::: "memory");
    float mrun = -1e30f, lrun = 0.f; f32x16 o0, o1;
#pragma unroll
    for (int r = 0; r < 16; ++r) { o0[r] = 0.f; o1[r] = 0.f; }
    const LAS float* bh = biasT + h * 260;
    const unsigned trb = ((lane >> 4) & 1) * 32 + (lane & 3) * 8 + (4 * hi + ((lane & 15) >> 2)) * 64;
    for (int j = 0; j < ntile; ++j) {
        const int left = ntile - 1 - j;
        if (left >= 2) asm volatile("s_waitcnt vmcnt(8) lgkmcnt(0)\n\ts_barrier" ::: "memory");
        else if (left == 1) asm volatile("s_waitcnt vmcnt(4) lgkmcnt(0)\n\ts_barrier" ::: "memory");
        else asm volatile("s_waitcnt vmcnt(0) lgkmcnt(0)\n\ts_barrier" ::: "memory");
        if (j + 3 < ntile) { ATT_ISSUE(tlo + j + 3, (j + 3) & 3); }
        asm volatile("" ::: "memory");
        const int w = tlo + j - qc;
        if (w >= 0 && w <= 8) {
#if ATT_IGLP >= 0
            __builtin_amdgcn_iglp_opt(ATT_IGLP);
#endif
            const LAS unsigned char* kc = ringS + (j & 3) * 16384; const LAS unsigned char* vc = kc + 8192;
            bf16x8 kf[2][4];
#pragma unroll
            for (int kb = 0; kb < 2; ++kb)
#pragma unroll
                for (int ks = 0; ks < 4; ++ks) kf[kb][ks] = *(const LAS bf16x8*)(kc + (kb * 4 + ks) * 1024 + 16 * lane);
            f32x16 s0, s1;
#pragma unroll
            for (int r = 0; r < 16; ++r) { s0[r] = 0.f; s1[r] = 0.f; }
            __builtin_amdgcn_s_setprio(1);
#pragma unroll
            for (int ks = 0; ks < 4; ++ks) { s0 = MFMA32(kf[0][ks], qf[ks], s0); s1 = MFMA32(kf[1][ks], qf[ks], s1); }
            __builtin_amdgcn_s_setprio(0);
            bf16x8 vf[2][2][2];
#pragma unroll
            for (int kb = 0; kb < 2; ++kb)
#pragma unroll
                for (int s2 = 0; s2 < 2; ++s2) { const unsigned off = (4 * kb + 2 * s2) * 512 + trb;
                    vf[kb][s2][0] = cat8(trrd(vc + off), trrd(vc + off + 512)); vf[kb][s2][1] = cat8(trrd(vc + 4096 + off), trrd(vc + 4096 + off + 512)); }
            asm volatile("" ::: "memory");
            const int relb = (8 - w) * 64 + iq;
            float tm = -1e30f, boff = 0.f;
            if (w <= 5) {
                boff = bh[256];
#pragma unroll
                for (int r = 0; r < 16; ++r) tm = fmaxf(tm, fmaxf(s0[r], s1[r]));
                tm += boff;
            } else {
                float bv0[16], bv1[16];
#pragma unroll
                for (int r = 0; r < 16; ++r) { const int j0 = crow(r, hi); int i0 = relb - j0, i1 = relb - j0 - 32; i0 = (i0 > 128 ? 128 : i0) + 128; i1 = (i1 > 128 ? 128 : i1) + 128;
                    bv0[r] = bh[i0]; bv1[r] = bh[i1]; }
#pragma unroll
                for (int r = 0; r < 16; ++r) { s0[r] += bv0[r]; s1[r] += bv1[r]; tm = fmaxf(tm, fmaxf(s0[r], s1[r])); }
            }
            { auto rr = __builtin_amdgcn_permlane32_swap(__float_as_uint(tm), __float_as_uint(tm), false, false); tm = fmaxf(__uint_as_float(rr[0]), __uint_as_float(rr[1])); }
            if (__any(tm > mrun + 8.0f)) {
                const float mn = fmaxf(mrun, tm); const float sc = __builtin_amdgcn_exp2f(mrun - mn); mrun = mn; lrun *= sc;
#pragma unroll
                for (int r = 0; r < 16; ++r) { o0[r] *= sc; o1[r] *= sc; }
            }
            const float sub = mrun - boff;
            float ps = 0.f;
#pragma unroll
            for (int r = 0; r < 16; ++r) { s0[r] = __builtin_amdgcn_exp2f(s0[r] - sub); s1[r] = __builtin_amdgcn_exp2f(s1[r] - sub); ps += s0[r] + s1[r]; }
            lrun += ps;
            bf16x8 pf[2][2];
#pragma unroll
            for (int s2 = 0; s2 < 2; ++s2) {
                u32x4 a, bb;
                a.x = cvtpk(s0[8 * s2 + 0], s0[8 * s2 + 1]); a.y = cvtpk(s0[8 * s2 + 2], s0[8 * s2 + 3]); a.z = cvtpk(s0[8 * s2 + 4], s0[8 * s2 + 5]); a.w = cvtpk(s0[8 * s2 + 6], s0[8 * s2 + 7]);
                bb.x = cvtpk(s1[8 * s2 + 0], s1[8 * s2 + 1]); bb.y = cvtpk(s1[8 * s2 + 2], s1[8 * s2 + 3]); bb.z = cvtpk(s1[8 * s2 + 4], s1[8 * s2 + 5]); bb.w = cvtpk(s1[8 * s2 + 6], s1[8 * s2 + 7]);
                pf[0][s2] = __builtin_bit_cast(bf16x8, a); pf[1][s2] = __builtin_bit_cast(bf16x8, bb);
            }
#pragma unroll
            for (int kb = 0; kb < 2; ++kb)
#pragma unroll
                for (int s2 = 0; s2 < 2; ++s2) {
                    o0 = MFMA32(vf[kb][s2][0], pf[kb][s2], o0); o1 = MFMA32(vf[kb][s2][1], pf[kb][s2], o1);
                }
        }
    }
#undef ATT_ISSUE
    lrun += __shfl_xor(lrun, 32);
    const float inv = 1.0f / lrun;
    bf16* op = mixed + (tokg + qc * 64 + iq) * DM + MIX_ATT + h * 64 + 4 * hi;
#pragma unroll
    for (int rg = 0; rg < 4; ++rg) {
        u32x2 w0v, w1v;
        w0v.x = cvtpk(o0[4 * rg] * inv, o0[4 * rg + 1] * inv); w0v.y = cvtpk(o0[4 * rg + 2] * inv, o0[4 * rg + 3] * inv);
        w1v.x = cvtpk(o1[4 * rg] * inv, o1[4 * rg + 1] * inv); w1v.y = cvtpk(o1[4 * rg + 2] * inv, o1[4 * rg + 3] * inv);
        *(u32x2*)(op + 8 * rg) = w0v; *(u32x2*)(op + 32 + 8 * rg) = w1v;
    }
    asm volatile("s_waitcnt lgkmcnt(0)\n\ts_barrier" ::: "memory");
}

__device__ __forceinline__ void gla_kv_item(const bf16* proj, const float* bgate, float* kvT, float* decay, LAS unsigned char* vimg, int it, int lane) {
    asm volatile("" : "+v"(lane));
    const int h = it & 3; const size_t tok0 = (size_t)(it >> 2) * 64;
    const int r32 = lane & 31, hi = lane >> 5;
    LDS_FENCE();
    {
        const int kc = lane < 48 ? lane : 47;
        const bf16* zp = proj + tok0 * LDP + GZ + h * 48 + kc; const bf16* kp = proj + tok0 * LDP + GK + h * 48 + kc;
        const float bz = bgate[h * 48 + kc];
        float suf = 0.f;
#pragma unroll
        for (int hb2 = 1; hb2 >= 0; --hb2) {
            bf16 zr[32], kr[32];
#pragma unroll
            for (int i = 0; i < 32; ++i) { zr[i] = zp[(size_t)(32 * hb2 + i) * LDP]; kr[i] = kp[(size_t)(32 * hb2 + i) * LDP]; }
            asm volatile("" ::: "memory");
#pragma unroll
            for (int i = 31; i >= 0; --i) { const int t = 32 * hb2 + i;
                const float z = bf2f(zr[i]) + bz, kk = bf2f(kr[i]);
                const float la = (fminf(z, 0.f) - __logf(1.f + __expf(-fabsf(z)))) * (1.0f / 16.0f);
                const float kd = kk * __expf(suf); suf += la;
                *(LAS bf16*)(vimg + lane * 144 + t * 2) = (bf16)(cvtpk(kd, 0.f) & 0xffffu); }
        }
        if (lane < 48) decay[(size_t)it * 48 + kc] = __expf(suf);
    }
    LDS_FENCE();
    bf16x8 kfr[2][4];
#pragma unroll
    for (int kb = 0; kb < 2; ++kb)
#pragma unroll
        for (int s = 0; s < 4; ++s) { const int kc = 32 * kb + r32; const int kcc = kc < 48 ? kc : 47;
            u32x4 a = *(const LAS u32x4*)(vimg + kcc * 144 + (16 * s + 8 * hi) * 2);
            if (kc >= 48) a = (u32x4){0u, 0u, 0u, 0u};
            kfr[kb][s] = __builtin_bit_cast(bf16x8, a); }
    LDS_FENCE();
    { u32x4 val[12];
#pragma unroll
      for (int i = 0; i < 12; ++i) { const int id = i * 64 + lane, t = id / 12, ch = id - 12 * t; val[i] = *(const u32x4*)(proj + (tok0 + t) * LDP + GV + h * 96 + 8 * ch); }
      asm volatile("" : "+v"(val[0]), "+v"(val[1]), "+v"(val[2]), "+v"(val[3]), "+v"(val[4]), "+v"(val[5]), "+v"(val[6]), "+v"(val[7]), "+v"(val[8]), "+v"(val[9]), "+v"(val[10]), "+v"(val[11]));
#pragma unroll
      for (int i = 0; i < 12; ++i) { const int id = i * 64 + lane, t = id / 12, ch = id - 12 * t; *(LAS u32x4*)(vimg + (ch >> 2) * 4096 + (t >> 3) * 512 + (t & 7) * 64 + (ch & 3) * 16) = val[i]; } }
    f32x16 acc[3][2];
#pragma unroll
    for (int vb = 0; vb < 3; ++vb)
#pragma unroll
        for (int kb = 0; kb < 2; ++kb)
#pragma unroll
            for (int r = 0; r < 16; ++r) acc[vb][kb][r] = 0.f;
    LDS_FENCE();
    const unsigned trb = ((lane >> 4) & 1) * 32 + (lane & 3) * 8 + ((lane & 15) >> 2) * 64 + hi * 512;
#pragma unroll
    for (int s = 0; s < 4; ++s)
#pragma unroll
        for (int vb = 0; vb < 3; ++vb) { const unsigned off = vb * 4096 + (2 * s) * 512 + trb;
            const bf16x8 vf = cat8(trrd(vimg + off), trrd(vimg + off + 256));
            acc[vb][0] = MFMA32(vf, kfr[0][s], acc[vb][0]); acc[vb][1] = MFMA32(vf, kfr[1][s], acc[vb][1]); }
    float* dst = kvT + (size_t)it * 4608;
#pragma unroll
    for (int vb = 0; vb < 3; ++vb)
#pragma unroll
        for (int r = 0; r < 16; ++r) { const int v = 32 * vb + crow(r, hi);
            dst[v * 48 + r32] = acc[vb][0][r];
            if (r32 < 16) dst[v * 48 + 32 + r32] = acc[vb][1][r]; }
    LDS_FENCE();
}
__device__ __forceinline__ void gla_scan(const float* kvT, const float* decay, bf16* St, int gtid, int nthr) {
    for (int e = gtid; e < 32 * 4608; e += nthr) {
        const int bh = e / 4608, rem = e - bh * 4608, k = rem % 48, b = bh >> 2, h = bh & 3;
        float st = 0.f;
#pragma nounroll
        for (int c0 = 0; c0 < 64; c0 += 16) {
            float kv[16], dc[16];
#pragma unroll
            for (int j = 0; j < 16; ++j) { const size_t it = (size_t)(((b * 64 + c0 + j) << 2) + h); kv[j] = STREAM_NT ? __builtin_nontemporal_load(kvT + it * 4608 + rem) : kvT[it * 4608 + rem]; dc[j] = decay[it * 48 + k]; }
            asm volatile("" : "+v"(kv[0]), "+v"(kv[1]), "+v"(kv[2]), "+v"(kv[3]), "+v"(kv[4]), "+v"(kv[5]), "+v"(kv[6]), "+v"(kv[7]), "+v"(kv[8]), "+v"(kv[9]), "+v"(kv[10]), "+v"(kv[11]), "+v"(kv[12]), "+v"(kv[13]), "+v"(kv[14]), "+v"(kv[15]),
                             "+v"(dc[0]), "+v"(dc[1]), "+v"(dc[2]), "+v"(dc[3]), "+v"(dc[4]), "+v"(dc[5]), "+v"(dc[6]), "+v"(dc[7]), "+v"(dc[8]), "+v"(dc[9]), "+v"(dc[10]), "+v"(dc[11]), "+v"(dc[12]), "+v"(dc[13]));
#pragma unroll
            for (int j = 0; j < 16; ++j) { const size_t it = (size_t)(((b * 64 + c0 + j) << 2) + h); st = dc[j] * st + kv[j]; St[it * 4608 + rem] = (bf16)(cvtpk(st, 0.f) & 0xffffu); }
        }
    }
}
__device__ __forceinline__ void gla_out_item(const bf16* proj, const bf16* St, bf16* mixed, int it, int lane) {
    asm volatile("" : "+v"(lane));
    const int h = it & 3; const size_t tok0 = (size_t)(it >> 2) * 64;
    const int r32 = lane & 31, hi = lane >> 5;
    bf16x8 af[3][3], bq[2][3]; u32x2 gg[2][3][4];
#pragma unroll
    for (int vb = 0; vb < 3; ++vb)
#pragma unroll
        for (int ks = 0; ks < 3; ++ks) af[vb][ks] = *(const bf16x8*)(St + (size_t)it * 4608 + (32 * vb + r32) * 48 + 16 * ks + 8 * hi);
#pragma unroll
    for (int tb = 0; tb < 2; ++tb)
#pragma unroll
        for (int ks = 0; ks < 3; ++ks) bq[tb][ks] = *(const bf16x8*)(proj + (tok0 + 32 * tb + r32) * LDP + GQ + h * 48 + 16 * ks + 8 * hi);
#pragma unroll
    for (int tb = 0; tb < 2; ++tb)
#pragma unroll
        for (int vb = 0; vb < 3; ++vb)
#pragma unroll
            for (int rg = 0; rg < 4; ++rg) gg[tb][vb][rg] = *(const u32x2*)(proj + (tok0 + 32 * tb + r32) * LDP + GG + h * 96 + 32 * vb + 8 * rg + 4 * hi);
    asm volatile("" : "+v"(af[0][0]), "+v"(af[0][1]), "+v"(af[0][2]), "+v"(af[1][0]), "+v"(af[1][1]), "+v"(af[1][2]), "+v"(af[2][0]), "+v"(af[2][1]), "+v"(af[2][2]),
                     "+v"(bq[0][0]), "+v"(bq[0][1]), "+v"(bq[0][2]), "+v"(bq[1][0]), "+v"(bq[1][1]), "+v"(bq[1][2]));
    f32x16 acc[3][2];
#pragma unroll
    for (int vb = 0; vb < 3; ++vb)
#pragma unroll
        for (int tb = 0; tb < 2; ++tb)
#pragma unroll
            for (int r = 0; r < 16; ++r) acc[vb][tb][r] = 0.f;
#pragma unroll
    for (int ks = 0; ks < 3; ++ks)
#pragma unroll
        for (int vb = 0; vb < 3; ++vb)
#pragma unroll
            for (int tb = 0; tb < 2; ++tb) acc[vb][tb] = MFMA32(af[vb][ks], bq[tb][ks], acc[vb][tb]);
    const float QS = 0.14433756729740643f;
#pragma unroll
    for (int tb = 0; tb < 2; ++tb) {
        float ss = 0.f;
#pragma unroll
        for (int vb = 0; vb < 3; ++vb)
#pragma unroll
            for (int r = 0; r < 16; ++r) { const float x = acc[vb][tb][r] * QS; acc[vb][tb][r] = x; ss += x * x; }
        ss += __shfl_xor(ss, 32);
        const float rn = __builtin_amdgcn_rsqf(ss * (1.0f / 96.0f) + EPS);
        const size_t tok = tok0 + 32 * tb + r32;
#pragma unroll
        for (int vb = 0; vb < 3; ++vb)
#pragma unroll
            for (int rg = 0; rg < 4; ++rg) { const int v0 = 32 * vb + 8 * rg + 4 * hi; const u32x2 g = gg[tb][vb][rg];
                const float g0 = bflo(g.x), g1 = bfhi(g.x), g2 = bflo(g.y), g3 = bfhi(g.y);
                const float y0 = acc[vb][tb][4 * rg + 0] * rn * (g0 * fast_sigmoid(g0));
                const float y1 = acc[vb][tb][4 * rg + 1] * rn * (g1 * fast_sigmoid(g1));
                const float y2 = acc[vb][tb][4 * rg + 2] * rn * (g2 * fast_sigmoid(g2));
                const float y3 = acc[vb][tb][4 * rg + 3] * rn * (g3 * fast_sigmoid(g3));
                u32x2 w; w.x = cvtpk(y0, y1); w.y = cvtpk(y2, y3);
                *(u32x2*)(mixed + tok * DM + MIX_GLA + h * 96 + v0) = w; }
    }
}
#define XB_TMO      128
#define XB_XCNT(j)  (256  + 64 * (j))
#define XB_XSUB(j)  (1280 + 64 * (j))
#define XB_XGEN(j)  (2304 + 64 * (j))
#define XB_TOP      3328
#define XB_TOPGEN   3392
#define XCD_BAR_WORDS 3456
#define XB_SPIN_CAP (1u << 18)

__device__ __forceinline__ unsigned xb_ld(unsigned* p)              { return __hip_atomic_load(p, __ATOMIC_RELAXED, __HIP_MEMORY_SCOPE_AGENT); }
__device__ __forceinline__ unsigned xb_add(unsigned* p, unsigned v) { return __hip_atomic_fetch_add(p, v, __ATOMIC_RELAXED, __HIP_MEMORY_SCOPE_AGENT); }
__device__ __forceinline__ unsigned xb_xcc_id() { return (unsigned)__builtin_amdgcn_s_getreg((3 << 11) | 20) & 0xFu; }
#define XB_SPIN(cond, bar) do { unsigned _sp = 0; while (cond) { __builtin_amdgcn_s_sleep(1); \
    if ((++_sp & 255u) == 0u) { if (xb_ld(&(bar)[XB_TMO])) break; if (_sp > XB_SPIN_CAP) { atomicAdd(&(bar)[XB_TMO], 1u); break; } } } } while (0)

struct XcdBarrier {
    unsigned* bar; unsigned x;
    volatile LAS unsigned* st;
};

__device__ __forceinline__ XcdBarrier xcd_barrier_post(unsigned* bar, volatile LAS unsigned* st) {
    XcdBarrier b; b.bar = bar; b.x = xb_xcc_id(); b.st = st;
    if (threadIdx.x == 0) (void)xb_add(&bar[XB_XCNT(b.x)], 1u);
    return b;
}
__device__ __forceinline__ void xcd_barrier_complete(unsigned* bar, unsigned x, unsigned& nloc, unsigned& nx) {
    const unsigned G = gridDim.x * gridDim.y * gridDim.z;
    unsigned sum, cnt, mine, sp = 0u;
    for (;;) {
        sum = 0u; cnt = 0u; mine = 0u;
#pragma unroll
        for (unsigned j = 0; j < 16; ++j) { const unsigned c = xb_ld(&bar[XB_XCNT(j)]); sum += c; cnt += (c > 0u) ? 1u : 0u; mine = (j == x) ? c : mine; }
        if (sum == G) break;
        __builtin_amdgcn_s_sleep(1);
        if ((++sp & 255u) == 0u) { if (xb_ld(&bar[XB_TMO])) break; if (sp > XB_SPIN_CAP) { atomicAdd(&bar[XB_TMO], 1u); break; } }
    }
    nloc = mine > 0u ? mine : 1u; nx = cnt > 0u ? cnt : 1u;
}

__device__ __forceinline__ void xcd_barrier(const XcdBarrier& b) {
    asm volatile("s_waitcnt vmcnt(0)" ::: "memory");
    __syncthreads();
    if (threadIdx.x == 0) {
        unsigned* bar = b.bar;
        __builtin_amdgcn_s_waitcnt(0);
        unsigned nloc = b.st[0], nx = b.st[1];
        if (nloc == 0u) { xcd_barrier_complete(bar, b.x, nloc, nx); b.st[0] = nloc; b.st[1] = nx; }
        const unsigned old = xb_add(&bar[XB_XSUB(b.x)], 1u);
        const unsigned gen = old / nloc;
        if (old + 1u == (gen + 1u) * nloc) {
            __builtin_amdgcn_fence(__ATOMIC_RELEASE, "agent");
            asm volatile("s_waitcnt vmcnt(0)" ::: "memory");
            const unsigned og = xb_add(&bar[XB_TOP], 1u);
            const unsigned tg = og / nx;
            if (og + 1u == (tg + 1u) * nx) xb_add(&bar[XB_TOPGEN], 1u);
            else XB_SPIN(xb_ld(&bar[XB_TOPGEN]) == tg, bar);
            __builtin_amdgcn_fence(__ATOMIC_ACQUIRE, "agent");
            xb_add(&bar[XB_XGEN(b.x)], 1u);
            asm volatile("s_waitcnt vmcnt(0)" ::: "memory");
        } else {
            XB_SPIN(xb_ld(&bar[XB_XGEN(b.x)]) == gen, bar);
            __builtin_amdgcn_fence(__ATOMIC_ACQUIRE, "agent");
            asm volatile("s_waitcnt vmcnt(0)" ::: "memory");
        }
    }
    __syncthreads();
}

#define KARGS() ({ CArgs* p_ = (CArgs*)__builtin_amdgcn_kernarg_segment_ptr(); size_t z_ = 0; asm volatile("" : "+s"(z_)); p_ + z_; })

__global__ void __launch_bounds__(NWAVES * 64, 2) mega_fwd(Args a) {
    extern __shared__ __attribute__((aligned(16))) unsigned char lds_raw[];
    cg::grid_group grid = cg::this_grid();
    LAS unsigned char* lds = (LAS unsigned char*)lds_raw;
    const int tid = threadIdx.x, lane = tid & 63, wave = __builtin_amdgcn_readfirstlane(tid >> 6);
    const int G = gridDim.x, bx = blockIdx.x;
    const int gw = bx * NWAVES + wave, ngw = G * NWAVES;
    unsigned char* ws = a.ws;
    bf16* hb = (bf16*)(ws + WS_HB); bf16* proj = (bf16*)(ws + WS_PROJ); bf16* mixed = (bf16*)(ws + WS_MIX); bf16* ffb = (bf16*)(ws + WS_FF);
    float* sspart = (float*)(ws + WS_SS); float* kvT = (float*)(ws + WS_KVT); float* decay = (float*)(ws + WS_DEC); bf16* St = (bf16*)(ws + WS_ST);
    float* out = a.out;
#if USE_XCD
    volatile LAS unsigned* MISC = (volatile LAS unsigned*)(lds + 143360);
    if (tid < 32) MISC[tid] = 0u;
    __syncthreads();
    XcdBarrier bar = xcd_barrier_post((unsigned*)(ws + WS_CTL) + 4096, MISC + 8);
#define GSYNC() xcd_barrier(bar)
#else
#define GSYNC() do { __threadfence(); grid.sync(); } while (0)
#endif

#ifndef REP_P0
#define REP_P0 1
#endif
#ifndef REP_B1
#define REP_B1 1
#endif
#ifndef REP_B23
#define REP_B23 1
#endif
#pragma nounroll
    for (int rep = 0; rep < REP_P0; ++rep) {
#if WSTAG
    p0_weights(KARGS(), (LAS float*)(lds + wave * 16384), 0, 2048, gw, ngw, lane);
    p0_weights(KARGS(), (LAS float*)(lds + wave * 16384), 4096, 6144, gw, ngw, lane);
    p0_weights(KARGS(), (LAS float*)(lds + wave * 16384), 10240, 12288, gw, ngw, lane);
#else
    p0_weights(KARGS(), (LAS float*)(lds + wave * 16384), 0, 12288, gw, ngw, lane);
#endif
    p0_rows(a.in[0], hb, sspart, gw, ngw, lane);
    }
#if USE_XCD
    if (G == 0x7fffffff) grid.sync();
    GSYNC();
#else
    __threadfence(); grid.sync();
#endif

#ifndef STAG_A
#define STAG_A 0
#endif
#ifndef STAG_D
#define STAG_D 0
#endif
#define STAGGER_WORK(lo_, hi_) do { if (WSTAG) { if (bx & 1) { int lane_s = threadIdx.x & 63; asm volatile("" : "+v"(lane_s)); \
        p0_weights(KARGS(), (LAS float*)(lds + wave * 16384), (lo_), (hi_), (bx >> 1) * NWAVES + wave, (G >> 1) * NWAVES, lane_s); } __syncthreads(); } } while (0)
#ifndef STAG_A
#define STAG_A 0
#endif
#ifndef STAG_D
#define STAG_D 0
#endif
#define STAGGER_IDLE(ticks) do { if ((ticks) > 0 && (bx & 1)) { const unsigned long long t0_ = __builtin_amdgcn_s_memrealtime(); while (__builtin_amdgcn_s_memrealtime() - t0_ < (unsigned long long)(ticks)) __builtin_amdgcn_s_sleep(8); } } while (0)
#define LAUNDER(p) do { size_t z_ = 0; asm volatile("" : "+s"(z_)); (p) = (p) + z_; } while (0)
#pragma nounroll
    for (int l = 0; l < 2; ++l) {
        const unsigned char* wl = KARGS()->ws + WS_W + (size_t)l * W_LAYER;
#ifndef REP_GA
#define REP_GA 1
#endif
#ifndef REP_GD
#define REP_GD 1
#endif
#pragma nounroll
        for (int rg = 0; rg < REP_GA; ++rg) { const bf16* gA = ((bf16*)(KARGS()->ws + WS_HB)); const bf16* gB = (const bf16*)(wl + W_IN); LAUNDER(gA); LAUNDER(gB);
          STAGGER_IDLE(STAG_A);
          pg8::Gemm g{gA, gB, MTOK, LDP, DM}; pg8::StaticOrder S; S.init(MTOK, LDP, G, bx);
#if PROBE_DRY
          if (rg + 1 < REP_GA) { pg8::EpiScaleBf16<0, true> E{((bf16*)(KARGS()->ws + WS_PROJ)), LDP, ((float*)(KARGS()->ws + WS_SS))};
          pg8::gemm_phase<pg8::EpiScaleBf16<0, true>, pg8::StaticOrder, true, PG_SP2>(lds, g, S, E); } else
#endif
          { pg8::EpiScaleBf16<0> E{((bf16*)(KARGS()->ws + WS_PROJ)), LDP, ((float*)(KARGS()->ws + WS_SS))};
          pg8::gemm_phase<pg8::EpiScaleBf16<0>, pg8::StaticOrder, true, PG_SP2>(lds, g, S, E); } }
        GSYNC();
        { bf16* projL = ((bf16*)(KARGS()->ws + WS_PROJ)); bf16* mixedL = ((bf16*)(KARGS()->ws + WS_MIX)); float* kvTL = ((float*)(KARGS()->ws + WS_KVT)); float* decayL = ((float*)(KARGS()->ws + WS_DEC)); bf16* StL = ((bf16*)(KARGS()->ws + WS_ST)); LAUNDER(projL); LAUNDER(mixedL); LAUNDER(kvTL); LAUNDER(decayL); LAUNDER(StL);
#pragma nounroll
        for (int rep = 0; rep < REP_B1; ++rep) {
#ifndef REP_CONV
#define REP_CONV 1
#endif
#ifndef REP_KV
#define REP_KV 1
#endif
#ifndef REP_ATT
#define REP_ATT 1
#endif
#ifndef REP_SCAN
#define REP_SCAN 1
#endif
#ifndef REP_OUT
#define REP_OUT 1
#endif
#ifndef NO_CONV
#pragma nounroll
        for (int rc = 0; rc < REP_CONV; ++rc)
        for (int bc = bx; bc < 512; bc += G)
            conv_item(projL, KARGS()->in[6] + l * 31 * 256, KARGS()->in[7] + l * 256, KARGS()->in[8] + l * 256, KARGS()->in[9] + l * 256, mixedL, lds, bc, tid, wave, lane);
#endif
        {
            LAS float* biasT = (LAS float*)(lds + 131072);
            int tidb = threadIdx.x; asm volatile("" : "+v"(tidb));
            for (int i = tidb; i < 6 * 257; i += NWAVES * 64) { const int hh = i / 257, j = i - hh * 257; biasT[hh * 260 + j] = KARGS()->in[10][(size_t)l * 6 * 257 + i] * LOG2E; }
            __syncthreads();
            LAS unsigned char* vimg = lds + wave * 16384;
#ifndef NO_GLAKV
#pragma nounroll
            for (int rc = 0; rc < REP_KV; ++rc)
            for (int it = gw; it < 2048; it += ngw) gla_kv_item(projL, KARGS()->in[4] + l * 192, kvTL, decayL, vimg, it, lane);
#endif
#ifndef NO_ATT
#pragma nounroll
            for (int rc = 0; rc < REP_ATT; ++rc)
#if ATT_BLOCK
            __syncthreads();
#pragma nounroll
            for (int ra = 0; ra < REP_ATT; ++ra)
            for (int u = bx; u < 768; u += G) {
                int uu = u;
                if (G == 256) { const int combo = (u >> 8) * 8 + (bx & 7); uu = ((combo / 3) * 32 + (bx >> 3)) * 3 + combo % 3; }
                ATT_UNIT_FN(projL, mixedL, biasT, lds, uu, wave, lane);
            }
#else
            for (int u = gw; u < 6144; u += ngw) attn_unit(projL, mixedL, biasT, vimg, u, lane);
#endif
#endif
        }
        __syncthreads();
        }
        GSYNC();
#pragma nounroll
        for (int rep = 0; rep < REP_B23; ++rep) {
        LAUNDER(kvTL); LAUNDER(decayL); LAUNDER(StL);
#pragma nounroll
        for (int rc = 0; rc < REP_SCAN; ++rc)
        { int tids = threadIdx.x; asm volatile("" : "+v"(tids)); gla_scan(kvTL, decayL, StL, bx * (NWAVES * 64) + tids, G * NWAVES * 64); }
        GSYNC();
        LAUNDER(projL); LAUNDER(mixedL); LAUNDER(StL);
#ifndef NO_GLAOUT
#pragma nounroll
        for (int rc = 0; rc < REP_OUT; ++rc)
        for (int it = gw; it < 2048; it += ngw) gla_out_item(projL, StL, mixedL, it, lane);
#endif
        GSYNC();
        }
        }
#ifndef REP_GC
#define REP_GC 1
#endif
#ifndef REP_GE
#define REP_GE 1
#endif
#pragma nounroll
        for (int rgc = 0; rgc < REP_GC; ++rgc)
        { const bf16* gA = ((bf16*)(KARGS()->ws + WS_MIX)); const bf16* gB = (const bf16*)(wl + W_OUT); LAUNDER(gA); LAUNDER(gB);
          STAGGER_WORK(l == 0 ? 2048 : 8192, l == 0 ? 4096 : 10240);
          pg8::Gemm g{gA, gB, MTOK, DM, DM}; pg8::StaticOrder S; S.init(MTOK, DM, G, bx);
          pg8::EpiResid E{((bf16*)(KARGS()->ws + WS_HB)), rgc + 1 < REP_GC ? (bf16*)(KARGS()->ws + 371 * MiB) : ((bf16*)(KARGS()->ws + WS_HB)), ((float*)(KARGS()->ws + WS_SSA)), nullptr};
          pg8::gemm_phase<pg8::EpiResid, pg8::StaticOrder, true, PG_SP2>(lds, g, S, E); }
        GSYNC();
#pragma nounroll
        for (int rg = 0; rg < REP_GD; ++rg) { const bf16* gA = ((bf16*)(KARGS()->ws + WS_HB)); const bf16* gB = (const bf16*)(wl + W_UP); LAUNDER(gA); LAUNDER(gB);
          STAGGER_IDLE(STAG_D);
          pg8::Gemm g{gA, gB, MTOK, FF, DM}; pg8::StaticOrder S; S.init(MTOK, FF, G, bx);
          pg8::EpiScaleBf16<1, false, false> E{((bf16*)(KARGS()->ws + WS_FF)), FF, nullptr};
          pg8::gemm_phase<pg8::EpiScaleBf16<1, false, false>, pg8::StaticOrder, true, PG_SP2>(lds, g, S, E); }
        GSYNC();
#pragma nounroll
        for (int rge = 0; rge < REP_GE; ++rge)
        { const bf16* gA = ((bf16*)(KARGS()->ws + WS_FF)); const bf16* gB = (const bf16*)(wl + W_DN); LAUNDER(gA); LAUNDER(gB);
          STAGGER_WORK(l == 0 ? 6144 : 0, l == 0 ? 8192 : 0);
          pg8::Gemm g{gA, gB, MTOK, DM, FF}; pg8::StaticOrder S; S.init(MTOK, DM, G, bx);
          pg8::EpiResid E{((bf16*)(KARGS()->ws + WS_HB)), rge + 1 < REP_GE ? (bf16*)(KARGS()->ws + 371 * MiB) : ((bf16*)(KARGS()->ws + WS_HB)), ((float*)(KARGS()->ws + WS_SS)), ((const float*)(KARGS()->ws + WS_SSA))};
          pg8::gemm_phase<pg8::EpiResid, pg8::StaticOrder, true, PG_SP2>(lds, g, S, E); }
        GSYNC();
    }
    { int lane2 = tid & 63; asm volatile("" : "+v"(lane2)); final_rows((KARGS()->out), ((bf16*)(KARGS()->ws + WS_HB)), ((float*)(KARGS()->ws + WS_SS)), KARGS()->in[15], gw, ngw, lane2); }
}

extern "C" void kernel_launch(void* const* d_in, const int* in_sizes, int n_in, void* d_out, int out_size, void* d_ws, size_t ws_size, hipStream_t stream) {
    static int grid = 0;
    if (grid == 0) {
        if (n_in != 16 || in_sizes[0] != MTOK * DM || out_size != MTOK * DM || ws_size < WS_END) { fprintf(stderr, "kernel_launch: unexpected shapes (n_in %d, ws %zu)\n", n_in, ws_size); grid = -1; return; }
        int dev = 0, cus = 0, per_cu = 0;
        if (hipGetDevice(&dev) != hipSuccess || hipDeviceGetAttribute(&cus, hipDeviceAttributeMultiprocessorCount, dev) != hipSuccess) { grid = -1; return; }
        if (hipFuncSetAttribute((const void*)mega_fwd, hipFuncAttributeMaxDynamicSharedMemorySize, LDS_BYTES) != hipSuccess) { fprintf(stderr, "kernel_launch: hipFuncSetAttribute failed\n"); grid = -1; return; }
        if (hipOccupancyMaxActiveBlocksPerMultiprocessor(&per_cu, (const void*)mega_fwd, NWAVES * 64, LDS_BYTES) != hipSuccess || per_cu < 1) { fprintf(stderr, "kernel_launch: occupancy query says %d blocks per CU\n", per_cu); (void)hipGetLastError(); grid = -1; return; }
        grid = cus;
    }
    if (grid < 0) return;
#if USE_XCD
    if (hipMemsetAsync((char*)d_ws + WS_CTL, 0, 65536, stream) != hipSuccess) { fprintf(stderr, "kernel_launch: memset failed\n"); return; }
#endif
    Args a{};
    for (int i = 0; i < 16; ++i) a.in[i] = (const float*)d_in[i];
    a.out = (float*)d_out; a.ws = (unsigned char*)d_ws;
    void* args[] = {&a};
    const hipError_t e = hipLaunchCooperativeKernel((const void*)mega_fwd, dim3(grid), dim3(NWAVES * 64), args, LDS_BYTES, stream);
    if (e != hipSuccess) fprintf(stderr, "kernel_launch: cooperative launch failed: %s (grid %d)\n", hipGetErrorString(e), grid);
}
```
